# Optimizing an MI355X kernel written in HIP

```python
import math
import jax, jax.numpy as jnp
from jax import lax
import numpy as np

D_MODEL = 1024
BATCH = 4
SEQ = 4096
DEPTH = 1
DEC_BATCH = 16
DEC_SEQ = 32
PAST_LEN = 1024

CHUNK = 64
N_META = 16
D_MIX = D_MODEL
RET_HEADS = 4
RET_DK = 128
RET_DV = 128
MLA_HEADS = 4
MLA_NOPE = 128
MLA_ROPE = 64
MLA_V = 128
MLA_Q_LORA = 256
MLA_KV_LORA = 128
D_FF = 2816
ROPE_BASE = 10000.0
LN_EPS = 1e-5
RMS_EPS = 1e-6
Q_BLOCK = 128
DN_ALPHA = (2 * DEPTH) ** 0.25
DN_BETA = (8 * DEPTH) ** -0.25

OFF_KR = RET_HEADS * RET_DK
OFF_VR = 2 * RET_HEADS * RET_DK
OFF_GR = OFF_VR + RET_HEADS * RET_DV
OFF_CQ = OFF_GR + RET_HEADS * RET_DV
OFF_CKV = OFF_CQ + MLA_Q_LORA
OFF_KPE = OFF_CKV + MLA_KV_LORA
D_IN = OFF_KPE + MLA_ROPE

kernel_name = "hymba_retnet_mla_macaron_deepnorm_stream_step"


def layer_norm(x, g, b):
    xf = x.astype(jnp.float32)
    mu = xf.mean(-1, keepdims=True)
    var = jnp.square(xf - mu).mean(-1, keepdims=True)
    return ((xf - mu) * lax.rsqrt(var + LN_EPS) * g.astype(jnp.float32) + b.astype(jnp.float32)).astype(x.dtype)


def rms_norm(x, g):
    xf = x.astype(jnp.float32)
    return (xf * lax.rsqrt(jnp.square(xf).mean(-1, keepdims=True) + RMS_EPS) * g.astype(jnp.float32)).astype(x.dtype)


def rope(x, pos):
    d = x.shape[-1]
    inv = ROPE_BASE ** (-jnp.arange(0, d, 2, dtype=jnp.float32) / d)
    ang = pos.astype(jnp.float32)[:, None] * inv[None, :]
    cos = jnp.cos(ang)[:, None, :]
    sin = jnp.sin(ang)[:, None, :]
    xf = x.astype(jnp.float32)
    x1, x2 = xf[..., : d // 2], xf[..., d // 2:]
    return jnp.concatenate([x1 * cos - x2 * sin, x1 * sin + x2 * cos], -1).astype(x.dtype)


def swiglu(x, w_in, w_out):
    g, u = jnp.split(x @ w_in, 2, axis=-1)
    return (jax.nn.silu(g) * u) @ w_out


def ffn_block(x, w_in, w_out, g, b):
    return layer_norm(DN_ALPHA * x + 0.5 * swiglu(x, w_in, w_out), g, b)


def ret_log_gamma():
    return jnp.log(1.0 - jnp.exp2(-5.0 - jnp.arange(RET_HEADS, dtype=jnp.float32)))


def retention(q, k, v, s0, chunk):
    B, L, H, dk = q.shape
    dv = v.shape[-1]
    n = L // chunk
    f32 = jnp.float32
    lg = ret_log_gamma()
    qc = q.astype(f32).reshape(B, n, chunk, H, dk)
    kc = k.astype(f32).reshape(B, n, chunk, H, dk)
    vc = v.astype(f32).reshape(B, n, chunk, H, dv)
    idx = jnp.arange(chunk, dtype=f32)
    rel = idx[:, None] - idx[None, :]
    dmask = jnp.where(rel >= 0, jnp.exp(lg[:, None, None] * jnp.maximum(rel, 0.0)), 0.0)
    scores = jnp.einsum("bnqhd,bnkhd->bnhqk", qc, kc) * dmask[None, None]
    inner = jnp.einsum("bnhqk,bnkhe->bnqhe", scores, vc)
    kdec = jnp.exp(lg[None, :] * (chunk - 1.0 - idx)[:, None])
    kv = jnp.einsum("bnkhd,kh,bnkhe->bnhde", kc, kdec, vc)
    chunk_decay = jnp.exp(lg * chunk)[:, None, None]

    def step(s, kv_i):
        return chunk_decay * s + kv_i, s

    s_last, s_prev = lax.scan(step, s0.astype(f32), jnp.moveaxis(kv, 1, 0))
    qdec = jnp.exp(lg[None, :] * (idx + 1.0)[:, None])
    cross = jnp.einsum("bnqhd,nbhde,qh->bnqhe", qc, s_prev, qdec)
    return (inner + cross).reshape(B, L, H, dv), s_last


def retention_out(o, g_r, gn_g):
    B, L = o.shape[:2]
    mu = o.mean(-1, keepdims=True)
    var = jnp.square(o - mu).mean(-1, keepdims=True)
    on = ((o - mu) * lax.rsqrt(var + LN_EPS)).reshape(B, L, RET_HEADS * RET_DV) * gn_g.astype(jnp.float32)
    return (on * jax.nn.silu(g_r.astype(jnp.float32))).astype(g_r.dtype)


def mla_latent(ckv_raw, kpe_raw, pos, kv_norm_g):
    ckv = rms_norm(ckv_raw, kv_norm_g)
    kpe = rope(kpe_raw[:, :, None, :], pos)[:, :, 0, :]
    return ckv, kpe


def mla_query(cq, pos, q_norm_g, w_uq):
    B, L, _ = cq.shape
    q = (rms_norm(cq, q_norm_g) @ w_uq).reshape(B, L, MLA_HEADS, MLA_NOPE + MLA_ROPE)
    return jnp.concatenate([q[..., :MLA_NOPE], rope(q[..., MLA_NOPE:], pos)], -1)


def mla_keys(ckv, kpe, w_ukv):
    B, L, _ = ckv.shape
    kv = (ckv @ w_ukv).reshape(B, L, MLA_HEADS, MLA_NOPE + MLA_V)
    k = jnp.concatenate([kv[..., :MLA_NOPE], jnp.broadcast_to(kpe[:, :, None, :], (B, L, MLA_HEADS, MLA_ROPE))], -1)
    return k, kv[..., MLA_NOPE:]


def attend(q, k, v, mask):
    s = jnp.einsum("bqhd,bkhd->bhqk", q, k).astype(jnp.float32) * (MLA_NOPE + MLA_ROPE) ** -0.5
    if mask is not None:
        s = jnp.where(mask, s, -jnp.inf)
    p = jax.nn.softmax(s, axis=-1).astype(v.dtype)
    return jnp.einsum("bhqk,bkhe->bqhe", p, v)


def mixer_front(h, pos, w_mix_in, mla_q_norm_g, mla_w_uq, mla_kv_norm_g):
    B, L, _ = h.shape
    p = h @ w_mix_in
    q_r, k_r, v_r, g_r, cq, ckv, kpe = jnp.split(p, [OFF_KR, OFF_VR, OFF_GR, OFF_CQ, OFF_CKV, OFF_KPE], axis=-1)
    q_r = rope(q_r.reshape(B, L, RET_HEADS, RET_DK), pos)
    k_r = rope(k_r.reshape(B, L, RET_HEADS, RET_DK), pos) * RET_DK ** -0.5
    v_r = v_r.reshape(B, L, RET_HEADS, RET_DV)
    q_m = mla_query(cq, pos, mla_q_norm_g, mla_w_uq)
    ckv, kpe = mla_latent(ckv, kpe, pos, mla_kv_norm_g)
    return q_r, k_r, v_r, g_r, q_m, ckv, kpe


def trunk_tail(h, ret_y, mla_y, w_mix_out, ln2_g, ln2_b, ffn2_w_in, ffn2_w_out, ln3_g, ln3_b):
    mix = jnp.concatenate([ret_y, mla_y.astype(ret_y.dtype)], -1) @ w_mix_out
    h = layer_norm(DN_ALPHA * h + mix, ln2_g, ln2_b)
    return ffn_block(h, ffn2_w_in, ffn2_w_out, ln3_g, ln3_b)


def setup_inputs(seed: int = 0) -> dict:
    key = jax.random.key(seed)
    ks = jax.random.split(key, 23)
    nrm = lambda k, shape, s=1.0: jax.random.normal(k, shape, jnp.float32) * s
    gain = lambda k, n: 1.0 + 0.02 * jax.random.normal(k, (n,), jnp.float32)
    return {
        "x_prompt": nrm(ks[0], (BATCH, SEQ, D_MODEL)),
        "x_sample": nrm(ks[1], (DEC_BATCH, DEC_SEQ, D_MODEL)),
        "cache_mla_ckv": nrm(ks[2], (DEC_BATCH, PAST_LEN, MLA_KV_LORA)),
        "cache_mla_kpe": nrm(ks[3], (DEC_BATCH, PAST_LEN, MLA_ROPE)),
        "state_ret": nrm(ks[4], (DEC_BATCH, RET_HEADS, RET_DK, RET_DV), 0.3),
        "meta_tokens": nrm(ks[5], (N_META, D_MODEL)),
        "ffn1_w_in": nrm(ks[6], (D_MODEL, 2 * D_FF), D_MODEL ** -0.5),
        "ffn1_w_out": nrm(ks[7], (D_FF, D_MODEL), DN_BETA * D_FF ** -0.5),
        "ln1_g": gain(ks[8], D_MODEL),
        "ln1_b": nrm(ks[9], (D_MODEL,), 0.02),
        "w_mix_in": nrm(ks[10], (D_MODEL, D_IN), D_MODEL ** -0.5),
        "ret_gn_g": gain(ks[11], RET_HEADS * RET_DV),
        "mla_q_norm_g": gain(ks[12], MLA_Q_LORA),
        "mla_w_uq": nrm(ks[13], (MLA_Q_LORA, MLA_HEADS * (MLA_NOPE + MLA_ROPE)), MLA_Q_LORA ** -0.5),
        "mla_kv_norm_g": gain(ks[14], MLA_KV_LORA),
        "mla_w_ukv": nrm(ks[15], (MLA_KV_LORA, MLA_HEADS * (MLA_NOPE + MLA_V)), MLA_KV_LORA ** -0.5),
        "w_mix_out": nrm(ks[16], (D_MIX, D_MODEL), DN_BETA * D_MIX ** -0.5),
        "ln2_g": gain(ks[17], D_MODEL),
        "ln2_b": nrm(ks[18], (D_MODEL,), 0.02),
        "ffn2_w_in": nrm(ks[19], (D_MODEL, 2 * D_FF), D_MODEL ** -0.5),
        "ffn2_w_out": nrm(ks[20], (D_FF, D_MODEL), DN_BETA * D_FF ** -0.5),
        "ln3_g": gain(ks[21], D_MODEL),
        "ln3_b": nrm(ks[22], (D_MODEL,), 0.02),
    }


def reference(x_prompt, x_sample, cache_mla_ckv, cache_mla_kpe, state_ret, meta_tokens,
              ffn1_w_in, ffn1_w_out, ln1_g, ln1_b, w_mix_in, ret_gn_g, mla_q_norm_g, mla_w_uq,
              mla_kv_norm_g, mla_w_ukv, w_mix_out, ln2_g, ln2_b, ffn2_w_in, ffn2_w_out, ln3_g, ln3_b):
    B, S, D = x_prompt.shape
    L = N_META + S
    x = jnp.concatenate([jnp.broadcast_to(meta_tokens.astype(x_prompt.dtype)[None], (B, N_META, D)), x_prompt], 1)
    h = x
    for _ in range(DEPTH):
        h = ffn_block(h, ffn1_w_in, ffn1_w_out, ln1_g, ln1_b)
        pos = jnp.arange(L)
        q_r, k_r, v_r, g_r, q_m, p_ckv, p_kpe = mixer_front(h, pos, w_mix_in, mla_q_norm_g, mla_w_uq, mla_kv_norm_g)
        pad = (-L) % CHUNK
        padf = lambda a: jnp.pad(a, ((0, 0), (pad, 0), (0, 0), (0, 0)))
        s0 = jnp.zeros((B, RET_HEADS, RET_DK, RET_DV), jnp.float32)
        o_r, p_state = retention(padf(q_r), padf(k_r), padf(v_r), s0, CHUNK)
        ret_y = retention_out(o_r[:, pad:], g_r, ret_gn_g)
        k_m, v_m = mla_keys(p_ckv, p_kpe, mla_w_ukv)
        meta_o = attend(q_m[:, :N_META], k_m[:, :N_META], v_m[:, :N_META], None)
        key_chunk = jnp.concatenate([jnp.full((N_META,), -1, jnp.int32), jnp.arange(S, dtype=jnp.int32) // CHUNK])
        nb = S // Q_BLOCK
        q_blocks = jnp.moveaxis(q_m[:, N_META:].reshape(B, nb, Q_BLOCK, MLA_HEADS, MLA_NOPE + MLA_ROPE), 1, 0)

        def block(args):
            qb, bi = args
            q_chunk = (bi * Q_BLOCK + jnp.arange(Q_BLOCK, dtype=jnp.int32)) // CHUNK
            mask = key_chunk[None, :] <= q_chunk[:, None]
            return attend(qb, k_m, v_m, mask)

        frame_o = lax.map(block, (q_blocks, jnp.arange(nb, dtype=jnp.int32)))
        frame_o = jnp.moveaxis(frame_o, 0, 1).reshape(B, S, MLA_HEADS, MLA_V)
        mla_y = jnp.concatenate([meta_o, frame_o], 1).reshape(B, L, MLA_HEADS * MLA_V)
        h = trunk_tail(h, ret_y, mla_y, w_mix_out, ln2_g, ln2_b, ffn2_w_in, ffn2_w_out, ln3_g, ln3_b)
    y_prompt = h[:, N_META:]

    DB, T, _ = x_sample.shape
    P = cache_mla_ckv.shape[1]
    hs = x_sample
    for _ in range(DEPTH):
        meta_h = ffn_block(meta_tokens.astype(x_sample.dtype), ffn1_w_in, ffn1_w_out, ln1_g, ln1_b)
        meta_lat = (meta_h @ w_mix_in[:, OFF_CKV:D_IN])[None]
        meta_ckv, meta_kpe = mla_latent(meta_lat[..., :MLA_KV_LORA], meta_lat[..., MLA_KV_LORA:], jnp.arange(N_META), mla_kv_norm_g)
        hs = ffn_block(hs, ffn1_w_in, ffn1_w_out, ln1_g, ln1_b)
        pos_s = N_META + P + jnp.arange(T)
        q_r, k_r, v_r, g_r, q_m, s_ckv, s_kpe = mixer_front(hs, pos_s, w_mix_in, mla_q_norm_g, mla_w_uq, mla_kv_norm_g)
        o_r, s_state = retention(q_r, k_r, v_r, state_ret, T)
        ret_y = retention_out(o_r, g_r, ret_gn_g)
        ckv_all = jnp.concatenate([jnp.broadcast_to(meta_ckv, (DB, N_META, MLA_KV_LORA)).astype(s_ckv.dtype),
                                   cache_mla_ckv.astype(s_ckv.dtype), s_ckv], 1)
        kpe_all = jnp.concatenate([jnp.broadcast_to(meta_kpe, (DB, N_META, MLA_ROPE)).astype(s_kpe.dtype),
                                   cache_mla_kpe.astype(s_kpe.dtype), s_kpe], 1)
        k_s, v_s = mla_keys(ckv_all, kpe_all, mla_w_ukv)
        mla_y = attend(q_m, k_s, v_s, None).reshape(DB, T, MLA_HEADS * MLA_V)
        hs = trunk_tail(hs, ret_y, mla_y, w_mix_out, ln2_g, ln2_b, ffn2_w_in, ffn2_w_out, ln3_g, ln3_b)
    y_sample = hs

    return (y_prompt, y_sample, p_ckv, p_kpe, p_state.astype(x_prompt.dtype),
            s_ckv, s_kpe, s_state.astype(state_ret.dtype))
```

```cpp
#include <hip/hip_runtime.h>
#include <hip/hip_cooperative_groups.h>
#include <cstdio>
#include <cstdint>

namespace pg8 {
#define PG8_LAS __attribute__((address_space(3)))
typedef unsigned short bf16_t;
typedef short bf16x8 __attribute__((ext_vector_type(8)));
typedef float f32x4 __attribute__((ext_vector_type(4)));
typedef unsigned u32x4 __attribute__((ext_vector_type(4)));
constexpr int BM = 256, BK = 64, HALF = 128, HTB = HALF * BK * 2  , STAGE_BYTES = 8 * HTB, NXCD = 8, WGM = 8;

__host__ __device__ __forceinline__ int lds_byte(int r, int c) { const int st = (r >> 4) * 2 + (c >> 5), rr = r & 15, cc = c & 31, ob = rr * 64 + cc * 2; return st * 1024 + (ob ^ (((ob >> 9) & 1) << 5)); }
__host__ __device__ __forceinline__ void stage_rc(int b, int& R, int& C) { const int st = b / 1024, sb = b % 1024, swz = sb ^ (((sb >> 9) & 1) << 5); R = (st >> 1) * 16 + swz / 64; C = (st & 1) * 32 + (swz % 64) / 2; }
__host__ __device__ __forceinline__ int perm32(int rho) { const int n = rho >> 4, i = rho & 15; return 8 * (i >> 2) + 4 * n + (i & 3); }

struct Unit { int pm, pn; };
struct Gemm { const bf16_t* A; const bf16_t* Bt; int M, N, K; };

struct StaticOrder {
    int nM, nN, nwg, G, c;
    __host__ __device__ void init(int M, int N, int G_, int c_) { nM = M / BM; nN = N / BM; nwg = nM * nN; G = G_; c = c_; }
    __host__ __device__ bool next(int i, Unit& u) const {
        const long L = (long)i * G + c; if (L >= nwg) return false;
        int wgid = (int)L; { const int q = nwg / NXCD, r = nwg % NXCD, xcd = wgid % NXCD, off = wgid / NXCD; wgid = (xcd < r ? xcd * (q + 1) : r * (q + 1) + (xcd - r) * q) + off; }
        const int nig = WGM * nN, gid = wgid / nig, fm = gid * WGM, gsz = (nM - fm) < WGM ? (nM - fm) : WGM;
        u.pm = fm + ((wgid % nig) % gsz); u.pn = (wgid % nig) / gsz; return true;
    }
    __device__ __forceinline__ void a_ready(const Unit&) const {}
    __device__ __forceinline__ void done(const Unit&) const {}
};

__device__ __forceinline__ unsigned cvt_pk_bf16(float lo, float hi) { unsigned r; asm volatile("v_cvt_pk_bf16_f32 %0, %1, %2" : "=v"(r) : "v"(lo), "v"(hi)); return r; }
typedef float f32x2 __attribute__((ext_vector_type(2)));

template <class Epi, class Sched, bool ALIGN_EPI = false, bool SP2 = false>
__device__ __forceinline__ void gemm_phase(PG8_LAS unsigned char* lds, const Gemm g, const Sched& S, const Epi& E) {
    const int tid = threadIdx.x, wid = __builtin_amdgcn_readfirstlane(tid >> 6), lane = tid & 63, wr = wid >> 2, wc = wid & 3, fr = lane & 15, fq = lane >> 4;
    const int K = g.K, nt = K / BK;
    unsigned voffA[2], voffB[2];
#pragma unroll
    for (int i = 0; i < 2; ++i) { int R, C; stage_rc(tid * 16 + i * 8192, R, C); const int Rb = Epi::PERM ? ((R & ~31) + perm32(R & 31)) : R;
        voffA[i] = (unsigned)(R * K + C) * 2u; voffB[i] = (unsigned)(Rb * K + C) * 2u; }
    const size_t kstep = (size_t)(BK * 2);
    const size_t hstep = (size_t)HALF * K * 2;
    const size_t tstep = 2 * hstep;
    const unsigned ldsw = (unsigned)wid * 1024u;
    const int aoff = lds_byte(wr * 64 + fr, fq * 8), boff = lds_byte(wc * 32 + fr, fq * 8);
#define PG8_SA(b, h) (((b) * 2 + (h)) * HTB)
#define PG8_SB(b, h) ((4 + (b) * 2 + (h)) * HTB)
#define PG8_STAGE(bufoff, gbase, voff) do { _Pragma("unroll") for (int _i = 0; _i < 2; ++_i) \
        __builtin_amdgcn_global_load_lds((const unsigned*)((const char*)(gbase) + (voff)[_i]), (PG8_LAS unsigned*)(lds + (bufoff) + ldsw + _i * 8192), 16, 0, 0); } while (0)
#define PG8_LDA(dst, b, h) do { _Pragma("unroll") for (int m = 0; m < 4; ++m) _Pragma("unroll") for (int k = 0; k < 2; ++k) dst[m][k] = *(const PG8_LAS bf16x8*)(lds + PG8_SA(b, h) + aoff + m * 2048 + k * 1024); } while (0)
#define PG8_LDB(dst, b, h) do { _Pragma("unroll") for (int n = 0; n < 2; ++n) _Pragma("unroll") for (int k = 0; k < 2; ++k) dst[n][k] = *(const PG8_LAS bf16x8*)(lds + PG8_SB(b, h) + boff + n * 2048 + k * 1024); } while (0)
#define PG8_MMA(ai, bj, At, Bt) do { __builtin_amdgcn_s_setprio(1); _Pragma("unroll") for (int m = 0; m < 4; ++m) _Pragma("unroll") for (int n = 0; n < 2; ++n) _Pragma("unroll") for (int k = 0; k < 2; ++k) \
        acc[ai][bj][m][n] = __builtin_amdgcn_mfma_f32_16x16x32_bf16(Bt[n][k], At[m][k], acc[ai][bj][m][n], 0, 0, 0); __builtin_amdgcn_s_setprio(0); } while (0)
#define PG8_WAIT_V(n) asm volatile("s_waitcnt vmcnt(" #n ")" ::: "memory")
#define PG8_WAIT_L(n) asm volatile("s_waitcnt lgkmcnt(" #n ")" ::: "memory")
#define PG8_BAR __builtin_amdgcn_s_barrier()
#define PG8_SCHED __builtin_amdgcn_sched_barrier(0)
    Unit cur, nxt; int ui = 0;
    if (!S.next(0, cur)) return;
    f32x4 acc[2][2][4][2];
#pragma unroll
    for (int a = 0; a < 2; ++a)
#pragma unroll
        for (int b = 0; b < 2; ++b)
#pragma unroll
            for (int m = 0; m < 4; ++m)
#pragma unroll
                for (int n = 0; n < 2; ++n) acc[a][b][m][n] = (f32x4){0.f, 0.f, 0.f, 0.f};
    bf16x8 At[4][2], B0[2][2], B1[2][2];
    const char* cA = (const char*)g.A + (size_t)cur.pm * tstep; const char* cB = (const char*)g.Bt + (size_t)cur.pn * tstep;
    S.a_ready(cur);
    if constexpr (SP2) {
        PG8_STAGE(PG8_SB(0, 0), cB, voffB); PG8_STAGE(PG8_SB(0, 1), cB + hstep, voffB); PG8_STAGE(PG8_SA(0, 0), cA, voffA); PG8_STAGE(PG8_SA(0, 1), cA + hstep, voffA);
        if (wr == 1) PG8_BAR;
        PG8_WAIT_V(2); PG8_BAR;
        PG8_STAGE(PG8_SB(1, 0), cB + kstep, voffB); PG8_STAGE(PG8_SA(1, 0), cA + kstep, voffA); PG8_STAGE(PG8_SB(1, 1), cB + hstep + kstep, voffB);
        PG8_WAIT_V(6); PG8_BAR;
    } else {
        PG8_STAGE(PG8_SB(0, 0), cB, voffB); PG8_STAGE(PG8_SA(0, 0), cA, voffA); PG8_STAGE(PG8_SB(0, 1), cB + hstep, voffB); PG8_STAGE(PG8_SA(0, 1), cA + hstep, voffA);
        if (wr == 1) PG8_BAR;
        PG8_WAIT_V(4); PG8_BAR;
        PG8_STAGE(PG8_SB(1, 0), cB + kstep, voffB); PG8_STAGE(PG8_SA(1, 0), cA + kstep, voffA); PG8_STAGE(PG8_SB(1, 1), cB + hstep + kstep, voffB);
        PG8_WAIT_V(6); PG8_BAR;
    }
    for (;;) {
        const bool has_next = S.next(ui + 1, nxt);
        const char* nA = has_next ? (const char*)g.A + (size_t)nxt.pm * tstep : cA; const char* nB = has_next ? (const char*)g.Bt + (size_t)nxt.pn * tstep : cB;
        for (int t = 0; t < nt; t += 2) {
            const bool last = (t == nt - 2);
            const char* a1 = cA + (size_t)(t + 1) * kstep;
            const char* a2 = last ? nA : cA + (size_t)(t + 2) * kstep; const char* b2 = last ? nB : cB + (size_t)(t + 2) * kstep;
            const char* a3 = a2 + kstep; const char* b3 = b2 + kstep;
            if (last && has_next) S.a_ready(nxt);
            if constexpr (SP2) {
            PG8_LDB(B0, 0, 0); PG8_LDB(B1, 0, 1); PG8_SCHED; PG8_LDA(At, 0, 0); PG8_STAGE(PG8_SA(1, 1), a1 + hstep, voffA);
            PG8_WAIT_V(8); PG8_WAIT_L(0); PG8_BAR; PG8_MMA(0, 0, At, B0); PG8_MMA(0, 1, At, B1); PG8_BAR; PG8_SCHED;
            PG8_LDA(At, 0, 1); PG8_STAGE(PG8_SB(0, 0), b2, voffB); PG8_STAGE(PG8_SB(0, 1), b2 + hstep, voffB); PG8_STAGE(PG8_SA(0, 0), a2, voffA);
            PG8_WAIT_V(8); PG8_WAIT_L(0); PG8_BAR; PG8_MMA(1, 0, At, B0); PG8_MMA(1, 1, At, B1); PG8_BAR; PG8_SCHED;
            PG8_LDB(B0, 1, 0); PG8_LDB(B1, 1, 1); PG8_SCHED; PG8_LDA(At, 1, 0); PG8_STAGE(PG8_SA(0, 1), a2 + hstep, voffA);
            PG8_WAIT_V(8); PG8_WAIT_L(0); PG8_BAR; PG8_MMA(0, 0, At, B0); PG8_MMA(0, 1, At, B1); PG8_BAR; PG8_SCHED;
            PG8_LDA(At, 1, 1); PG8_STAGE(PG8_SB(1, 0), b3, voffB); PG8_STAGE(PG8_SB(1, 1), b3 + hstep, voffB); PG8_STAGE(PG8_SA(1, 0), a3, voffA);
            PG8_WAIT_V(8); PG8_WAIT_L(0); PG8_BAR; PG8_MMA(1, 0, At, B0); PG8_MMA(1, 1, At, B1); PG8_BAR; PG8_SCHED;
            } else {
            PG8_LDB(B0, 0, 0); PG8_SCHED; PG8_LDA(At, 0, 0); PG8_STAGE(PG8_SA(1, 1), a1 + hstep, voffA);
            PG8_WAIT_L(8); PG8_BAR; PG8_WAIT_L(0); PG8_MMA(0, 0, At, B0); PG8_BAR; PG8_SCHED;
            PG8_LDB(B1, 0, 1); PG8_STAGE(PG8_SB(0, 0), b2, voffB);
            PG8_BAR; PG8_WAIT_L(0); PG8_MMA(0, 1, At, B1); PG8_BAR;
            PG8_LDA(At, 0, 1); PG8_STAGE(PG8_SA(0, 0), a2, voffA);
            PG8_BAR; PG8_WAIT_L(0); PG8_MMA(1, 0, At, B0); PG8_BAR; PG8_SCHED;
            PG8_STAGE(PG8_SB(0, 1), b2 + hstep, voffB);
            PG8_WAIT_V(6); PG8_BAR; PG8_MMA(1, 1, At, B1); PG8_BAR;
            PG8_LDB(B0, 1, 0); PG8_SCHED; PG8_LDA(At, 1, 0); PG8_STAGE(PG8_SA(0, 1), a2 + hstep, voffA);
            PG8_WAIT_L(8); PG8_BAR; PG8_WAIT_L(0); PG8_MMA(0, 0, At, B0); PG8_BAR; PG8_SCHED;
            PG8_LDB(B1, 1, 1); PG8_STAGE(PG8_SB(1, 0), b3, voffB);
            PG8_BAR; PG8_WAIT_L(0); PG8_MMA(0, 1, At, B1); PG8_BAR;
            PG8_LDA(At, 1, 1); PG8_STAGE(PG8_SA(1, 0), a3, voffA);
            PG8_BAR; PG8_WAIT_L(0); PG8_MMA(1, 0, At, B0); PG8_BAR; PG8_SCHED;
            PG8_STAGE(PG8_SB(1, 1), b3 + hstep, voffB);
            PG8_WAIT_V(6); PG8_BAR; PG8_MMA(1, 1, At, B1); PG8_BAR;
            }
        }
        if constexpr (ALIGN_EPI) { if (wr == 0) PG8_BAR; }
        if constexpr (!Epi::AFTER_DRAIN) { E(acc, cur, wr, wc, fr, fq); S.done(cur); }
        if (!has_next) break;
#pragma unroll
        for (int a = 0; a < 2; ++a)
#pragma unroll
            for (int b = 0; b < 2; ++b)
#pragma unroll
                for (int m = 0; m < 4; ++m)
#pragma unroll
                    for (int n = 0; n < 2; ++n) acc[a][b][m][n] = (f32x4){0.f, 0.f, 0.f, 0.f};
        cur = nxt; cA = nA; cB = nB; ++ui;
        if constexpr (ALIGN_EPI) { if (wr == 1) PG8_BAR; }
    }
    PG8_WAIT_V(0);
    if constexpr (!ALIGN_EPI) { if (wr == 0) PG8_BAR; }
    PG8_BAR;
    if constexpr (Epi::AFTER_DRAIN) { E.fused(acc, cur, wr, wc, fr, fq, lds, wid, lane); S.done(cur); }
#undef PG8_SA
#undef PG8_SB
#undef PG8_STAGE
#undef PG8_LDA
#undef PG8_LDB
#undef PG8_MMA
#undef PG8_WAIT_V
#undef PG8_WAIT_L
#undef PG8_BAR
#undef PG8_SCHED
}
}

#define LAS __attribute__((address_space(3)))

#define XB_TMO      128
#define XB_XCNT(j)  (256  + 64 * (j))
#define XB_XSUB(j)  (1280 + 64 * (j))
#define XB_XGEN(j)  (2304 + 64 * (j))
#define XB_TOP      3328
#define XB_TOPGEN   3392
#define XCD_BAR_WORDS 3456
#define XB_SPIN_CAP (1u << 18)

__device__ __forceinline__ unsigned xb_ld(unsigned* p)              { return __hip_atomic_load(p, __ATOMIC_RELAXED, __HIP_MEMORY_SCOPE_AGENT); }
__device__ __forceinline__ unsigned xb_add(unsigned* p, unsigned v) { return __hip_atomic_fetch_add(p, v, __ATOMIC_RELAXED, __HIP_MEMORY_SCOPE_AGENT); }
__device__ __forceinline__ unsigned xb_xcc_id() { return (unsigned)__builtin_amdgcn_s_getreg((3 << 11) | 20) & 0xFu; }
#define XB_SPIN(cond, bar) do { unsigned _sp = 0; while (cond) { __builtin_amdgcn_s_sleep(1); \
    if ((++_sp & 255u) == 0u) { if (xb_ld(&(bar)[XB_TMO])) break; if (_sp > XB_SPIN_CAP) { atomicAdd(&(bar)[XB_TMO], 1u); break; } } } } while (0)

struct XcdBarrier {
    unsigned* bar; unsigned x;
    volatile LAS unsigned* st;
};

__device__ __forceinline__ XcdBarrier xcd_barrier_post(unsigned* bar, volatile LAS unsigned* st) {
    XcdBarrier b; b.bar = bar; b.x = xb_xcc_id(); b.st = st;
    if (threadIdx.x == 0) (void)xb_add(&bar[XB_XCNT(b.x)], 1u);
    return b;
}
__device__ __forceinline__ void xcd_barrier_complete(unsigned* bar, unsigned x, unsigned& nloc, unsigned& nx) {
    const unsigned G = gridDim.x * gridDim.y * gridDim.z;
    unsigned sum, cnt, mine, sp = 0u;
    for (;;) {
        sum = 0u; cnt = 0u; mine = 0u;
#pragma unroll
        for (unsigned j = 0; j < 16; ++j) { const unsigned c = xb_ld(&bar[XB_XCNT(j)]); sum += c; cnt += (c > 0u) ? 1u : 0u; mine = (j == x) ? c : mine; }
        if (sum == G) break;
        __builtin_amdgcn_s_sleep(1);
        if ((++sp & 255u) == 0u) { if (xb_ld(&bar[XB_TMO])) break; if (sp > XB_SPIN_CAP) { atomicAdd(&bar[XB_TMO], 1u); break; } }
    }
    nloc = mine > 0u ? mine : 1u; nx = cnt > 0u ? cnt : 1u;
}

__device__ __forceinline__ void xcd_barrier(const XcdBarrier& b) {
    asm volatile("s_waitcnt vmcnt(0)" ::: "memory");
    __syncthreads();
    if (threadIdx.x == 0) {
        unsigned* bar = b.bar;
        __builtin_amdgcn_s_waitcnt(0);
        unsigned nloc = b.st[0], nx = b.st[1];
        if (nloc == 0u) { xcd_barrier_complete(bar, b.x, nloc, nx); b.st[0] = nloc; b.st[1] = nx; }
        const unsigned old = xb_add(&bar[XB_XSUB(b.x)], 1u);
        const unsigned gen = old / nloc;
        if (old + 1u == (gen + 1u) * nloc) {
            __builtin_amdgcn_fence(__ATOMIC_RELEASE, "agent");
            asm volatile("s_waitcnt vmcnt(0)" ::: "memory");
            const unsigned og = xb_add(&bar[XB_TOP], 1u);
            const unsigned tg = og / nx;
            if (og + 1u == (tg + 1u) * nx) xb_add(&bar[XB_TOPGEN], 1u);
            else XB_SPIN(xb_ld(&bar[XB_TOPGEN]) == tg, bar);
            __builtin_amdgcn_fence(__ATOMIC_ACQUIRE, "agent");
            xb_add(&bar[XB_XGEN(b.x)], 1u);
            asm volatile("s_waitcnt vmcnt(0)" ::: "memory");
        } else {
            XB_SPIN(xb_ld(&bar[XB_XGEN(b.x)]) == gen, bar);
            __builtin_amdgcn_fence(__ATOMIC_ACQUIRE, "agent");
            asm volatile("s_waitcnt vmcnt(0)" ::: "memory");
        }
    }
    __syncthreads();
}


#define GAS __attribute__((address_space(1)))

typedef unsigned short bf16;
typedef unsigned v4u __attribute__((ext_vector_type(4)));
typedef unsigned v2u __attribute__((ext_vector_type(2)));
typedef float f32x4 __attribute__((ext_vector_type(4)));
typedef float f32x2 __attribute__((ext_vector_type(2)));
typedef float f32x16 __attribute__((ext_vector_type(16)));
typedef short bf16x8 __attribute__((ext_vector_type(8)));
#define LDS_WAIT() asm volatile("s_waitcnt lgkmcnt(0)" ::: "memory")
#define VM_WAIT() asm volatile("s_waitcnt vmcnt(0)" ::: "memory")

constexpr int DM = 1024, NMETA = 16, SEQ = 4096, NB = 4, DBS = 16, TS = 32, PAST = 1024, FF = 2816, LP = NMETA + SEQ;
constexpr int R_PROMPT = 16, R_SAMPLE = R_PROMPT + NB * SEQ, R_VALID = R_SAMPLE + DBS * TS, MTOT = 17152;
static_assert(R_SAMPLE == 16400 && R_VALID == 16912 && MTOT % 256 == 0 && MTOT >= R_VALID + 64, "row space");
constexpr int DIN = 2496, DINP = 2560, NQA = 768, KVW = 192;
constexpr float DN_ALPHA = 1.189207115002721f, LN_EPS = 1e-5f, RMS_EPS = 1e-6f, LOG2E = 1.4426950408889634f;
constexpr float SM_SCALE = 0.07216878364870322f;
constexpr float KR_SCALE = 0.08838834764831845f;
constexpr size_t O_YP = 0, O_YS = O_YP + (size_t)NB * SEQ * DM, O_PCKV = O_YS + (size_t)DBS * TS * DM, O_PKPE = O_PCKV + (size_t)NB * LP * 128, O_PST = O_PKPE + (size_t)NB * LP * 64,
                 O_SCKV = O_PST + (size_t)NB * 4 * 128 * 128, O_SKPE = O_SCKV + (size_t)DBS * TS * 128, O_SST = O_SKPE + (size_t)DBS * TS * 64, O_END = O_SST + (size_t)DBS * 4 * 128 * 128;
static_assert(O_END == 21868544, "d_out size");

constexpr size_t al256(size_t x) { return (x + 255) & ~(size_t)255; }
constexpr size_t WS_CTL = 0, CTL_BYTES = 1u << 20;
constexpr size_t WS_WFI = WS_CTL + CTL_BYTES;
constexpr size_t WS_WFO = WS_WFI + (size_t)5632 * 1024 * 2;
constexpr size_t WS_WMI = WS_WFO + (size_t)1024 * 2816 * 2;
constexpr size_t WS_WMO = WS_WMI + (size_t)2560 * 1024 * 2;
constexpr size_t WS_WUQ = WS_WMO + (size_t)1024 * 1024 * 2;
constexpr size_t WS_R128 = WS_WUQ + (size_t)768 * 256 * 2;
constexpr size_t WS_R64 = WS_R128 + (size_t)LP * 64 * 8;
constexpr size_t WS_A16A = al256(WS_R64 + (size_t)LP * 32 * 8);
constexpr size_t A16_BYTES = (size_t)MTOT * 1024 * 2;
constexpr size_t WS_A16B = WS_A16A + A16_BYTES;
constexpr size_t WS_Z = WS_A16B + A16_BYTES;
constexpr size_t Z_BYTES = (size_t)MTOT * 1024 * 4;
constexpr size_t WS_HID = WS_Z + Z_BYTES;
constexpr size_t HID_BYTES = (size_t)MTOT * 2816 * 2;
constexpr size_t WS_END = WS_HID + HID_BYTES;
static_assert(WS_END <= 268435456, "workspace map exceeds 256 MiB");
constexpr size_t WS_P2RAW = WS_Z;
constexpr size_t WS_QA = WS_Z;
constexpr size_t WS_KVN = WS_QA + (size_t)MTOT * 768 * 2;
constexpr int KVN_ITEMS = 4 + NB * 4 * 64;
constexpr size_t WS_KVCT = WS_KVN + (size_t)KVN_ITEMS * 32768;
constexpr size_t WS_CKVT = WS_KVCT + (size_t)DBS * 128 * PAST * 2;
static_assert(WS_CKVT + (size_t)128 * MTOT * 2 <= WS_Z + Z_BYTES && WS_KVCT >= WS_P2RAW + (size_t)MTOT * 512 * 4, "Z overlays");
constexpr size_t RB_BYTES = (size_t)MTOT * 512 * 2;
constexpr size_t WS_QR = WS_HID, WS_KR = WS_QR + RB_BYTES, WS_VR = WS_KR + RB_BYTES, WS_GS = WS_VR + RB_BYTES;
constexpr size_t WS_KVB = WS_GS + RB_BYTES;
constexpr size_t WS_KVC = WS_KVB + (size_t)MTOT * KVW * 2;
constexpr size_t WS_CQB = WS_KVC + (size_t)DBS * PAST * KVW * 2;
static_assert(WS_CQB + (size_t)MTOT * 256 * 2 <= WS_HID + HID_BYTES, "HID overlays");
constexpr int CW_BAR = 4096;

__device__ __forceinline__ float lg2gamma(int h) { return h == 0 ? -0.04580368961312479f : h == 1 ? -0.02272007650008353f : h == 2 ? -0.011315313227834146f : -0.005646563141142063f; }

__device__ __forceinline__ int row_pos(int r) { return r < R_PROMPT ? r : (r < R_SAMPLE ? NMETA + ((r - R_PROMPT) & (SEQ - 1)) : (r < R_VALID ? NMETA + PAST + ((r - R_SAMPLE) & (TS - 1)) : 0)); }
__device__ __forceinline__ unsigned f2bf(float f) { unsigned u = __builtin_bit_cast(unsigned, f); return (u + 0x7fffu + ((u >> 16) & 1u)) >> 16; }
__device__ __forceinline__ unsigned pk2(float lo, float hi) { return pg8::cvt_pk_bf16(lo, hi); }
__device__ __forceinline__ float bf2f(unsigned short b) { return __builtin_bit_cast(float, (unsigned)b << 16); }
__device__ __forceinline__ float bflo(unsigned w) { return __builtin_bit_cast(float, w << 16); }
__device__ __forceinline__ float bfhi(unsigned w) { return __builtin_bit_cast(float, w & 0xffff0000u); }
__device__ __forceinline__ float siluf(float x) { return x * __builtin_amdgcn_rcpf(1.0f + __builtin_amdgcn_exp2f(-x * LOG2E)); }
__device__ __forceinline__ float wave_sum(float v) {
#pragma unroll
    for (int o = 1; o < 64; o <<= 1) v += __shfl_xor(v, o);
    return v;
}

struct Args { const float* in[23]; float* out; unsigned char* ws; };

__device__ __forceinline__ const float* x_row(const Args& a, int r) {
    if (r < R_PROMPT) return a.in[5] + (size_t)r * DM;
    if (r < R_SAMPLE) return a.in[0] + (size_t)(r - R_PROMPT) * DM;
    if (r < R_VALID) return a.in[1] + (size_t)(r - R_SAMPLE) * DM;
    return nullptr;
}

struct EpiSwiglu {
    static constexpr bool PERM = true, AFTER_DRAIN = false;
    bf16* H;
    __device__ __forceinline__ void operator()(const pg8::f32x4 (&acc)[2][2][4][2], const pg8::Unit& u, int wr, int wc, int fr, int fq) const {
        asm volatile("" : "+v"(fr), "+v"(fq));
        const int row0 = u.pm * 256 + wr * 64 + fr, col0 = u.pn * 128 + wc * 32 + 8 * fq;
#pragma unroll
        for (int ai = 0; ai < 2; ++ai)
#pragma unroll
            for (int m = 0; m < 4; ++m) {
                const int row = row0 + ai * 128 + m * 16;
                const pg8::f32x4 g0 = acc[ai][0][m][0], g1 = acc[ai][0][m][1], u0 = acc[ai][1][m][0], u1 = acc[ai][1][m][1];
                v4u w;
                w.x = pk2(siluf(g0[0]) * u0[0], siluf(g0[1]) * u0[1]); w.y = pk2(siluf(g0[2]) * u0[2], siluf(g0[3]) * u0[3]);
                w.z = pk2(siluf(g1[0]) * u1[0], siluf(g1[1]) * u1[1]); w.w = pk2(siluf(g1[2]) * u1[2], siluf(g1[3]) * u1[3]);
                *(v4u*)(H + (size_t)row * FF + col0) = w;
            }
    }
};
template <int SRC> struct EpiResZ {
    static constexpr bool PERM = false, AFTER_DRAIN = false;
    float* Z; const bf16* resb; Args a; float scale;
    __device__ __forceinline__ void operator()(const pg8::f32x4 (&acc)[2][2][4][2], const pg8::Unit& u, int wr, int wc, int fr, int fq) const {
        asm volatile("" : "+v"(fr), "+v"(fq));
        const int row0 = u.pm * 256 + wr * 64 + fr, col0 = u.pn * 256 + wc * 32 + 4 * fq;
#pragma unroll
        for (int ai = 0; ai < 2; ++ai)
#pragma unroll
            for (int m = 0; m < 4; ++m) {
                const int row = row0 + ai * 128 + m * 16;
                const float* xr = SRC == 0 ? x_row(a, row) : nullptr;
#pragma unroll
                for (int bj = 0; bj < 2; ++bj)
#pragma unroll
                    for (int n = 0; n < 2; ++n) {
                        const int c = col0 + bj * 128 + n * 16;
                        f32x4 rv;
                        if (SRC == 0) rv = xr ? *(const f32x4*)(xr + c) : (f32x4){0.f, 0.f, 0.f, 0.f};
                        else { const v2u w = *(const v2u*)(resb + (size_t)row * DM + c); rv = (f32x4){bflo(w.x), bfhi(w.x), bflo(w.y), bfhi(w.y)}; }
                        const pg8::f32x4 av = acc[ai][bj][m][n];
                        f32x4 o; o.x = DN_ALPHA * rv.x + scale * av[0]; o.y = DN_ALPHA * rv.y + scale * av[1]; o.z = DN_ALPHA * rv.z + scale * av[2]; o.w = DN_ALPHA * rv.w + scale * av[3];
                        *(f32x4*)(Z + (size_t)row * DM + c) = o;
                    }
                asm volatile("" ::: "memory");
            }
    }
};
struct EpiMixIn {
    static constexpr bool PERM = true, AFTER_DRAIN = false;
    bf16 *QR, *KR, *VR, *GS; float* P2; const f32x2* R128;
    __device__ __forceinline__ void operator()(const pg8::f32x4 (&acc)[2][2][4][2], const pg8::Unit& u, int wr, int wc, int fr, int fq) const {
        asm volatile("" : "+v"(fr), "+v"(fq));
        const int row0 = u.pm * 256 + wr * 64 + fr, pn = u.pn;
        if (pn < 4) {
            bf16* dst = pn < 2 ? QR : KR; const float sc = pn < 2 ? 1.0f : KR_SCALE;
            const int head = 2 * (pn & 1) + (wc >> 1), i0 = (wc & 1) * 32 + 8 * fq;
#pragma unroll
            for (int ai = 0; ai < 2; ++ai)
#pragma unroll
                for (int m = 0; m < 4; ++m) {
                    const int row = row0 + ai * 128 + m * 16;
                    const f32x2* cs = R128 + (size_t)row_pos(row) * 64 + i0;
                    float o1[8], o2[8];
#pragma unroll
                    for (int n = 0; n < 2; ++n)
#pragma unroll
                        for (int j = 0; j < 4; ++j) { const f32x2 t = cs[4 * n + j]; const float x1 = acc[ai][0][m][n][j], x2 = acc[ai][1][m][n][j];
                            o1[4 * n + j] = (x1 * t.x - x2 * t.y) * sc; o2[4 * n + j] = (x1 * t.y + x2 * t.x) * sc; }
                    v4u w1, w2;
                    w1.x = pk2(o1[0], o1[1]); w1.y = pk2(o1[2], o1[3]); w1.z = pk2(o1[4], o1[5]); w1.w = pk2(o1[6], o1[7]);
                    w2.x = pk2(o2[0], o2[1]); w2.y = pk2(o2[2], o2[3]); w2.z = pk2(o2[4], o2[5]); w2.w = pk2(o2[6], o2[7]);
                    bf16* p = dst + (size_t)row * 512 + head * 128 + i0;
                    *(v4u*)p = w1; *(v4u*)(p + 64) = w2;
                    asm volatile("" ::: "memory");
                }
        } else if (pn < 8) {
            bf16* dst = pn < 6 ? VR : GS; const bool act = pn >= 6;
            const int cb = (pn & 1) * 256 + wc * 32 + 8 * fq;
#pragma unroll
            for (int ai = 0; ai < 2; ++ai)
#pragma unroll
                for (int m = 0; m < 4; ++m) {
                    const int row = row0 + ai * 128 + m * 16;
#pragma unroll
                    for (int bj = 0; bj < 2; ++bj) {
                        pg8::f32x4 v0 = acc[ai][bj][m][0], v1 = acc[ai][bj][m][1];
                        if (act) {
#pragma unroll
                            for (int j = 0; j < 4; ++j) { v0[j] = siluf(v0[j]); v1[j] = siluf(v1[j]); } }
                        v4u w; w.x = pk2(v0[0], v0[1]); w.y = pk2(v0[2], v0[3]); w.z = pk2(v1[0], v1[1]); w.w = pk2(v1[2], v1[3]);
                        *(v4u*)(dst + (size_t)row * 512 + cb + bj * 128) = w;
                    }
                }
        } else {
            const int cb = (pn - 8) * 256 + wc * 32 + 8 * fq;
#pragma unroll
            for (int ai = 0; ai < 2; ++ai)
#pragma unroll
                for (int m = 0; m < 4; ++m) {
                    const int row = row0 + ai * 128 + m * 16;
#pragma unroll
                    for (int bj = 0; bj < 2; ++bj) {
                        float* p = P2 + (size_t)row * 512 + cb + bj * 128;
                        const pg8::f32x4 v0 = acc[ai][bj][m][0], v1 = acc[ai][bj][m][1];
                        *(f32x4*)p = (f32x4){v0[0], v0[1], v0[2], v0[3]}; *(f32x4*)(p + 4) = (f32x4){v1[0], v1[1], v1[2], v1[3]};
                    }
                }
        }
    }
};
struct EpiUq {
    static constexpr bool PERM = true, AFTER_DRAIN = false;
    bf16* QA; const f32x2* R64;
    __device__ __forceinline__ void operator()(const pg8::f32x4 (&acc)[2][2][4][2], const pg8::Unit& u, int wr, int wc, int fr, int fq) const {
        asm volatile("" : "+v"(fr), "+v"(fq));
        const int row0 = u.pm * 256 + wr * 64 + fr, pn = u.pn;
        if (pn < 2) {
#pragma unroll
            for (int ai = 0; ai < 2; ++ai)
#pragma unroll
                for (int m = 0; m < 4; ++m) {
                    const int row = row0 + ai * 128 + m * 16;
#pragma unroll
                    for (int bj = 0; bj < 2; ++bj) {
                        const pg8::f32x4 v0 = acc[ai][bj][m][0] * SM_SCALE, v1 = acc[ai][bj][m][1] * SM_SCALE;
                        v4u w; w.x = pk2(v0[0], v0[1]); w.y = pk2(v0[2], v0[3]); w.z = pk2(v1[0], v1[1]); w.w = pk2(v1[2], v1[3]);
                        *(v4u*)(QA + (size_t)row * NQA + (2 * pn + bj) * KVW + wc * 32 + 8 * fq) = w;
                    }
                }
        } else {
            const int head = wc, i0 = 8 * fq;
#pragma unroll
            for (int ai = 0; ai < 2; ++ai)
#pragma unroll
                for (int m = 0; m < 4; ++m) {
                    const int row = row0 + ai * 128 + m * 16;
                    const f32x2* cs = R64 + (size_t)row_pos(row) * 32 + i0;
                    float o1[8], o2[8];
#pragma unroll
                    for (int n = 0; n < 2; ++n)
#pragma unroll
                        for (int j = 0; j < 4; ++j) { const f32x2 t = cs[4 * n + j]; const float x1 = acc[ai][0][m][n][j], x2 = acc[ai][1][m][n][j];
                            o1[4 * n + j] = (x1 * t.x - x2 * t.y) * SM_SCALE; o2[4 * n + j] = (x1 * t.y + x2 * t.x) * SM_SCALE; }
                    v4u w1, w2;
                    w1.x = pk2(o1[0], o1[1]); w1.y = pk2(o1[2], o1[3]); w1.z = pk2(o1[4], o1[5]); w1.w = pk2(o1[6], o1[7]);
                    w2.x = pk2(o2[0], o2[1]); w2.y = pk2(o2[2], o2[3]); w2.z = pk2(o2[4], o2[5]); w2.w = pk2(o2[6], o2[7]);
                    bf16* p = QA + (size_t)row * NQA + head * KVW + 128 + i0;
                    *(v4u*)p = w1; *(v4u*)(p + 32) = w2;
                    asm volatile("" ::: "memory");
                }
        }
    }
};

__device__ __forceinline__ int src_col(int mat, int n) {
    if (mat == 0) { const int pn = n >> 8, bj = (n >> 7) & 1, i = n & 127; return bj * FF + 128 * pn + i; }
    if (mat == 2) {
        if (n < 1024) { const int pn = n >> 8, bj = (n >> 7) & 1, ip = n & 127, hh = ip >> 6, i = ip & 63; return (pn >> 1) * 512 + (2 * (pn & 1) + hh) * 128 + 64 * bj + i; }
        return n < DIN ? n : -1; }
    if (mat == 3) { const int bj = n >> 7, ip = n & 127, head = ip >> 5, i = ip & 31; return head * KVW + 128 + 32 * bj + i; }
    return n;
}
__device__ __forceinline__ void transpose_item(const float* __restrict__ W, int srcN, bf16* WT, int dstPitch, int dstRowOff, int mat, int k0, int n0, LAS float* scr, int lane) {
    const int sc = src_col(mat, n0 + (lane & 31));
#pragma unroll 8
    for (int i = 0; i < 32; ++i) { const int kk = 2 * i + (lane >> 5); scr[kk * 33 + (lane & 31)] = sc >= 0 ? W[(size_t)(k0 + kk) * srcN + sc] : 0.f; }
    LDS_WAIT();
    const int c = lane & 7;
#pragma unroll
    for (int j = 0; j < 4; ++j) { const int n = (lane >> 3) + 8 * j; const LAS float* s = scr + (8 * c) * 33 + n;
        v4u o; o.x = pk2(s[0 * 33], s[1 * 33]); o.y = pk2(s[2 * 33], s[3 * 33]); o.z = pk2(s[4 * 33], s[5 * 33]); o.w = pk2(s[6 * 33], s[7 * 33]);
        *(v4u*)(WT + (size_t)(dstRowOff + n0 + n) * dstPitch + k0 + 8 * c) = o; }
    LDS_WAIT();
}
__device__ __forceinline__ void transpose_matrix(const float* W, int Kdim, int srcN, bf16* WT, int Ndst, int dstPitch, int dstRowOff, int mat, LAS float* scr, int gw, int NGW, int lane) {
    const int nblk = Ndst / 32, nitems = (Kdim / 64) * nblk;
    for (int it = gw; it < nitems; it += NGW) transpose_item(W, srcN, WT, dstPitch, dstRowOff, mat, 64 * (it / nblk), 32 * (it % nblk), scr, lane);
}
__device__ __forceinline__ void sincos_acc(float ang, float& sn, float& cs) {
    const double x = (double)ang; const double kq = __builtin_rint(x * 0.63661977236758134308);
    const double r = (x - kq * 1.57079632679489655800e+00) - kq * 6.12323399573676603587e-17;
    const double r2 = r * r;
    const double s = r * (1.0 + r2 * (-1.0 / 6 + r2 * (1.0 / 120 + r2 * (-1.0 / 5040 + r2 * (1.0 / 362880 + r2 * (-1.0 / 39916800 + r2 * (1.0 / 6227020800.0)))))));
    const double c = 1.0 + r2 * (-0.5 + r2 * (1.0 / 24 + r2 * (-1.0 / 720 + r2 * (1.0 / 40320 + r2 * (-1.0 / 3628800 + r2 * (1.0 / 479001600 + r2 * (-1.0 / 87178291200.0)))))));
    const int q = (int)((long long)kq & 3);
    const double ss = (q == 0) ? s : (q == 1) ? c : (q == 2) ? -s : -c;
    const double cc = (q == 0) ? c : (q == 1) ? -s : (q == 2) ? -c : s;
    sn = (float)ss; cs = (float)cc;
}

template <bool FINAL> __device__ __forceinline__ void ln_rows(const Args& a, const float* Z, const float* g, const float* b, bf16* outB, int gw, int NGW, int lane) {
    f32x4 gv[4], bv[4];
#pragma unroll
    for (int j = 0; j < 4; ++j) { gv[j] = *(const f32x4*)(g + 4 * lane + 256 * j); bv[j] = *(const f32x4*)(b + 4 * lane + 256 * j); }
    for (int r = gw; r < (FINAL ? R_VALID : MTOT); r += NGW) {
        if (FINAL && r < R_PROMPT) continue;
        const f32x4* zr = (const f32x4*)(Z + (size_t)r * DM) + lane;
        f32x4 v[4]; float s = 0.f;
#pragma unroll
        for (int j = 0; j < 4; ++j) { v[j] = zr[64 * j]; s += (v[j].x + v[j].y) + (v[j].z + v[j].w); }
        const float mean = wave_sum(s) * (1.f / DM); float s2 = 0.f;
#pragma unroll
        for (int j = 0; j < 4; ++j) { v[j] = v[j] - mean; s2 += (v[j].x * v[j].x + v[j].y * v[j].y) + (v[j].z * v[j].z + v[j].w * v[j].w); }
        const float rstd = 1.0f / sqrtf(wave_sum(s2) * (1.f / DM) + LN_EPS);
        if (FINAL) {
            float* o = a.out + (r < R_SAMPLE ? O_YP + (size_t)(r - R_PROMPT) * DM : O_YS + (size_t)(r - R_SAMPLE) * DM);
#pragma unroll
            for (int j = 0; j < 4; ++j) *((f32x4*)o + lane + 64 * j) = v[j] * rstd * gv[j] + bv[j];
        } else {
            v2u* o = (v2u*)(outB + (size_t)r * DM) + lane;
#pragma unroll
            for (int j = 0; j < 4; ++j) { const f32x4 y = v[j] * rstd * gv[j] + bv[j]; v2u w; w.x = pk2(y.x, y.y); w.y = pk2(y.z, y.w); o[64 * j] = w; }
        }
    }
}

__device__ __forceinline__ void post_rows(const Args& a, int gw, int NGW, int lane) {
    unsigned char* ws = a.ws;
    const float* P2 = (const float*)(ws + WS_P2RAW); bf16* CQB = (bf16*)(ws + WS_CQB); bf16* KVB = (bf16*)(ws + WS_KVB); bf16* CKVT = (bf16*)(ws + WS_CKVT);
    const f32x2* R64 = (const f32x2*)(ws + WS_R64);
    const f32x4 gq = *(const f32x4*)(a.in[12] + 4 * lane);
    const float gk0 = a.in[14][lane], gk1 = a.in[14][64 + lane];
    for (int it = gw; it < MTOT / 8; it += NGW) {
        float t0[8], t1[8];
#pragma unroll
        for (int rr = 0; rr < 8; ++rr) {
            const int row = 8 * it + rr; const float* p = P2 + (size_t)row * 512;
            const f32x4 cq = *(const f32x4*)(p + 4 * lane);
            const float c0 = p[256 + lane], c1 = p[320 + lane];
            const float k1 = p[384 + (lane & 31)], k2 = p[416 + (lane & 31)];
            const float ssq = wave_sum((cq.x * cq.x + cq.y * cq.y) + (cq.z * cq.z + cq.w * cq.w));
            const float ssk = wave_sum(c0 * c0 + c1 * c1);
            const float rq = 1.0f / sqrtf(ssq * (1.f / 256) + RMS_EPS), rk = 1.0f / sqrtf(ssk * (1.f / 128) + RMS_EPS);
            v2u w; w.x = pk2(cq.x * rq * gq.x, cq.y * rq * gq.y); w.y = pk2(cq.z * rq * gq.z, cq.w * rq * gq.w);
            *((v2u*)(CQB + (size_t)row * 256) + lane) = w;
            const float v0 = c0 * rk * gk0, v1 = c1 * rk * gk1;
            t0[rr] = v0; t1[rr] = v1;
            const f32x2 cs = R64[(size_t)row_pos(row) * 32 + (lane & 31)];
            const float kp = lane < 32 ? k1 * cs.x - k2 * cs.y : k1 * cs.y + k2 * cs.x;
            KVB[(size_t)row * KVW + lane] = (bf16)f2bf(v0); KVB[(size_t)row * KVW + 64 + lane] = (bf16)f2bf(v1); KVB[(size_t)row * KVW + 128 + lane] = (bf16)f2bf(kp);
            if (row < R_PROMPT) {
#pragma unroll
                for (int b = 0; b < NB; ++b) { float* oc = a.out + O_PCKV + ((size_t)b * LP + row) * 128; oc[lane] = v0; oc[64 + lane] = v1; a.out[O_PKPE + ((size_t)b * LP + row) * 64 + lane] = kp; }
            } else if (row < R_SAMPLE) {
                const int b = (row - R_PROMPT) >> 12, s = (row - R_PROMPT) & (SEQ - 1);
                float* oc = a.out + O_PCKV + ((size_t)b * LP + NMETA + s) * 128; oc[lane] = v0; oc[64 + lane] = v1; a.out[O_PKPE + ((size_t)b * LP + NMETA + s) * 64 + lane] = kp;
            } else if (row < R_VALID) {
                float* oc = a.out + O_SCKV + (size_t)(row - R_SAMPLE) * 128; oc[lane] = v0; oc[64 + lane] = v1; a.out[O_SKPE + (size_t)(row - R_SAMPLE) * 64 + lane] = kp;
            }
        }
        v4u w0, w1;
        w0.x = pk2(t0[0], t0[1]); w0.y = pk2(t0[2], t0[3]); w0.z = pk2(t0[4], t0[5]); w0.w = pk2(t0[6], t0[7]);
        w1.x = pk2(t1[0], t1[1]); w1.y = pk2(t1[2], t1[3]); w1.z = pk2(t1[4], t1[5]); w1.w = pk2(t1[6], t1[7]);
        *(v4u*)(CKVT + (size_t)lane * MTOT + 8 * it) = w0; *(v4u*)(CKVT + (size_t)(64 + lane) * MTOT + 8 * it) = w1;
    }
    bf16* KVC = (bf16*)(ws + WS_KVC); bf16* KVCT = (bf16*)(ws + WS_KVCT);
    for (int it = gw; it < DBS * PAST / 8; it += NGW) {
        const int db = it >> 7, p0 = (it & 127) * 8;
        float t0[8], t1[8];
#pragma unroll
        for (int rr = 0; rr < 8; ++rr) {
            const size_t r = (size_t)db * PAST + p0 + rr;
            const float v0 = a.in[2][r * 128 + lane], v1 = a.in[2][r * 128 + 64 + lane], kp = a.in[3][r * 64 + lane];
            t0[rr] = v0; t1[rr] = v1;
            KVC[r * KVW + lane] = (bf16)f2bf(v0); KVC[r * KVW + 64 + lane] = (bf16)f2bf(v1); KVC[r * KVW + 128 + lane] = (bf16)f2bf(kp);
        }
        v4u w0, w1;
        w0.x = pk2(t0[0], t0[1]); w0.y = pk2(t0[2], t0[3]); w0.z = pk2(t0[4], t0[5]); w0.w = pk2(t0[6], t0[7]);
        w1.x = pk2(t1[0], t1[1]); w1.y = pk2(t1[2], t1[3]); w1.z = pk2(t1[4], t1[5]); w1.w = pk2(t1[6], t1[7]);
        *(v4u*)(KVCT + ((size_t)db * 128 + lane) * PAST + p0) = w0; *(v4u*)(KVCT + ((size_t)db * 128 + 64 + lane) * PAST + p0) = w1;
    }
}

__device__ __forceinline__ int crow(int r, int hi) { return (r & 3) + 8 * (r >> 2) + 4 * hi; }
#define PK4(P, BASE, OUT) do { unsigned a0_ = pk2(P[BASE + 0], P[BASE + 1]), a1_ = pk2(P[BASE + 2], P[BASE + 3]);   \
    unsigned b0_ = pk2(P[BASE + 4], P[BASE + 5]), b1_ = pk2(P[BASE + 6], P[BASE + 7]);                              \
    auto r0_ = __builtin_amdgcn_permlane32_swap(a0_, b0_, false, false); auto r1_ = __builtin_amdgcn_permlane32_swap(a1_, b1_, false, false); \
    v4u w_ = {r0_[0], r1_[0], r0_[1], r1_[1]}; OUT = __builtin_bit_cast(bf16x8, w_); } while (0)
__device__ __forceinline__ float half_swap_max(float x) { auto rr = __builtin_amdgcn_permlane32_swap(__float_as_uint(x), __float_as_uint(x), false, false); return fmaxf(__uint_as_float(rr[0]), __uint_as_float(rr[1])); }
__device__ __forceinline__ float half_swap_sum(float x) { auto rr = __builtin_amdgcn_permlane32_swap(__float_as_uint(x), __float_as_uint(x), false, false); return __uint_as_float(rr[0]) + __uint_as_float(rr[1]); }

__device__ __forceinline__ void attn_wave(const Args& a, int type, int bi, int c, int h, int qhalf, int lane) {
    asm volatile("" : "+v"(lane));
    unsigned char* ws = a.ws;
    const bf16* QA = (const bf16*)(ws + WS_QA); const bf16* KVB = (const bf16*)(ws + WS_KVB); const bf16* CKVT = (const bf16*)(ws + WS_CKVT);
    const bf16* KVC = (const bf16*)(ws + WS_KVC); const bf16* KVCT = (const bf16*)(ws + WS_KVCT); bf16* MIXA = (bf16*)(ws + WS_A16A);
    const int r32 = lane & 31, hi = lane >> 5;
    int qrow0, nq, nt;
    if (type == 0) { qrow0 = R_PROMPT + bi * SEQ + 64 * c + 32 * qhalf; nq = 32; nt = c + 2; }
    else if (type == 1) { qrow0 = R_SAMPLE + TS * bi; nq = 32; nt = 18; }
    else { qrow0 = 0; nq = 16; nt = 1; }
    bf16x8 qr[12];
    { const bf16* qp = QA + (size_t)(qrow0 + r32) * NQA + h * KVW + hi * 8;
#pragma unroll
      for (int d0 = 0; d0 < 12; ++d0) qr[d0] = *(const bf16x8*)(qp + d0 * 16); }
    f32x16 o[4];
#pragma unroll
    for (int d = 0; d < 4; ++d)
#pragma unroll
        for (int r = 0; r < 16; ++r) o[d][r] = 0.f;
    float m_reg = -1e30f, l_reg = 0.f;
    for (int t = 0; t < nt; ++t) {
        const bf16* Kb; const bf16* Vb; int vpitch, nvalid;
        if (t == 0) { Kb = KVB; Vb = CKVT; vpitch = MTOT; nvalid = NMETA; }
        else if (type == 0) { const int row0 = R_PROMPT + bi * SEQ + 64 * (t - 1); Kb = KVB + (size_t)row0 * KVW; Vb = CKVT + row0; vpitch = MTOT; nvalid = 64; }
        else if (t <= 16) { Kb = KVC + ((size_t)bi * PAST + 64 * (t - 1)) * KVW; Vb = KVCT + (size_t)bi * 128 * PAST + 64 * (t - 1); vpitch = PAST; nvalid = 64; }
        else { const int row0 = R_SAMPLE + TS * bi; Kb = KVB + (size_t)row0 * KVW; Vb = CKVT + row0; vpitch = MTOT; nvalid = TS; }
        f32x16 p0, p1;
#pragma unroll
        for (int r = 0; r < 16; ++r) { p0[r] = 0.f; p1[r] = 0.f; }
        const bf16* kp0 = Kb + (size_t)r32 * KVW + hi * 8; const bf16* kp1 = kp0 + 32 * KVW;
#pragma unroll
        for (int d0 = 0; d0 < 12; ++d0) {
            const bf16x8 k0 = *(const bf16x8*)(kp0 + d0 * 16), k1 = *(const bf16x8*)(kp1 + d0 * 16);
            p0 = __builtin_amdgcn_mfma_f32_32x32x16_bf16(k0, qr[d0], p0, 0, 0, 0);
            p1 = __builtin_amdgcn_mfma_f32_32x32x16_bf16(k1, qr[d0], p1, 0, 0, 0);
            if ((d0 & 3) == 3) asm volatile("" ::: "memory");
        }
        if (nvalid < 64) {
#pragma unroll
            for (int r = 0; r < 16; ++r) { const int key = crow(r, hi); if (key >= nvalid) p0[r] = -1e30f; if (key + 32 >= nvalid) p1[r] = -1e30f; }
        }
        float pmax = p0[0];
#pragma unroll
        for (int r = 1; r < 16; ++r) pmax = fmaxf(pmax, p0[r]);
#pragma unroll
        for (int r = 0; r < 16; ++r) pmax = fmaxf(pmax, p1[r]);
        pmax = half_swap_max(pmax);
        const float mn = fmaxf(m_reg, pmax), alpha = __builtin_amdgcn_exp2f((m_reg - mn) * LOG2E); m_reg = mn;
        const float mnC = -mn * LOG2E; float ps = 0.f;
#pragma unroll
        for (int r = 0; r < 16; ++r) { p0[r] = __builtin_amdgcn_exp2f(fmaf(p0[r], LOG2E, mnC)); p1[r] = __builtin_amdgcn_exp2f(fmaf(p1[r], LOG2E, mnC)); ps += p0[r] + p1[r]; }
        ps = half_swap_sum(ps);
        l_reg = l_reg * alpha + ps;
        if (__any(alpha < 1.f)) {
#pragma unroll
            for (int r = 0; r < 16; ++r) { const float ar = __shfl(alpha, crow(r, hi));
#pragma unroll
                for (int d = 0; d < 4; ++d) o[d][r] *= ar; }
        }
        bf16x8 pa0, pa1, pa2, pa3;
        PK4(p0, 0, pa0); PK4(p0, 8, pa1); PK4(p1, 0, pa2); PK4(p1, 8, pa3);
#pragma unroll
        for (int d0 = 0; d0 < 4; ++d0) {
            const bf16* vp = Vb + (size_t)(32 * d0 + r32) * vpitch + 8 * hi;
            const bf16x8 v0 = *(const bf16x8*)(vp), v1 = *(const bf16x8*)(vp + 16), v2 = *(const bf16x8*)(vp + 32), v3 = *(const bf16x8*)(vp + 48);
            o[d0] = __builtin_amdgcn_mfma_f32_32x32x16_bf16(pa0, v0, o[d0], 0, 0, 0);
            o[d0] = __builtin_amdgcn_mfma_f32_32x32x16_bf16(pa1, v1, o[d0], 0, 0, 0);
            o[d0] = __builtin_amdgcn_mfma_f32_32x32x16_bf16(pa2, v2, o[d0], 0, 0, 0);
            o[d0] = __builtin_amdgcn_mfma_f32_32x32x16_bf16(pa3, v3, o[d0], 0, 0, 0);
            asm volatile("" ::: "memory");
        }
    }
    const float rl = __builtin_amdgcn_rcpf(l_reg);
#pragma unroll
    for (int r = 0; r < 16; ++r) { const int qr_ = crow(r, hi); const float rr = __shfl(rl, qr_);
        if (qr_ < nq) {
            bf16* op = MIXA + (size_t)(qrow0 + qr_) * DM + 512 + h * 128 + r32;
#pragma unroll
            for (int d0 = 0; d0 < 4; ++d0) op[32 * d0] = (bf16)f2bf(o[d0][r] * rr);
        } }
}

struct RetItem { int kind, bh, n; };
__device__ __forceinline__ void ret_geom(const RetItem& it, int& h, int& rowbase, int& tlo, int& thi, int& T) {
    if (it.kind == 0) { h = it.bh; rowbase = -48; tlo = 48; thi = 64; T = 64; }
    else if (it.kind == 1) { h = it.bh & 3; rowbase = R_PROMPT + (it.bh >> 2) * SEQ + 64 * (it.n - 1); tlo = 0; thi = 64; T = 64; }
    else { h = it.bh & 3; rowbase = R_SAMPLE + TS * (it.bh >> 2); tlo = 0; thi = TS; T = TS; }
}
__device__ __forceinline__ int kvn_index(const RetItem& it) { return it.kind == 0 ? it.bh : 4 + it.bh * 64 + (it.n - 1); }
__device__ __forceinline__ bf16x8 col_frag(const bf16* X, int rowbase, int col, int t0, int tlo, int thi, bool decay, float lg2, int T) {
    unsigned w[4];
#pragma unroll
    for (int j = 0; j < 8; j += 2) {
        float v[2];
#pragma unroll
        for (int q = 0; q < 2; ++q) { const int t = t0 + j + q; float x = 0.f;
            if (t >= tlo && t < thi) { x = bf2f(X[(size_t)(rowbase + t) * 512 + col]); if (decay) x *= __builtin_amdgcn_exp2f(lg2 * (float)(T - 1 - t)); }
            v[q] = x; }
        w[j >> 1] = pk2(v[0], v[1]);
    }
    v4u ww = {w[0], w[1], w[2], w[3]}; return __builtin_bit_cast(bf16x8, ww);
}
__device__ __forceinline__ void ret_kv_wave(const Args& a, const RetItem& it, int w, int lane) {
    asm volatile("" : "+v"(lane));
    unsigned char* ws = a.ws;
    const bf16* KR = (const bf16*)(ws + WS_KR); const bf16* VR = (const bf16*)(ws + WS_VR); bf16* KVN = (bf16*)(ws + WS_KVN);
    int h, rowbase, tlo, thi, T; ret_geom(it, h, rowbase, tlo, thi, T);
    const float lg2 = lg2gamma(h); const int r32 = lane & 31, hi = lane >> 5, ib = w >> 1, jb0 = 2 * (w & 1);
    f32x16 c0, c1;
#pragma unroll
    for (int r = 0; r < 16; ++r) { c0[r] = 0.f; c1[r] = 0.f; }
    for (int ks = tlo >> 4; ks < (thi + 15) >> 4; ++ks) {
        const int t0 = 16 * ks + 8 * hi;
        const bf16x8 af = col_frag(KR, rowbase, h * 128 + 32 * ib + r32, t0, tlo, thi, false, 0.f, T);
        const bf16x8 b0 = col_frag(VR, rowbase, h * 128 + 32 * jb0 + r32, t0, tlo, thi, true, lg2, T);
        const bf16x8 b1 = col_frag(VR, rowbase, h * 128 + 32 * (jb0 + 1) + r32, t0, tlo, thi, true, lg2, T);
        c0 = __builtin_amdgcn_mfma_f32_32x32x16_bf16(af, b0, c0, 0, 0, 0);
        c1 = __builtin_amdgcn_mfma_f32_32x32x16_bf16(af, b1, c1, 0, 0, 0);
    }
    if (it.kind != 2) {
        bf16* dst = KVN + (size_t)kvn_index(it) * 16384;
#pragma unroll
        for (int rg = 0; rg < 4; ++rg) { const int dk0 = 32 * ib + 8 * rg + 4 * hi;
            v2u w0; w0.x = pk2(c0[4 * rg], c0[4 * rg + 1]); w0.y = pk2(c0[4 * rg + 2], c0[4 * rg + 3]);
            v2u w1; w1.x = pk2(c1[4 * rg], c1[4 * rg + 1]); w1.y = pk2(c1[4 * rg + 2], c1[4 * rg + 3]);
            *(v2u*)(dst + (size_t)(32 * jb0 + r32) * 128 + dk0) = w0; *(v2u*)(dst + (size_t)(32 * (jb0 + 1) + r32) * 128 + dk0) = w1; }
    } else {
        const float dec = __builtin_amdgcn_exp2f(lg2 * (float)T);
        const float* s0 = a.in[4] + (size_t)it.bh * 16384; float* so = a.out + O_SST + (size_t)it.bh * 16384;
#pragma unroll
        for (int r = 0; r < 16; ++r) { const size_t e = (size_t)(32 * ib + crow(r, hi)) * 128 + 32 * jb0 + r32;
            so[e] = dec * s0[e] + c0[r]; so[e + 32] = dec * s0[e + 32] + c1[r]; }
    }
}
__device__ __forceinline__ void ret_out_wave(const Args& a, const RetItem& it, int qhalf, int lane) {
    asm volatile("" : "+v"(lane));
    unsigned char* ws = a.ws;
    const bf16* QR = (const bf16*)(ws + WS_QR); const bf16* KR = (const bf16*)(ws + WS_KR); const bf16* VR = (const bf16*)(ws + WS_VR); const bf16* GS = (const bf16*)(ws + WS_GS);
    const bf16* KVN = (const bf16*)(ws + WS_KVN); bf16* MIXA = (bf16*)(ws + WS_A16A);
    int h, rowbase, tlo, thi, T; ret_geom(it, h, rowbase, tlo, thi, T);
    const float lg2 = lg2gamma(h); const int r32 = lane & 31, hi = lane >> 5;
    const int tq = 32 * qhalf + r32; const bool qv = tq >= tlo && tq < thi;
    bf16x8 qr[8];
    { const bf16* qp = QR + (size_t)(rowbase + tq) * 512 + h * 128 + hi * 8;
#pragma unroll
      for (int d0 = 0; d0 < 8; ++d0) qr[d0] = qv ? *(const bf16x8*)(qp + d0 * 16) : (bf16x8){0, 0, 0, 0, 0, 0, 0, 0}; }
    f32x16 o[4];
#pragma unroll
    for (int d = 0; d < 4; ++d)
#pragma unroll
        for (int r = 0; r < 16; ++r) o[d][r] = 0.f;
    if (it.kind == 1) {
        const bf16* st = KVN + (size_t)kvn_index(it) * 16384;
#pragma unroll
        for (int d0 = 0; d0 < 4; ++d0) { const bf16* sp = st + (size_t)(32 * d0 + r32) * 128 + 8 * hi;
#pragma unroll
            for (int kd = 0; kd < 8; ++kd) o[d0] = __builtin_amdgcn_mfma_f32_32x32x16_bf16(qr[kd], *(const bf16x8*)(sp + 16 * kd), o[d0], 0, 0, 0);
            asm volatile("" ::: "memory"); }
    } else if (it.kind == 2) {
        const float* s0 = a.in[4] + (size_t)it.bh * 16384;
#pragma unroll
        for (int d0 = 0; d0 < 4; ++d0)
#pragma unroll
            for (int kd = 0; kd < 8; ++kd) { const float* sp = s0 + (size_t)(16 * kd + 8 * hi) * 128 + 32 * d0 + r32;
                v4u ww = {pk2(sp[0], sp[128]), pk2(sp[256], sp[384]), pk2(sp[512], sp[640]), pk2(sp[768], sp[896])};
                o[d0] = __builtin_amdgcn_mfma_f32_32x32x16_bf16(qr[kd], __builtin_bit_cast(bf16x8, ww), o[d0], 0, 0, 0); asm volatile("" ::: "memory"); }
    }
    if (it.kind != 0) {
#pragma unroll
        for (int r = 0; r < 16; ++r) { const float qd = __builtin_amdgcn_exp2f(lg2 * (float)(32 * qhalf + crow(r, hi) + 1));
#pragma unroll
            for (int d = 0; d < 4; ++d) o[d][r] *= qd; }
    }
    f32x16 p0, p1;
#pragma unroll
    for (int r = 0; r < 16; ++r) { p0[r] = 0.f; p1[r] = 0.f; }
    { const bool k0v = r32 >= tlo && r32 < thi, k1v = 32 + r32 >= tlo && 32 + r32 < thi;
      const bf16* kp0 = KR + (size_t)(rowbase + r32) * 512 + h * 128 + hi * 8; const bf16* kp1 = kp0 + 32 * 512;
#pragma unroll
      for (int d0 = 0; d0 < 8; ++d0) {
          const bf16x8 z = {0, 0, 0, 0, 0, 0, 0, 0};
          const bf16x8 k0 = k0v ? *(const bf16x8*)(kp0 + d0 * 16) : z, k1 = k1v ? *(const bf16x8*)(kp1 + d0 * 16) : z;
          p0 = __builtin_amdgcn_mfma_f32_32x32x16_bf16(k0, qr[d0], p0, 0, 0, 0);
          p1 = __builtin_amdgcn_mfma_f32_32x32x16_bf16(k1, qr[d0], p1, 0, 0, 0);
          if ((d0 & 3) == 3) asm volatile("" ::: "memory");
      } }
#pragma unroll
    for (int r = 0; r < 16; ++r) { const int k0 = crow(r, hi), k1 = k0 + 32;
        p0[r] = tq >= k0 ? p0[r] * __builtin_amdgcn_exp2f(lg2 * (float)(tq - k0)) : 0.f;
        p1[r] = tq >= k1 ? p1[r] * __builtin_amdgcn_exp2f(lg2 * (float)(tq - k1)) : 0.f; }
    bf16x8 pa0, pa1, pa2, pa3;
    PK4(p0, 0, pa0); PK4(p0, 8, pa1); PK4(p1, 0, pa2); PK4(p1, 8, pa3);
#pragma unroll
    for (int d0 = 0; d0 < 4; ++d0) {
        const int col = h * 128 + 32 * d0 + r32;
        o[d0] = __builtin_amdgcn_mfma_f32_32x32x16_bf16(pa0, col_frag(VR, rowbase, col, 0 + 8 * hi, tlo, thi, false, 0.f, T), o[d0], 0, 0, 0);
        o[d0] = __builtin_amdgcn_mfma_f32_32x32x16_bf16(pa1, col_frag(VR, rowbase, col, 16 + 8 * hi, tlo, thi, false, 0.f, T), o[d0], 0, 0, 0);
        asm volatile("" ::: "memory");
        if (thi > 32) {
            o[d0] = __builtin_amdgcn_mfma_f32_32x32x16_bf16(pa2, col_frag(VR, rowbase, col, 32 + 8 * hi, tlo, thi, false, 0.f, T), o[d0], 0, 0, 0);
            o[d0] = __builtin_amdgcn_mfma_f32_32x32x16_bf16(pa3, col_frag(VR, rowbase, col, 48 + 8 * hi, tlo, thi, false, 0.f, T), o[d0], 0, 0, 0);
        }
        asm volatile("" ::: "memory");
    }
    const float* gn = a.in[11] + h * 128;
    float gg[4];
#pragma unroll
    for (int d = 0; d < 4; ++d) gg[d] = gn[32 * d + r32];
#pragma unroll
    for (int r = 0; r < 16; ++r) {
        float s = (o[0][r] + o[1][r]) + (o[2][r] + o[3][r]);
#pragma unroll
        for (int off = 1; off < 32; off <<= 1) s += __shfl_xor(s, off);
        const float mean = s * (1.f / 128);
        float q = 0.f;
#pragma unroll
        for (int d = 0; d < 4; ++d) { const float dd = o[d][r] - mean; q += dd * dd; }
#pragma unroll
        for (int off = 1; off < 32; off <<= 1) q += __shfl_xor(q, off);
        const float rstd = 1.0f / sqrtf(q * (1.f / 128) + LN_EPS);
        const int t = 32 * qhalf + crow(r, hi);
        if (t >= tlo && t < thi) {
            const size_t rb = (size_t)(rowbase + t);
#pragma unroll
            for (int d = 0; d < 4; ++d) { const float gate = bf2f(GS[rb * 512 + h * 128 + 32 * d + r32]);
                MIXA[rb * DM + h * 128 + 32 * d + r32] = (bf16)f2bf((o[d][r] - mean) * rstd * gg[d] * gate); }
        }
    }
}


__device__ __forceinline__ void ret_scan(const Args& a, int gtid, int gthreads) {
    unsigned* KVN = (unsigned*)(a.ws + WS_KVN);
    for (int g = gtid; g < NB * 4 * 8192; g += gthreads) {
        const int bh = g >> 13, e2 = g & 8191, h = bh & 3;
        const float dec = __builtin_amdgcn_exp2f(lg2gamma(h) * 64.f);
        const unsigned w0 = KVN[(size_t)h * 8192 + e2];
        float s0 = bflo(w0), s1 = bfhi(w0);
        unsigned* p = KVN + (size_t)(4 + bh * 64) * 8192 + e2;
#pragma unroll 16
        for (int n = 0; n < 64; ++n) { const unsigned kv = p[(size_t)n * 8192]; p[(size_t)n * 8192] = pk2(s0, s1); s0 = dec * s0 + bflo(kv); s1 = dec * s1 + bfhi(kv); }
        const int dv = e2 >> 6, dk = (e2 & 63) * 2;
        float* so = a.out + O_PST + (size_t)bh * 16384;
        so[(size_t)dk * 128 + dv] = s0; so[(size_t)(dk + 1) * 128 + dv] = s1;
    }
}

constexpr int NWAVES = 8, LDS_BYTES = 147456, RING_BYTES = 131072, MISC_OFF = RING_BYTES + 320;

__global__ void __launch_bounds__(NWAVES * 64, 2) fwd_mega(Args a) {
    extern __shared__ __attribute__((aligned(16))) unsigned char lds[];
    LAS unsigned char* L = (LAS unsigned char*)lds;
    volatile LAS unsigned* MISC = (volatile LAS unsigned*)(L + MISC_OFF);
    const int tid = threadIdx.x, lane = tid & 63, wave = __builtin_amdgcn_readfirstlane(tid >> 6);
    const int G = gridDim.x, bx = blockIdx.x;
    const int vcu = (G % 8 == 0) ? (bx % 8) * (G / 8) + bx / 8 : bx;
    const int gw = vcu * NWAVES + wave, NGW = G * NWAVES, gtid = vcu * (NWAVES * 64) + tid, gthreads = G * NWAVES * 64;
    unsigned char* ws = a.ws;
    for (int u = tid; u < (LDS_BYTES - RING_BYTES) / 4; u += NWAVES * 64) ((LAS unsigned*)(L + RING_BYTES))[u] = 0u;
    __syncthreads();
    XcdBarrier bar = xcd_barrier_post((unsigned*)(ws + WS_CTL) + CW_BAR, MISC + 8);
#define GRID_BAR() xcd_barrier(bar)
    LAS float* scr = (LAS float*)(L + wave * 16384);

    bf16* WFI = (bf16*)(ws + WS_WFI); bf16* WFO = (bf16*)(ws + WS_WFO); bf16* WMI = (bf16*)(ws + WS_WMI); bf16* WMO = (bf16*)(ws + WS_WMO); bf16* WUQ = (bf16*)(ws + WS_WUQ);
    f32x2* R128 = (f32x2*)(ws + WS_R128); f32x2* R64 = (f32x2*)(ws + WS_R64);
    bf16* A16A = (bf16*)(ws + WS_A16A); bf16* A16B = (bf16*)(ws + WS_A16B); float* Z = (float*)(ws + WS_Z); bf16* HID = (bf16*)(ws + WS_HID);

    {
        transpose_matrix(a.in[6], DM, 2 * FF, WFI, 2 * FF, DM, 0, 0, scr, gw, NGW, lane);
        transpose_matrix(a.in[7], FF, DM, WFO, DM, FF, 0, 1, scr, gw, NGW, lane);
        transpose_matrix(a.in[10], DM, DIN, WMI, DINP, DM, 0, 2, scr, gw, NGW, lane);
        transpose_matrix(a.in[16], 512, DM, WMO, DM, DM, 0, 1, scr, gw, NGW, lane);
        transpose_matrix(a.in[13], 256, NQA, WUQ, 256, 256, 512, 3, scr, gw, NGW, lane);
        const float* wuq = a.in[13]; const float* wukv = a.in[15]; const float* wmo = a.in[16];
        for (int idx = gtid; idx < 512 * 256; idx += gthreads) {
            const int k = idx & 255, np = idx >> 8, head = np >> 7, c = np & 127;
            const f32x4* x = (const f32x4*)(wuq + (size_t)k * NQA + head * KVW); const f32x4* y = (const f32x4*)(wukv + (size_t)c * 1024 + head * 256);
            float s = 0.f;
#pragma unroll 8
            for (int n = 0; n < 32; ++n) { const f32x4 xv = x[n], yv = y[n]; s += (xv.x * yv.x + xv.y * yv.y) + (xv.z * yv.z + xv.w * yv.w); }
            WUQ[(size_t)np * 256 + k] = (bf16)f2bf(s);
        }
        for (int idx = gtid; idx < 1024 * 64; idx += gthreads) {
            const int n = idx & 1023, hc = idx >> 10, head = hc >> 4, c8 = hc & 15;
            float s[8];
#pragma unroll
            for (int j = 0; j < 8; ++j) s[j] = 0.f;
            const float* wm = wmo + (size_t)(512 + head * 128) * DM + n; const float* uk = wukv + (size_t)(c8 * 8) * 1024 + head * 256 + 128;
            for (int v = 0; v < 128; ++v) { const float m = wm[(size_t)v * DM];
#pragma unroll
                for (int j = 0; j < 8; ++j) s[j] += uk[(size_t)j * 1024 + v] * m; }
            v4u w; w.x = pk2(s[0], s[1]); w.y = pk2(s[2], s[3]); w.z = pk2(s[4], s[5]); w.w = pk2(s[6], s[7]);
            *(v4u*)(WMO + (size_t)n * DM + 512 + head * 128 + c8 * 8) = w;
        }
        for (int idx = gtid; idx < LP * 64; idx += gthreads) {
            const int pos = idx >> 6, i = idx & 63;
            const float inv = (float)exp2(-(double)(2 * i) * (13.287712379549449 / 128.0));
            float sn, cs; sincos_acc((float)pos * inv, sn, cs);
            R128[idx] = (f32x2){cs, sn};
            if ((i & 1) == 0) R64[(size_t)pos * 32 + (i >> 1)] = (f32x2){cs, sn};
        }
        for (int r = gw; r < MTOT; r += NGW) {
            const float* xr = x_row(a, r); v2u* o = (v2u*)(A16A + (size_t)r * DM) + lane;
#pragma unroll
            for (int j = 0; j < 4; ++j) { v2u w = {0u, 0u}; if (xr) { const f32x4 v = *((const f32x4*)xr + lane + 64 * j); w.x = pk2(v.x, v.y); w.y = pk2(v.z, v.w); } o[64 * j] = w; }
        }
    }
    GRID_BAR();
#ifndef NO_P1
    { pg8::Gemm g{A16A, WFI, MTOT, 2 * FF, DM}; pg8::StaticOrder S; S.init(MTOT, 2 * FF, G, bx); EpiSwiglu E{HID};
      pg8::gemm_phase<EpiSwiglu, pg8::StaticOrder, true, true>(L, g, S, E); }
#endif
    GRID_BAR();
#ifndef NO_P2
    { pg8::Gemm g{HID, WFO, MTOT, DM, FF}; pg8::StaticOrder S; S.init(MTOT, DM, G, bx); EpiResZ<0> E{Z, nullptr, a, 0.5f};
      pg8::gemm_phase<EpiResZ<0>, pg8::StaticOrder, true, true>(L, g, S, E); }
#endif
    GRID_BAR();
    ln_rows<false>(a, Z, a.in[8], a.in[9], A16B, gw, NGW, lane);
    GRID_BAR();
#ifndef NO_P4
    { pg8::Gemm g{A16B, WMI, MTOT, DINP, DM}; pg8::StaticOrder S; S.init(MTOT, DINP, G, bx);
      EpiMixIn E{(bf16*)(ws + WS_QR), (bf16*)(ws + WS_KR), (bf16*)(ws + WS_VR), (bf16*)(ws + WS_GS), (float*)(ws + WS_P2RAW), R128};
      pg8::gemm_phase<EpiMixIn, pg8::StaticOrder, true, true>(L, g, S, E); }
#endif
    GRID_BAR();
    post_rows(a, gw, NGW, lane);
    transpose_matrix(a.in[19], DM, 2 * FF, WFI, 2 * FF, DM, 0, 0, scr, gw, NGW, lane);
    transpose_matrix(a.in[20], FF, DM, WFO, DM, FF, 0, 1, scr, gw, NGW, lane);
    GRID_BAR();
#ifndef NO_P6
    { int kq = 256; asm volatile("" : "+s"(kq));
      pg8::Gemm g{(const bf16*)(ws + WS_CQB), WUQ, MTOT, NQA, kq}; pg8::StaticOrder S; S.init(MTOT, NQA, G, bx); EpiUq E{(bf16*)(ws + WS_QA), R64};
      pg8::gemm_phase<EpiUq, pg8::StaticOrder, true, true>(L, g, S, E); }
#endif
    GRID_BAR();
    {
        constexpr int NRA = 4 + NB * 4 * 64 + DBS * 4;
        for (int i = vcu; i < NRA; i += G) {
            RetItem it;
            if (i < 4) it = RetItem{0, i, 0}; else if (i < 4 + 1024) { const int j = i - 4; it = RetItem{1, j >> 6, (j & 63) + 1}; } else it = RetItem{2, i - 1028, 0};
#ifndef NO_RETA
            ret_kv_wave(a, it, wave, lane);
#endif
        }
        constexpr int NAU = NB * 64 + DBS + 1;
        for (int i = vcu; i < NAU; i += G) {
#ifndef NO_ATTN
            if (i < NB * 64) { const int c = 63 - (i >> 2), b = i & 3; attn_wave(a, 0, b, c, wave >> 1, wave & 1, lane); }
            else if (i < NB * 64 + DBS) { if ((wave & 1) == 0) attn_wave(a, 1, i - NB * 64, 0, wave >> 1, 0, lane); }
            else { if ((wave & 1) == 0) attn_wave(a, 2, 0, 0, wave >> 1, 0, lane); }
#endif
        }
    }
    GRID_BAR();
    ret_scan(a, gtid, gthreads);
    GRID_BAR();
    {
        constexpr int NRC = 4 + NB * 4 * 64 * 2 + DBS * 4;
        for (int i = gw; i < NRC; i += NGW) {
#ifndef NO_RETC
            if (i < 2048) { const int j = i >> 1; ret_out_wave(a, RetItem{1, j >> 6, (j & 63) + 1}, i & 1, lane); }
            else if (i < 2048 + 64) ret_out_wave(a, RetItem{2, i - 2048, 0}, 0, lane);
            else ret_out_wave(a, RetItem{0, i - 2112, 0}, 1, lane);
#endif
        }
    }
    GRID_BAR();
#ifndef NO_P10
    { pg8::Gemm g{A16A, WMO, MTOT, DM, DM}; pg8::StaticOrder S; S.init(MTOT, DM, G, bx); EpiResZ<1> E{Z, A16B, a, 1.0f};
      pg8::gemm_phase<EpiResZ<1>, pg8::StaticOrder, true, true>(L, g, S, E); }
#endif
    GRID_BAR();
    ln_rows<false>(a, Z, a.in[17], a.in[18], A16B, gw, NGW, lane);
    GRID_BAR();
#ifndef NO_P12
    { pg8::Gemm g{A16B, WFI, MTOT, 2 * FF, DM}; pg8::StaticOrder S; S.init(MTOT, 2 * FF, G, bx); EpiSwiglu E{HID};
      pg8::gemm_phase<EpiSwiglu, pg8::StaticOrder, true, true>(L, g, S, E); }
#endif
    GRID_BAR();
#ifndef NO_P13
    { pg8::Gemm g{HID, WFO, MTOT, DM, FF}; pg8::StaticOrder S; S.init(MTOT, DM, G, bx); EpiResZ<1> E{Z, A16B, a, 0.5f};
      pg8::gemm_phase<EpiResZ<1>, pg8::StaticOrder, true, true>(L, g, S, E); }
#endif
    GRID_BAR();
    ln_rows<true>(a, Z, a.in[21], a.in[22], nullptr, gw, NGW, lane);
#undef GRID_BAR
}

extern "C" void kernel_launch(void* const* d_in, const int* in_sizes, int n_in, void* d_out, int out_size, void* d_ws, size_t ws_size, hipStream_t stream) {
    static int grid = 0;
    if (grid == 0) {
        if (n_in != 23 || out_size != (int)O_END || ws_size < WS_END) { fprintf(stderr, "kernel_launch: unexpected shapes (n_in %d, out %d, ws %zu; need 23, %zu, >= %zu)\n", n_in, out_size, ws_size, (size_t)O_END, (size_t)WS_END); grid = -1; return; }
        int dev = 0, cus = 0, per_cu = 0;
        if (hipGetDevice(&dev) != hipSuccess || hipDeviceGetAttribute(&cus, hipDeviceAttributeMultiprocessorCount, dev) != hipSuccess) { grid = -1; return; }
        if (hipFuncSetAttribute((const void*)fwd_mega, hipFuncAttributeMaxDynamicSharedMemorySize, LDS_BYTES) != hipSuccess) { fprintf(stderr, "kernel_launch: hipFuncSetAttribute failed\n"); grid = -1; return; }
        if (hipOccupancyMaxActiveBlocksPerMultiprocessor(&per_cu, (const void*)fwd_mega, NWAVES * 64, LDS_BYTES) != hipSuccess || per_cu < 1) { fprintf(stderr, "kernel_launch: occupancy query says %d blocks per CU\n", per_cu); per_cu = 1; }
        (void)hipGetLastError();
        grid = cus;
    }
    if (grid < 0) return;
    (void)hipMemsetAsync((char*)d_ws + WS_CTL, 0, CTL_BYTES, stream);
    Args a{};
    for (int i = 0; i < 23; ++i) a.in[i] = (const float*)d_in[i];
    a.out = (float*)d_out; a.ws = (unsigned char*)d_ws;
    void* args[] = {&a};
    hipError_t e = hipLaunchCooperativeKernel((const void*)fwd_mega, dim3(grid), dim3(NWAVES * 64), args, LDS_BYTES, stream);
    if (e != hipSuccess) fprintf(stderr, "kernel_launch: cooperative launch failed: %s (grid %d)\n", hipGetErrorString(e), grid);
}
```

```cpp
#include <hip/hip_runtime.h>
#include <hip/hip_cooperative_groups.h>
#include <cstdio>
#include <cstdint>

namespace pg8 {
#define PG8_LAS __attribute__((address_space(3)))
typedef unsigned short bf16_t;
typedef short bf16x8 __attribute__((ext_vector_type(8)));
typedef float f32x4 __attribute__((ext_vector_type(4)));
typedef unsigned u32x4 __attribute__((ext_vector_type(4)));
constexpr int BM = 256, BK = 64, HALF = 128, HTB = HALF * BK * 2  , STAGE_BYTES = 8 * HTB, NXCD = 8, WGM = 8;

__host__ __device__ __forceinline__ int lds_byte(int r, int c) { const int st = (r >> 4) * 2 + (c >> 5), rr = r & 15, cc = c & 31, ob = rr * 64 + cc * 2; return st * 1024 + (ob ^ (((ob >> 9) & 1) << 5)); }
__host__ __device__ __forceinline__ void stage_rc(int b, int& R, int& C) { const int st = b / 1024, sb = b % 1024, swz = sb ^ (((sb >> 9) & 1) << 5); R = (st >> 1) * 16 + swz / 64; C = (st & 1) * 32 + (swz % 64) / 2; }
__host__ __device__ __forceinline__ int perm32(int rho) { const int n = rho >> 4, i = rho & 15; return 8 * (i >> 2) + 4 * n + (i & 3); }

struct Unit { int pm, pn; };
struct Gemm { const bf16_t* A; const bf16_t* Bt; int M, N, K; };

struct StaticOrder {
    int nM, nN, nwg, G, c;
    __host__ __device__ void init(int M, int N, int G_, int c_) { nM = M / BM; nN = N / BM; nwg = nM * nN; G = G_; c = c_; }
    __host__ __device__ bool next(int i, Unit& u) const {
        const long L = (long)i * G + c; if (L >= nwg) return false;
        int wgid = (int)L; { const int q = nwg / NXCD, r = nwg % NXCD, xcd = wgid % NXCD, off = wgid / NXCD; wgid = (xcd < r ? xcd * (q + 1) : r * (q + 1) + (xcd - r) * q) + off; }
        const int nig = WGM * nN, gid = wgid / nig, fm = gid * WGM, gsz = (nM - fm) < WGM ? (nM - fm) : WGM;
        u.pm = fm + ((wgid % nig) % gsz); u.pn = (wgid % nig) / gsz; return true;
    }
    __device__ __forceinline__ void a_ready(const Unit&) const {}
    __device__ __forceinline__ void done(const Unit&) const {}
};

__device__ __forceinline__ unsigned cvt_pk_bf16(float lo, float hi) { unsigned r; asm volatile("v_cvt_pk_bf16_f32 %0, %1, %2" : "=v"(r) : "v"(lo), "v"(hi)); return r; }
typedef float f32x2 __attribute__((ext_vector_type(2)));

template <class Epi, class Sched, bool ALIGN_EPI = false, bool SP2 = false>
__device__ __forceinline__ void gemm_phase(PG8_LAS unsigned char* lds, const Gemm g, const Sched& S, const Epi& E) {
    int tid_ = threadIdx.x; asm volatile("" : "+v"(tid_));
    const int tid = tid_, wid = __builtin_amdgcn_readfirstlane(tid >> 6), lane = tid & 63, wr = wid >> 2, wc = wid & 3, fr = lane & 15, fq = lane >> 4;
    const int K = g.K, nt = K / BK;
    unsigned voffA[2], voffB[2];
#pragma unroll
    for (int i = 0; i < 2; ++i) { int R, C; stage_rc(tid * 16 + i * 8192, R, C); const int Rb = Epi::PERM ? ((R & ~31) + perm32(R & 31)) : R;
        voffA[i] = (unsigned)(R * K + C) * 2u; voffB[i] = (unsigned)(Rb * K + C) * 2u; }
    const size_t kstep = (size_t)(BK * 2);
    const size_t hstep = (size_t)HALF * K * 2;
    const size_t tstep = 2 * hstep;
    const unsigned ldsw = (unsigned)wid * 1024u;
    const int aoff = lds_byte(wr * 64 + fr, fq * 8), boff = lds_byte(wc * 32 + fr, fq * 8);
#define PG8_SA(b, h) (((b) * 2 + (h)) * HTB)
#define PG8_SB(b, h) ((4 + (b) * 2 + (h)) * HTB)
#define PG8_STAGE(bufoff, gbase, voff) do { _Pragma("unroll") for (int _i = 0; _i < 2; ++_i) \
        __builtin_amdgcn_global_load_lds((const unsigned*)((const char*)(gbase) + (voff)[_i]), (PG8_LAS unsigned*)(lds + (bufoff) + ldsw + _i * 8192), 16, 0, 0); } while (0)
#define PG8_LDA(dst, b, h) do { _Pragma("unroll") for (int m = 0; m < 4; ++m) _Pragma("unroll") for (int k = 0; k < 2; ++k) dst[m][k] = *(const PG8_LAS bf16x8*)(lds + PG8_SA(b, h) + aoff + m * 2048 + k * 1024); } while (0)
#define PG8_LDB(dst, b, h) do { _Pragma("unroll") for (int n = 0; n < 2; ++n) _Pragma("unroll") for (int k = 0; k < 2; ++k) dst[n][k] = *(const PG8_LAS bf16x8*)(lds + PG8_SB(b, h) + boff + n * 2048 + k * 1024); } while (0)
#define PG8_MMA(ai, bj, At, Bt) do { __builtin_amdgcn_s_setprio(1); _Pragma("unroll") for (int m = 0; m < 4; ++m) _Pragma("unroll") for (int n = 0; n < 2; ++n) _Pragma("unroll") for (int k = 0; k < 2; ++k) \
        acc[ai][bj][m][n] = __builtin_amdgcn_mfma_f32_16x16x32_bf16(Bt[n][k], At[m][k], acc[ai][bj][m][n], 0, 0, 0); __builtin_amdgcn_s_setprio(0); } while (0)
#define PG8_WAIT_V(n) asm volatile("s_waitcnt vmcnt(" #n ")" ::: "memory")
#define PG8_WAIT_L(n) asm volatile("s_waitcnt lgkmcnt(" #n ")" ::: "memory")
#define PG8_BAR __builtin_amdgcn_s_barrier()
#define PG8_SCHED __builtin_amdgcn_sched_barrier(0)
    Unit cur, nxt; int ui = 0;
    if (!S.next(0, cur)) return;
    f32x4 acc[2][2][4][2];
#pragma unroll
    for (int a = 0; a < 2; ++a)
#pragma unroll
        for (int b = 0; b < 2; ++b)
#pragma unroll
            for (int m = 0; m < 4; ++m)
#pragma unroll
                for (int n = 0; n < 2; ++n) acc[a][b][m][n] = (f32x4){0.f, 0.f, 0.f, 0.f};
    bf16x8 At[4][2], B0[2][2], B1[2][2];
    const char* cA = (const char*)g.A + (size_t)cur.pm * tstep; const char* cB = (const char*)g.Bt + (size_t)cur.pn * tstep;
    S.a_ready(cur);
    if constexpr (SP2) {
        PG8_STAGE(PG8_SB(0, 0), cB, voffB); PG8_STAGE(PG8_SB(0, 1), cB + hstep, voffB); PG8_STAGE(PG8_SA(0, 0), cA, voffA); PG8_STAGE(PG8_SA(0, 1), cA + hstep, voffA);
        if (wr == 1) PG8_BAR;
        PG8_WAIT_V(2); PG8_BAR;
        PG8_STAGE(PG8_SB(1, 0), cB + kstep, voffB); PG8_STAGE(PG8_SA(1, 0), cA + kstep, voffA); PG8_STAGE(PG8_SB(1, 1), cB + hstep + kstep, voffB);
        PG8_WAIT_V(6); PG8_BAR;
    } else {
        PG8_STAGE(PG8_SB(0, 0), cB, voffB); PG8_STAGE(PG8_SA(0, 0), cA, voffA); PG8_STAGE(PG8_SB(0, 1), cB + hstep, voffB); PG8_STAGE(PG8_SA(0, 1), cA + hstep, voffA);
        if (wr == 1) PG8_BAR;
        PG8_WAIT_V(4); PG8_BAR;
        PG8_STAGE(PG8_SB(1, 0), cB + kstep, voffB); PG8_STAGE(PG8_SA(1, 0), cA + kstep, voffA); PG8_STAGE(PG8_SB(1, 1), cB + hstep + kstep, voffB);
        PG8_WAIT_V(6); PG8_BAR;
    }
    for (;;) {
        const bool has_next = S.next(ui + 1, nxt);
        const char* nA = has_next ? (const char*)g.A + (size_t)nxt.pm * tstep : cA; const char* nB = has_next ? (const char*)g.Bt + (size_t)nxt.pn * tstep : cB;
        for (int t = 0; t < nt; t += 2) {
            const bool last = (t == nt - 2);
            const char* a1 = cA + (size_t)(t + 1) * kstep;
            const char* a2 = last ? nA : cA + (size_t)(t + 2) * kstep; const char* b2 = last ? nB : cB + (size_t)(t + 2) * kstep;
            const char* a3 = a2 + kstep; const char* b3 = b2 + kstep;
            if (last && has_next) S.a_ready(nxt);
            if constexpr (SP2) {
            PG8_LDB(B0, 0, 0); PG8_LDB(B1, 0, 1); PG8_SCHED; PG8_LDA(At, 0, 0); PG8_STAGE(PG8_SA(1, 1), a1 + hstep, voffA);
            PG8_WAIT_V(8); PG8_WAIT_L(0); PG8_BAR; PG8_MMA(0, 0, At, B0); PG8_MMA(0, 1, At, B1); PG8_BAR; PG8_SCHED;
            PG8_LDA(At, 0, 1); PG8_STAGE(PG8_SB(0, 0), b2, voffB); PG8_STAGE(PG8_SB(0, 1), b2 + hstep, voffB); PG8_STAGE(PG8_SA(0, 0), a2, voffA);
            PG8_WAIT_V(8); PG8_WAIT_L(0); PG8_BAR; PG8_MMA(1, 0, At, B0); PG8_MMA(1, 1, At, B1); PG8_BAR; PG8_SCHED;
            PG8_LDB(B0, 1, 0); PG8_LDB(B1, 1, 1); PG8_SCHED; PG8_LDA(At, 1, 0); PG8_STAGE(PG8_SA(0, 1), a2 + hstep, voffA);
            PG8_WAIT_V(8); PG8_WAIT_L(0); PG8_BAR; PG8_MMA(0, 0, At, B0); PG8_MMA(0, 1, At, B1); PG8_BAR; PG8_SCHED;
            PG8_LDA(At, 1, 1); PG8_STAGE(PG8_SB(1, 0), b3, voffB); PG8_STAGE(PG8_SB(1, 1), b3 + hstep, voffB); PG8_STAGE(PG8_SA(1, 0), a3, voffA);
            PG8_WAIT_V(8); PG8_WAIT_L(0); PG8_BAR; PG8_MMA(1, 0, At, B0); PG8_MMA(1, 1, At, B1); PG8_BAR; PG8_SCHED;
            } else {
            PG8_LDB(B0, 0, 0); PG8_SCHED; PG8_LDA(At, 0, 0); PG8_STAGE(PG8_SA(1, 1), a1 + hstep, voffA);
            PG8_WAIT_L(8); PG8_BAR; PG8_WAIT_L(0); PG8_MMA(0, 0, At, B0); PG8_BAR; PG8_SCHED;
            PG8_LDB(B1, 0, 1); PG8_STAGE(PG8_SB(0, 0), b2, voffB);
            PG8_BAR; PG8_WAIT_L(0); PG8_MMA(0, 1, At, B1); PG8_BAR;
            PG8_LDA(At, 0, 1); PG8_STAGE(PG8_SA(0, 0), a2, voffA);
            PG8_BAR; PG8_WAIT_L(0); PG8_MMA(1, 0, At, B0); PG8_BAR; PG8_SCHED;
            PG8_STAGE(PG8_SB(0, 1), b2 + hstep, voffB);
            PG8_WAIT_V(6); PG8_BAR; PG8_MMA(1, 1, At, B1); PG8_BAR;
            PG8_LDB(B0, 1, 0); PG8_SCHED; PG8_LDA(At, 1, 0); PG8_STAGE(PG8_SA(0, 1), a2 + hstep, voffA);
            PG8_WAIT_L(8); PG8_BAR; PG8_WAIT_L(0); PG8_MMA(0, 0, At, B0); PG8_BAR; PG8_SCHED;
            PG8_LDB(B1, 1, 1); PG8_STAGE(PG8_SB(1, 0), b3, voffB);
            PG8_BAR; PG8_WAIT_L(0); PG8_MMA(0, 1, At, B1); PG8_BAR;
            PG8_LDA(At, 1, 1); PG8_STAGE(PG8_SA(1, 0), a3, voffA);
            PG8_BAR; PG8_WAIT_L(0); PG8_MMA(1, 0, At, B0); PG8_BAR; PG8_SCHED;
            PG8_STAGE(PG8_SB(1, 1), b3 + hstep, voffB);
            PG8_WAIT_V(6); PG8_BAR; PG8_MMA(1, 1, At, B1); PG8_BAR;
            }
        }
        if constexpr (ALIGN_EPI) { if (wr == 0) PG8_BAR; }
        if constexpr (!Epi::AFTER_DRAIN) { E(acc, cur, wr, wc, fr, fq); S.done(cur); }
        if (!has_next) break;
#pragma unroll
        for (int a = 0; a < 2; ++a)
#pragma unroll
            for (int b = 0; b < 2; ++b)
#pragma unroll
                for (int m = 0; m < 4; ++m)
#pragma unroll
                    for (int n = 0; n < 2; ++n) acc[a][b][m][n] = (f32x4){0.f, 0.f, 0.f, 0.f};
        cur = nxt; cA = nA; cB = nB; ++ui;
        if constexpr (ALIGN_EPI) { if (wr == 1) PG8_BAR; }
    }
    PG8_WAIT_V(0);
    if constexpr (!ALIGN_EPI) { if (wr == 0) PG8_BAR; }
    PG8_BAR;
    if constexpr (Epi::AFTER_DRAIN) { E.fused(acc, cur, wr, wc, fr, fq, lds, wid, lane); S.done(cur); }
#undef PG8_SA
#undef PG8_SB
#undef PG8_STAGE
#undef PG8_LDA
#undef PG8_LDB
#undef PG8_MMA
#undef PG8_WAIT_V
#undef PG8_WAIT_L
#undef PG8_BAR
#undef PG8_SCHED
}
}

#define LAS __attribute__((address_space(3)))

#define XB_TMO      128
#define XB_XCNT(j)  (256  + 64 * (j))
#define XB_XSUB(j)  (1280 + 64 * (j))
#define XB_XGEN(j)  (2304 + 64 * (j))
#define XB_TOP      3328
#define XB_TOPGEN   3392
#define XCD_BAR_WORDS 3456
#define XB_SPIN_CAP (1u << 18)

__device__ __forceinline__ unsigned xb_ld(unsigned* p)              { return __hip_atomic_load(p, __ATOMIC_RELAXED, __HIP_MEMORY_SCOPE_AGENT); }
__device__ __forceinline__ unsigned xb_add(unsigned* p, unsigned v) { return __hip_atomic_fetch_add(p, v, __ATOMIC_RELAXED, __HIP_MEMORY_SCOPE_AGENT); }
__device__ __forceinline__ unsigned xb_xcc_id() { return (unsigned)__builtin_amdgcn_s_getreg((3 << 11) | 20) & 0xFu; }
#define XB_SPIN(cond, bar) do { unsigned _sp = 0; while (cond) { __builtin_amdgcn_s_sleep(1); \
    if ((++_sp & 255u) == 0u) { if (xb_ld(&(bar)[XB_TMO])) break; if (_sp > XB_SPIN_CAP) { atomicAdd(&(bar)[XB_TMO], 1u); break; } } } } while (0)

struct XcdBarrier {
    unsigned* bar; unsigned x;
    volatile LAS unsigned* st;
};

__device__ __forceinline__ XcdBarrier xcd_barrier_post(unsigned* bar, volatile LAS unsigned* st) {
    XcdBarrier b; b.bar = bar; b.x = xb_xcc_id(); b.st = st;
    if (threadIdx.x == 0) (void)xb_add(&bar[XB_XCNT(b.x)], 1u);
    return b;
}
__device__ __forceinline__ void xcd_barrier_complete(unsigned* bar, unsigned x, unsigned& nloc, unsigned& nx) {
    const unsigned G = gridDim.x * gridDim.y * gridDim.z;
    unsigned sum, cnt, mine, sp = 0u;
    for (;;) {
        sum = 0u; cnt = 0u; mine = 0u;
#pragma unroll
        for (unsigned j = 0; j < 16; ++j) { const unsigned c = xb_ld(&bar[XB_XCNT(j)]); sum += c; cnt += (c > 0u) ? 1u : 0u; mine = (j == x) ? c : mine; }
        if (sum == G) break;
        __builtin_amdgcn_s_sleep(1);
        if ((++sp & 255u) == 0u) { if (xb_ld(&bar[XB_TMO])) break; if (sp > XB_SPIN_CAP) { atomicAdd(&bar[XB_TMO], 1u); break; } }
    }
    nloc = mine > 0u ? mine : 1u; nx = cnt > 0u ? cnt : 1u;
}

__device__ __forceinline__ void xcd_barrier(const XcdBarrier& b) {
    asm volatile("s_waitcnt vmcnt(0)" ::: "memory");
    __syncthreads();
    if (threadIdx.x == 0) {
        unsigned* bar = b.bar;
        __builtin_amdgcn_s_waitcnt(0);
        unsigned nloc = b.st[0], nx = b.st[1];
        if (nloc == 0u) { xcd_barrier_complete(bar, b.x, nloc, nx); b.st[0] = nloc; b.st[1] = nx; }
        const unsigned old = xb_add(&bar[XB_XSUB(b.x)], 1u);
        const unsigned gen = old / nloc;
        if (old + 1u == (gen + 1u) * nloc) {
            __builtin_amdgcn_fence(__ATOMIC_RELEASE, "agent");
            asm volatile("s_waitcnt vmcnt(0)" ::: "memory");
            const unsigned og = xb_add(&bar[XB_TOP], 1u);
            const unsigned tg = og / nx;
            if (og + 1u == (tg + 1u) * nx) xb_add(&bar[XB_TOPGEN], 1u);
            else XB_SPIN(xb_ld(&bar[XB_TOPGEN]) == tg, bar);
            __builtin_amdgcn_fence(__ATOMIC_ACQUIRE, "agent");
            xb_add(&bar[XB_XGEN(b.x)], 1u);
            asm volatile("s_waitcnt vmcnt(0)" ::: "memory");
        } else {
            XB_SPIN(xb_ld(&bar[XB_XGEN(b.x)]) == gen, bar);
            __builtin_amdgcn_fence(__ATOMIC_ACQUIRE, "agent");
            asm volatile("s_waitcnt vmcnt(0)" ::: "memory");
        }
    }
    __syncthreads();
}


#define GAS __attribute__((address_space(1)))

typedef unsigned short bf16;
typedef unsigned v4u __attribute__((ext_vector_type(4)));
typedef unsigned v2u __attribute__((ext_vector_type(2)));
typedef float f32x4 __attribute__((ext_vector_type(4)));
typedef float f32x2 __attribute__((ext_vector_type(2)));
typedef float f32x16 __attribute__((ext_vector_type(16)));
typedef short bf16x8 __attribute__((ext_vector_type(8)));
#define LDS_WAIT() asm volatile("s_waitcnt lgkmcnt(0)" ::: "memory")
#define VM_WAIT() asm volatile("s_waitcnt vmcnt(0)" ::: "memory")

constexpr int DM = 1024, NMETA = 16, SEQ = 4096, NB = 4, DBS = 16, TS = 32, PAST = 1024, FF = 2816, LP = NMETA + SEQ;
constexpr int R_PROMPT = 16, R_SAMPLE = R_PROMPT + NB * SEQ, R_VALID = R_SAMPLE + DBS * TS, MTOT = 17152;
static_assert(R_SAMPLE == 16400 && R_VALID == 16912 && MTOT % 256 == 0 && MTOT >= R_VALID + 64, "row space");
constexpr int DIN = 2496, DINP = 2560, NQA = 768, KVW = 192;
constexpr float DN_ALPHA = 1.189207115002721f, LN_EPS = 1e-5f, RMS_EPS = 1e-6f, LOG2E = 1.4426950408889634f;
constexpr float SM_SCALE = 0.07216878364870322f;
constexpr float KR_SCALE = 0.08838834764831845f;
constexpr size_t O_YP = 0, O_YS = O_YP + (size_t)NB * SEQ * DM, O_PCKV = O_YS + (size_t)DBS * TS * DM, O_PKPE = O_PCKV + (size_t)NB * LP * 128, O_PST = O_PKPE + (size_t)NB * LP * 64,
                 O_SCKV = O_PST + (size_t)NB * 4 * 128 * 128, O_SKPE = O_SCKV + (size_t)DBS * TS * 128, O_SST = O_SKPE + (size_t)DBS * TS * 64, O_END = O_SST + (size_t)DBS * 4 * 128 * 128;
static_assert(O_END == 21868544, "d_out size");

constexpr size_t al256(size_t x) { return (x + 255) & ~(size_t)255; }
constexpr size_t WS_CTL = 0, CTL_BYTES = 1u << 20;
constexpr size_t WS_WFI = WS_CTL + CTL_BYTES;
constexpr size_t WS_WFO = WS_WFI + (size_t)5632 * 1024 * 2;
constexpr size_t WS_WMI = WS_WFO + (size_t)1024 * 2816 * 2;
constexpr size_t WS_WMO = WS_WMI + (size_t)2560 * 1024 * 2;
constexpr size_t WS_WUQ = WS_WMO + (size_t)1024 * 1024 * 2;
constexpr size_t WS_R128 = WS_WUQ + (size_t)768 * 256 * 2;
constexpr size_t WS_R64 = WS_R128 + (size_t)LP * 64 * 8;
constexpr size_t WS_A16A = al256(WS_R64 + (size_t)LP * 32 * 8);
constexpr size_t A16_BYTES = (size_t)MTOT * 1024 * 2;
constexpr size_t WS_A16B = WS_A16A + A16_BYTES;
constexpr size_t WS_Z = WS_A16B + A16_BYTES;
constexpr size_t Z_BYTES = (size_t)MTOT * 1024 * 4;
constexpr size_t WS_HID = WS_Z + Z_BYTES;
constexpr size_t HID_BYTES = (size_t)MTOT * 2816 * 2;
constexpr size_t WS_END = WS_HID + HID_BYTES;
static_assert(WS_END <= 268435456, "workspace map exceeds 256 MiB");
constexpr size_t WS_P2RAW = WS_Z;
constexpr size_t WS_QA = WS_Z;
constexpr size_t WS_KVN = WS_QA + (size_t)MTOT * 768 * 2;
constexpr int KVN_ITEMS = 4 + NB * 4 * 64;
constexpr size_t WS_KVCT = WS_KVN + (size_t)KVN_ITEMS * 32768;
constexpr size_t WS_CKVT = WS_KVCT + (size_t)DBS * 128 * PAST * 2;
static_assert(WS_CKVT + (size_t)128 * MTOT * 2 <= WS_Z + Z_BYTES && WS_KVCT >= WS_P2RAW + (size_t)MTOT * 512 * 4, "Z overlays");
constexpr size_t RB_BYTES = (size_t)MTOT * 512 * 2;
constexpr size_t WS_QR = WS_HID, WS_KR = WS_QR + RB_BYTES, WS_VR = WS_KR + RB_BYTES, WS_GS = WS_VR + RB_BYTES;
constexpr size_t WS_KVB = WS_GS + RB_BYTES;
constexpr size_t WS_KVC = WS_KVB + (size_t)MTOT * KVW * 2;
constexpr size_t WS_CQB = WS_KVC + (size_t)DBS * PAST * KVW * 2;
static_assert(WS_CQB + (size_t)MTOT * 256 * 2 <= WS_HID + HID_BYTES, "HID overlays");
constexpr int CW_BAR = 4096;

__device__ __forceinline__ float lg2gamma(int h) { return h == 0 ? -0.04580368961312479f : h == 1 ? -0.02272007650008353f : h == 2 ? -0.011315313227834146f : -0.005646563141142063f; }

__device__ __forceinline__ int row_pos(int r) { return r < R_PROMPT ? r : (r < R_SAMPLE ? NMETA + ((r - R_PROMPT) & (SEQ - 1)) : (r < R_VALID ? NMETA + PAST + ((r - R_SAMPLE) & (TS - 1)) : 0)); }
__device__ __forceinline__ unsigned f2bf(float f) { unsigned u = __builtin_bit_cast(unsigned, f); return (u + 0x7fffu + ((u >> 16) & 1u)) >> 16; }
__device__ __forceinline__ unsigned pk2(float lo, float hi) { return pg8::cvt_pk_bf16(lo, hi); }
__device__ __forceinline__ float bf2f(unsigned short b) { return __builtin_bit_cast(float, (unsigned)b << 16); }
__device__ __forceinline__ float bflo(unsigned w) { return __builtin_bit_cast(float, w << 16); }
__device__ __forceinline__ float bfhi(unsigned w) { return __builtin_bit_cast(float, w & 0xffff0000u); }
__device__ __forceinline__ float siluf(float x) { return x * __builtin_amdgcn_rcpf(1.0f + __builtin_amdgcn_exp2f(-x * LOG2E)); }
__device__ __forceinline__ float wave_sum(float v) {
#pragma unroll
    for (int o = 1; o < 64; o <<= 1) v += __shfl_xor(v, o);
    return v;
}

struct Args { const float* in[23]; float* out; unsigned char* ws; };

__device__ __forceinline__ const float* x_row(const Args& a, int r) {
    if (r < R_PROMPT) return a.in[5] + (size_t)r * DM;
    if (r < R_SAMPLE) return a.in[0] + (size_t)(r - R_PROMPT) * DM;
    if (r < R_VALID) return a.in[1] + (size_t)(r - R_SAMPLE) * DM;
    return nullptr;
}

struct EpiSwiglu {
    static constexpr bool PERM = true, AFTER_DRAIN = false;
    bf16* H;
    __device__ __forceinline__ void operator()(const pg8::f32x4 (&acc)[2][2][4][2], const pg8::Unit& u, int wr, int wc, int fr, int fq) const {
        asm volatile("" : "+v"(fr), "+v"(fq));
        const int row0 = u.pm * 256 + wr * 64 + fr, col0 = u.pn * 128 + wc * 32 + 8 * fq;
#pragma unroll
        for (int ai = 0; ai < 2; ++ai)
#pragma unroll
            for (int m = 0; m < 4; ++m) {
                const int row = row0 + ai * 128 + m * 16;
                const pg8::f32x4 g0 = acc[ai][0][m][0], g1 = acc[ai][0][m][1], u0 = acc[ai][1][m][0], u1 = acc[ai][1][m][1];
                v4u w;
                w.x = pk2(siluf(g0[0]) * u0[0], siluf(g0[1]) * u0[1]); w.y = pk2(siluf(g0[2]) * u0[2], siluf(g0[3]) * u0[3]);
                w.z = pk2(siluf(g1[0]) * u1[0], siluf(g1[1]) * u1[1]); w.w = pk2(siluf(g1[2]) * u1[2], siluf(g1[3]) * u1[3]);
                *(v4u*)(H + (size_t)row * FF + col0) = w;
            }
    }
};
template <int SRC> struct EpiResZ {
    static constexpr bool PERM = false, AFTER_DRAIN = false;
    float* Z; const bf16* resb; Args a; float scale;
    __device__ __forceinline__ void operator()(const pg8::f32x4 (&acc)[2][2][4][2], const pg8::Unit& u, int wr, int wc, int fr, int fq) const {
        asm volatile("" : "+v"(fr), "+v"(fq));
        const int row0 = u.pm * 256 + wr * 64 + fr, col0 = u.pn * 256 + wc * 32 + 4 * fq;
#pragma unroll
        for (int ai = 0; ai < 2; ++ai)
#pragma unroll
            for (int m = 0; m < 4; ++m) {
                const int row = row0 + ai * 128 + m * 16;
                const float* xr = SRC == 0 ? x_row(a, row) : nullptr;
#pragma unroll
                for (int bj = 0; bj < 2; ++bj)
#pragma unroll
                    for (int n = 0; n < 2; ++n) {
                        const int c = col0 + bj * 128 + n * 16;
                        f32x4 rv;
                        if (SRC == 0) rv = xr ? *(const f32x4*)(xr + c) : (f32x4){0.f, 0.f, 0.f, 0.f};
                        else { const v2u w = *(const v2u*)(resb + (size_t)row * DM + c); rv = (f32x4){bflo(w.x), bfhi(w.x), bflo(w.y), bfhi(w.y)}; }
                        const pg8::f32x4 av = acc[ai][bj][m][n];
                        f32x4 o; o.x = DN_ALPHA * rv.x + scale * av[0]; o.y = DN_ALPHA * rv.y + scale * av[1]; o.z = DN_ALPHA * rv.z + scale * av[2]; o.w = DN_ALPHA * rv.w + scale * av[3];
                        *(f32x4*)(Z + (size_t)row * DM + c) = o;
                    }
                asm volatile("" ::: "memory");
            }
    }
};
struct EpiMixIn {
    static constexpr bool PERM = true, AFTER_DRAIN = false;
    bf16 *QR, *KR, *VR, *GS; float* P2; const f32x2* R128;
    __device__ __forceinline__ void operator()(const pg8::f32x4 (&acc)[2][2][4][2], const pg8::Unit& u, int wr, int wc, int fr, int fq) const {
        asm volatile("" : "+v"(fr), "+v"(fq));
        const int row0 = u.pm * 256 + wr * 64 + fr, pn = u.pn;
        if (pn < 4) {
            bf16* dst = pn < 2 ? QR : KR; const float sc = pn < 2 ? 1.0f : KR_SCALE;
            const int head = 2 * (pn & 1) + (wc >> 1), i0 = (wc & 1) * 32 + 8 * fq;
#pragma unroll
            for (int ai = 0; ai < 2; ++ai)
#pragma unroll
                for (int m = 0; m < 4; ++m) {
                    const int row = row0 + ai * 128 + m * 16;
                    const f32x2* cs = R128 + (size_t)row_pos(row) * 64 + i0;
                    float o1[8], o2[8];
#pragma unroll
                    for (int n = 0; n < 2; ++n)
#pragma unroll
                        for (int j = 0; j < 4; ++j) { const f32x2 t = cs[4 * n + j]; const float x1 = acc[ai][0][m][n][j], x2 = acc[ai][1][m][n][j];
                            o1[4 * n + j] = (x1 * t.x - x2 * t.y) * sc; o2[4 * n + j] = (x1 * t.y + x2 * t.x) * sc; }
                    v4u w1, w2;
                    w1.x = pk2(o1[0], o1[1]); w1.y = pk2(o1[2], o1[3]); w1.z = pk2(o1[4], o1[5]); w1.w = pk2(o1[6], o1[7]);
                    w2.x = pk2(o2[0], o2[1]); w2.y = pk2(o2[2], o2[3]); w2.z = pk2(o2[4], o2[5]); w2.w = pk2(o2[6], o2[7]);
                    bf16* p = dst + (size_t)row * 512 + head * 128 + i0;
                    *(v4u*)p = w1; *(v4u*)(p + 64) = w2;
                    asm volatile("" ::: "memory");
                }
        } else if (pn < 8) {
            bf16* dst = pn < 6 ? VR : GS; const bool act = pn >= 6;
            const int cb = (pn & 1) * 256 + wc * 32 + 8 * fq;
#pragma unroll
            for (int ai = 0; ai < 2; ++ai)
#pragma unroll
                for (int m = 0; m < 4; ++m) {
                    const int row = row0 + ai * 128 + m * 16;
#pragma unroll
                    for (int bj = 0; bj < 2; ++bj) {
                        pg8::f32x4 v0 = acc[ai][bj][m][0], v1 = acc[ai][bj][m][1];
                        if (act) {
#pragma unroll
                            for (int j = 0; j < 4; ++j) { v0[j] = siluf(v0[j]); v1[j] = siluf(v1[j]); } }
                        v4u w; w.x = pk2(v0[0], v0[1]); w.y = pk2(v0[2], v0[3]); w.z = pk2(v1[0], v1[1]); w.w = pk2(v1[2], v1[3]);
                        *(v4u*)(dst + (size_t)row * 512 + cb + bj * 128) = w;
                    }
                }
        } else {
            const int cb = (pn - 8) * 256 + wc * 32 + 8 * fq;
#pragma unroll
            for (int ai = 0; ai < 2; ++ai)
#pragma unroll
                for (int m = 0; m < 4; ++m) {
                    const int row = row0 + ai * 128 + m * 16;
#pragma unroll
                    for (int bj = 0; bj < 2; ++bj) {
                        float* p = P2 + (size_t)row * 512 + cb + bj * 128;
                        const pg8::f32x4 v0 = acc[ai][bj][m][0], v1 = acc[ai][bj][m][1];
                        *(f32x4*)p = (f32x4){v0[0], v0[1], v0[2], v0[3]}; *(f32x4*)(p + 4) = (f32x4){v1[0], v1[1], v1[2], v1[3]};
                    }
                }
        }
    }
};
struct EpiUq {
    static constexpr bool PERM = true, AFTER_DRAIN = false;
    bf16* QA; const f32x2* R64;
    __device__ __forceinline__ void operator()(const pg8::f32x4 (&acc)[2][2][4][2], const pg8::Unit& u, int wr, int wc, int fr, int fq) const {
        asm volatile("" : "+v"(fr), "+v"(fq));
        const int row0 = u.pm * 256 + wr * 64 + fr, pn = u.pn;
        if (pn < 2) {
#pragma unroll
            for (int ai = 0; ai < 2; ++ai)
#pragma unroll
                for (int m = 0; m < 4; ++m) {
                    const int row = row0 + ai * 128 + m * 16;
#pragma unroll
                    for (int bj = 0; bj < 2; ++bj) {
                        const pg8::f32x4 v0 = acc[ai][bj][m][0] * SM_SCALE, v1 = acc[ai][bj][m][1] * SM_SCALE;
                        v4u w; w.x = pk2(v0[0], v0[1]); w.y = pk2(v0[2], v0[3]); w.z = pk2(v1[0], v1[1]); w.w = pk2(v1[2], v1[3]);
                        *(v4u*)(QA + (size_t)row * NQA + (2 * pn + bj) * KVW + wc * 32 + 8 * fq) = w;
                    }
                }
        } else {
            const int head = wc, i0 = 8 * fq;
#pragma unroll
            for (int ai = 0; ai < 2; ++ai)
#pragma unroll
                for (int m = 0; m < 4; ++m) {
                    const int row = row0 + ai * 128 + m * 16;
                    const f32x2* cs = R64 + (size_t)row_pos(row) * 32 + i0;
                    float o1[8], o2[8];
#pragma unroll
                    for (int n = 0; n < 2; ++n)
#pragma unroll
                        for (int j = 0; j < 4; ++j) { const f32x2 t = cs[4 * n + j]; const float x1 = acc[ai][0][m][n][j], x2 = acc[ai][1][m][n][j];
                            o1[4 * n + j] = (x1 * t.x - x2 * t.y) * SM_SCALE; o2[4 * n + j] = (x1 * t.y + x2 * t.x) * SM_SCALE; }
                    v4u w1, w2;
                    w1.x = pk2(o1[0], o1[1]); w1.y = pk2(o1[2], o1[3]); w1.z = pk2(o1[4], o1[5]); w1.w = pk2(o1[6], o1[7]);
                    w2.x = pk2(o2[0], o2[1]); w2.y = pk2(o2[2], o2[3]); w2.z = pk2(o2[4], o2[5]); w2.w = pk2(o2[6], o2[7]);
                    bf16* p = QA + (size_t)row * NQA + head * KVW + 128 + i0;
                    *(v4u*)p = w1; *(v4u*)(p + 32) = w2;
                    asm volatile("" ::: "memory");
                }
        }
    }
};

__device__ __forceinline__ int src_col(int mat, int n) {
    if (mat == 0) { const int pn = n >> 8, bj = (n >> 7) & 1, i = n & 127; return bj * FF + 128 * pn + i; }
    if (mat == 2) {
        if (n < 1024) { const int pn = n >> 8, bj = (n >> 7) & 1, ip = n & 127, hh = ip >> 6, i = ip & 63; return (pn >> 1) * 512 + (2 * (pn & 1) + hh) * 128 + 64 * bj + i; }
        return n < DIN ? n : -1; }
    if (mat == 3) { const int bj = n >> 7, ip = n & 127, head = ip >> 5, i = ip & 31; return head * KVW + 128 + 32 * bj + i; }
    return n;
}
__device__ __forceinline__ void transpose_item(const float* __restrict__ W, int srcN, bf16* WT, int dstPitch, int dstRowOff, int mat, int k0, int n0, LAS float* scr, int lane) {
    const int sc = src_col(mat, n0 + (lane & 31));
#pragma unroll 8
    for (int i = 0; i < 32; ++i) { const int kk = 2 * i + (lane >> 5); scr[kk * 33 + (lane & 31)] = sc >= 0 ? W[(size_t)(k0 + kk) * srcN + sc] : 0.f; }
    LDS_WAIT();
    const int c = lane & 7;
#pragma unroll
    for (int j = 0; j < 4; ++j) { const int n = (lane >> 3) + 8 * j; const LAS float* s = scr + (8 * c) * 33 + n;
        v4u o; o.x = pk2(s[0 * 33], s[1 * 33]); o.y = pk2(s[2 * 33], s[3 * 33]); o.z = pk2(s[4 * 33], s[5 * 33]); o.w = pk2(s[6 * 33], s[7 * 33]);
        *(v4u*)(WT + (size_t)(dstRowOff + n0 + n) * dstPitch + k0 + 8 * c) = o; }
    LDS_WAIT();
}
__device__ __forceinline__ void transpose_matrix(const float* W, int Kdim, int srcN, bf16* WT, int Ndst, int dstPitch, int dstRowOff, int mat, LAS float* scr, int gw, int NGW, int lane) {
    const int nblk = Ndst / 32, nitems = (Kdim / 64) * nblk;
    for (int it = gw; it < nitems; it += NGW) transpose_item(W, srcN, WT, dstPitch, dstRowOff, mat, 64 * (it / nblk), 32 * (it % nblk), scr, lane);
}
__device__ __forceinline__ void sincos_acc(float ang, float& sn, float& cs) {
    const double x = (double)ang; const double kq = __builtin_rint(x * 0.63661977236758134308);
    const double r = (x - kq * 1.57079632679489655800e+00) - kq * 6.12323399573676603587e-17;
    const double r2 = r * r;
    const double s = r * (1.0 + r2 * (-1.0 / 6 + r2 * (1.0 / 120 + r2 * (-1.0 / 5040 + r2 * (1.0 / 362880 + r2 * (-1.0 / 39916800 + r2 * (1.0 / 6227020800.0)))))));
    const double c = 1.0 + r2 * (-0.5 + r2 * (1.0 / 24 + r2 * (-1.0 / 720 + r2 * (1.0 / 40320 + r2 * (-1.0 / 3628800 + r2 * (1.0 / 479001600 + r2 * (-1.0 / 87178291200.0)))))));
    const int q = (int)((long long)kq & 3);
    const double ss = (q == 0) ? s : (q == 1) ? c : (q == 2) ? -s : -c;
    const double cc = (q == 0) ? c : (q == 1) ? -s : (q == 2) ? -c : s;
    sn = (float)ss; cs = (float)cc;
}

template <bool FINAL> __device__ __forceinline__ void ln_rows(const Args& a, const float* Z, const float* g, const float* b, bf16* outB, int gw, int NGW, int lane) {
    f32x4 gv[4], bv[4];
#pragma unroll
    for (int j = 0; j < 4; ++j) { gv[j] = *(const f32x4*)(g + 4 * lane + 256 * j); bv[j] = *(const f32x4*)(b + 4 * lane + 256 * j); }
    for (int r = gw; r < (FINAL ? R_VALID : MTOT); r += NGW) {
        if (FINAL && r < R_PROMPT) continue;
        const f32x4* zr = (const f32x4*)(Z + (size_t)r * DM) + lane;
        f32x4 v[4]; float s = 0.f;
#pragma unroll
        for (int j = 0; j < 4; ++j) { v[j] = zr[64 * j]; s += (v[j].x + v[j].y) + (v[j].z + v[j].w); }
        const float mean = wave_sum(s) * (1.f / DM); float s2 = 0.f;
#pragma unroll
        for (int j = 0; j < 4; ++j) { v[j] = v[j] - mean; s2 += (v[j].x * v[j].x + v[j].y * v[j].y) + (v[j].z * v[j].z + v[j].w * v[j].w); }
        const float rstd = 1.0f / sqrtf(wave_sum(s2) * (1.f / DM) + LN_EPS);
        if (FINAL) {
            float* o = a.out + (r < R_SAMPLE ? O_YP + (size_t)(r - R_PROMPT) * DM : O_YS + (size_t)(r - R_SAMPLE) * DM);
#pragma unroll
            for (int j = 0; j < 4; ++j) *((f32x4*)o + lane + 64 * j) = v[j] * rstd * gv[j] + bv[j];
        } else {
            v2u* o = (v2u*)(outB + (size_t)r * DM) + lane;
#pragma unroll
            for (int j = 0; j < 4; ++j) { const f32x4 y = v[j] * rstd * gv[j] + bv[j]; v2u w; w.x = pk2(y.x, y.y); w.y = pk2(y.z, y.w); o[64 * j] = w; }
        }
    }
}

__device__ __forceinline__ void post_rows(const Args& a, int gw, int NGW, int lane) {
    unsigned char* ws = a.ws;
    const float* P2 = (const float*)(ws + WS_P2RAW); bf16* CQB = (bf16*)(ws + WS_CQB); bf16* KVB = (bf16*)(ws + WS_KVB);
    const f32x2* R64 = (const f32x2*)(ws + WS_R64);
    const f32x4 gq = *(const f32x4*)(a.in[12] + 4 * lane);
    const float gk0 = a.in[14][lane], gk1 = a.in[14][64 + lane];
    for (int it = gw; it < MTOT / 8; it += NGW) {
#pragma unroll 2
        for (int rr = 0; rr < 8; ++rr) {
            const int row = 8 * it + rr; const float* p = P2 + (size_t)row * 512;
            const f32x4 cq = *(const f32x4*)(p + 4 * lane);
            const float c0 = p[256 + lane], c1 = p[320 + lane];
            const float k1 = p[384 + (lane & 31)], k2 = p[416 + (lane & 31)];
            const float ssq = wave_sum((cq.x * cq.x + cq.y * cq.y) + (cq.z * cq.z + cq.w * cq.w));
            const float ssk = wave_sum(c0 * c0 + c1 * c1);
            const float rq = 1.0f / sqrtf(ssq * (1.f / 256) + RMS_EPS), rk = 1.0f / sqrtf(ssk * (1.f / 128) + RMS_EPS);
            v2u w; w.x = pk2(cq.x * rq * gq.x, cq.y * rq * gq.y); w.y = pk2(cq.z * rq * gq.z, cq.w * rq * gq.w);
            *((v2u*)(CQB + (size_t)row * 256) + lane) = w;
            const float v0 = c0 * rk * gk0, v1 = c1 * rk * gk1;
            const f32x2 cs = R64[(size_t)row_pos(row) * 32 + (lane & 31)];
            const float kp = lane < 32 ? k1 * cs.x - k2 * cs.y : k1 * cs.y + k2 * cs.x;
            KVB[(size_t)row * KVW + lane] = (bf16)f2bf(v0); KVB[(size_t)row * KVW + 64 + lane] = (bf16)f2bf(v1); KVB[(size_t)row * KVW + 128 + lane] = (bf16)f2bf(kp);
            if (row < R_PROMPT) {
#pragma unroll
                for (int b = 0; b < NB; ++b) { float* oc = a.out + O_PCKV + ((size_t)b * LP + row) * 128; oc[lane] = v0; oc[64 + lane] = v1; a.out[O_PKPE + ((size_t)b * LP + row) * 64 + lane] = kp; }
            } else if (row < R_SAMPLE) {
                const int b = (row - R_PROMPT) >> 12, s = (row - R_PROMPT) & (SEQ - 1);
                float* oc = a.out + O_PCKV + ((size_t)b * LP + NMETA + s) * 128; oc[lane] = v0; oc[64 + lane] = v1; a.out[O_PKPE + ((size_t)b * LP + NMETA + s) * 64 + lane] = kp;
            } else if (row < R_VALID) {
                float* oc = a.out + O_SCKV + (size_t)(row - R_SAMPLE) * 128; oc[lane] = v0; oc[64 + lane] = v1; a.out[O_SKPE + (size_t)(row - R_SAMPLE) * 64 + lane] = kp;
            }
        }
    }
    bf16* KVC = (bf16*)(ws + WS_KVC);
    for (int r = gw; r < DBS * PAST; r += NGW) {
        const float v0 = a.in[2][(size_t)r * 128 + lane], v1 = a.in[2][(size_t)r * 128 + 64 + lane], kp = a.in[3][(size_t)r * 64 + lane];
        KVC[(size_t)r * KVW + lane] = (bf16)f2bf(v0); KVC[(size_t)r * KVW + 64 + lane] = (bf16)f2bf(v1); KVC[(size_t)r * KVW + 128 + lane] = (bf16)f2bf(kp);
    }
}

__device__ __forceinline__ int crow(int r, int hi) { return (r & 3) + 8 * (r >> 2) + 4 * hi; }
#define PK4(P, BASE, OUT) do { unsigned a0_ = pk2(P[BASE + 0], P[BASE + 1]), a1_ = pk2(P[BASE + 2], P[BASE + 3]);   \
    unsigned b0_ = pk2(P[BASE + 4], P[BASE + 5]), b1_ = pk2(P[BASE + 6], P[BASE + 7]);                              \
    auto r0_ = __builtin_amdgcn_permlane32_swap(a0_, b0_, false, false); auto r1_ = __builtin_amdgcn_permlane32_swap(a1_, b1_, false, false); \
    v4u w_ = {r0_[0], r1_[0], r0_[1], r1_[1]}; OUT = __builtin_bit_cast(bf16x8, w_); } while (0)
__device__ __forceinline__ float half_swap_max(float x) { auto rr = __builtin_amdgcn_permlane32_swap(__float_as_uint(x), __float_as_uint(x), false, false); return fmaxf(__uint_as_float(rr[0]), __uint_as_float(rr[1])); }
__device__ __forceinline__ float half_swap_sum(float x) { auto rr = __builtin_amdgcn_permlane32_swap(__float_as_uint(x), __float_as_uint(x), false, false); return __uint_as_float(rr[0]) + __uint_as_float(rr[1]); }


typedef short v4i16_t __attribute__((ext_vector_type(4)));
__device__ __forceinline__ unsigned offb(unsigned row, unsigned ch) { return 256u * row + 16u * (ch ^ (((row & 3) << 2) | ((row >> 2) & 3))); }
__device__ __forceinline__ unsigned offk(unsigned row, unsigned ch) { return 128u * row + 16u * (ch ^ ((row >> 1) & 7)); }
__device__ __forceinline__ bf16x8 rowfrag(LAS unsigned char* T, unsigned rb, unsigned lane, unsigned s) { return *(LAS bf16x8*)(T + offb(rb + (lane & 31), 2 * s + (lane >> 5))); }
__device__ __forceinline__ bf16x8 rowfrag64(LAS unsigned char* T, unsigned rb, unsigned lane, unsigned s) { return *(LAS bf16x8*)(T + offk(rb + (lane & 31), 2 * s + (lane >> 5))); }
__device__ __forceinline__ bf16x8 trfrag(LAS unsigned char* T, unsigned lane, unsigned c, unsigned ks) {
    const unsigned h = lane >> 5, blk = (lane >> 4) & 1, q = (lane & 15) >> 2, p = lane & 3, row = 16 * ks + 8 * h + q, ch = 4 * c + 2 * blk + (p >> 1);
    const v4i16_t lo = __builtin_amdgcn_ds_read_tr16_b64_v4i16((LAS v4i16_t*)(T + offb(row, ch) + 8 * (p & 1)));
    const v4i16_t hi = __builtin_amdgcn_ds_read_tr16_b64_v4i16((LAS v4i16_t*)(T + offb(row + 4, ch) + 8 * (p & 1)));
    return (bf16x8){lo[0], lo[1], lo[2], lo[3], hi[0], hi[1], hi[2], hi[3]};
}

constexpr int AT_TILE = 24576;
__device__ __forceinline__ const bf16* attn_tile_src(unsigned char* ws, int type, int bi, int t, int& nvalid) {
    const bf16* KVB = (const bf16*)(ws + WS_KVB); const bf16* KVC = (const bf16*)(ws + WS_KVC);
    if (t == 0) { nvalid = NMETA; return KVB; }
    if (type == 0) { nvalid = 64; return KVB + (size_t)(R_PROMPT + bi * SEQ + 64 * (t - 1)) * KVW; }
    if (t <= 16) { nvalid = 64; return KVC + ((size_t)bi * PAST + 64 * (t - 1)) * KVW; }
    nvalid = TS; return KVB + (size_t)(R_SAMPLE + TS * bi) * KVW;
}
__device__ __forceinline__ void attn_unit(const Args& a, LAS unsigned char* L, int type, int bi, int c, int qh, int tid) {
    asm volatile("" : "+v"(tid));
    unsigned char* ws = a.ws;
    const bf16* QA = (const bf16*)(ws + WS_QA); bf16* MIXA = (bf16*)(ws + WS_A16A);
    const int lane = tid & 63, wave = __builtin_amdgcn_readfirstlane(tid >> 6), g = wave >> 2, h = wave & 3, r32 = lane & 31, hi = lane >> 5;
    int qrow0, nq, nt;
    if (type == 0) { qrow0 = R_PROMPT + bi * SEQ + 64 * c + 32 * qh; nq = 32; nt = c + 2; }
    else if (type == 1) { qrow0 = R_SAMPLE + TS * bi; nq = 32; nt = 18; }
    else { qrow0 = 0; nq = 16; nt = 1; }
    const int nsteps = (nt + 1) >> 1;
    bf16x8 qr[12];
    { const bf16* qp = QA + (size_t)(qrow0 + r32) * NQA + h * KVW + hi * 8;
#pragma unroll
      for (int d0 = 0; d0 < 12; ++d0) qr[d0] = *(const bf16x8*)(qp + d0 * 16); }
    f32x16 o[4];
#pragma unroll
    for (int d = 0; d < 4; ++d)
#pragma unroll
        for (int r = 0; r < 16; ++r) o[d][r] = 0.f;
    float m_reg = -1e30f, l_reg = 0.f;
    unsigned rb_[8], kb_[4], tb_[8];
    { const unsigned X = ((r32 & 3) << 2) | ((r32 >> 2) & 3);
#pragma unroll
      for (int s = 0; s < 8; ++s) rb_[s] = 256u * r32 + 32u * (s ^ (X >> 1)) + 16u * (hi ^ (X & 1));
#pragma unroll
      for (int s = 0; s < 4; ++s) kb_[s] = 16384u + offk(r32, 2 * s + hi);
      const unsigned blk = (lane >> 4) & 1, q = (lane & 15) >> 2, p = lane & 3;
#pragma unroll
      for (int cb = 0; cb < 4; ++cb)
#pragma unroll
          for (int t = 0; t < 2; ++t) tb_[2 * cb + t] = 256u * (8 * hi + 4 * t + q) + 64u * (cb ^ q) + 16u * ((2 * blk + (p >> 1)) ^ ((2 * hi + t) & 3)) + 8u * (p & 1); }
    unsigned so_[6];
#pragma unroll
    for (int i = 0; i < 6; ++i) { const int pid = wave * 6 + i, pp = pid >= 24 ? pid - 24 : pid;
        if (pp < 16) { const unsigned row = 4 * pp + (lane >> 4), slot = lane & 15; so_[i] = row * KVW + 8 * (slot ^ (((row & 3) << 2) | ((row >> 2) & 3))); }
        else { const unsigned row = 8 * (pp - 16) + (lane >> 3), slot = lane & 7; so_[i] = row * KVW + 128 + 8 * (slot ^ ((row >> 1) & 7)); } }
#define AT_STAGE(step) do { _Pragma("unroll") for (int i_ = 0; i_ < 6; ++i_) { const int pid_ = wave * 6 + i_, tt_ = pid_ >= 24 ? 1 : 0, pp_ = pid_ - 24 * tt_, t_ = 2 * (step) + tt_; \
        if (t_ < nt) { int nv_; const bf16* src_ = attn_tile_src(ws, type, bi, t_, nv_); LAS unsigned char* T_ = L + (((step) & 1) * 2 + tt_) * AT_TILE + (pp_ < 16 ? pp_ * 1024 : 16384 + (pp_ - 16) * 1024); \
            __builtin_amdgcn_global_load_lds((const unsigned*)(src_ + so_[i_]), (LAS unsigned*)T_, 16, 0, 0); } } } while (0)
    AT_STAGE(0);
    __syncthreads();
    for (int s = 0; s < nsteps; ++s) {
        if (s + 1 < nsteps) AT_STAGE(s + 1);
        const int t = 2 * s + g;
        if (t < nt) {
            int nvalid; (void)attn_tile_src(ws, type, bi, t, nvalid);
            LAS unsigned char* T = L + ((s & 1) * 2 + g) * AT_TILE;
            f32x16 p0, p1;
#pragma unroll
            for (int r = 0; r < 16; ++r) { p0[r] = 0.f; p1[r] = 0.f; }
#pragma unroll
            for (int d0 = 0; d0 < 8; ++d0) {
                const bf16x8 k0 = *(LAS bf16x8*)(T + rb_[d0]), k1 = *(LAS bf16x8*)(T + rb_[d0] + 8192);
                p0 = __builtin_amdgcn_mfma_f32_32x32x16_bf16(k0, qr[d0], p0, 0, 0, 0);
                p1 = __builtin_amdgcn_mfma_f32_32x32x16_bf16(k1, qr[d0], p1, 0, 0, 0);
            }
#pragma unroll
            for (int d0 = 0; d0 < 4; ++d0) {
                const bf16x8 k0 = *(LAS bf16x8*)(T + kb_[d0]), k1 = *(LAS bf16x8*)(T + kb_[d0] + 4096);
                p0 = __builtin_amdgcn_mfma_f32_32x32x16_bf16(k0, qr[8 + d0], p0, 0, 0, 0);
                p1 = __builtin_amdgcn_mfma_f32_32x32x16_bf16(k1, qr[8 + d0], p1, 0, 0, 0);
            }
            if (nvalid < 64) {
#pragma unroll
                for (int r = 0; r < 16; ++r) { const int key = crow(r, hi); if (key >= nvalid) p0[r] = -1e30f; if (key + 32 >= nvalid) p1[r] = -1e30f; }
            }
            float pmax = p0[0];
#pragma unroll
            for (int r = 1; r < 16; ++r) pmax = fmaxf(pmax, p0[r]);
#pragma unroll
            for (int r = 0; r < 16; ++r) pmax = fmaxf(pmax, p1[r]);
            pmax = half_swap_max(pmax);
            const float mn = fmaxf(m_reg, pmax), alpha = __builtin_amdgcn_exp2f((m_reg - mn) * LOG2E); m_reg = mn;
            const float mnC = -mn * LOG2E; float ps = 0.f;
#pragma unroll
            for (int r = 0; r < 16; ++r) { p0[r] = __builtin_amdgcn_exp2f(fmaf(p0[r], LOG2E, mnC)); p1[r] = __builtin_amdgcn_exp2f(fmaf(p1[r], LOG2E, mnC)); ps += p0[r] + p1[r]; }
            ps = half_swap_sum(ps);
            l_reg = l_reg * alpha + ps;
            if (__any(alpha < 1.f)) {
#pragma unroll
                for (int r = 0; r < 16; ++r) { const float ar = __shfl(alpha, crow(r, hi));
#pragma unroll
                    for (int d = 0; d < 4; ++d) o[d][r] *= ar; }
            }
            bf16x8 pa0, pa1, pa2, pa3;
            PK4(p0, 0, pa0); PK4(p0, 8, pa1); PK4(p1, 0, pa2); PK4(p1, 8, pa3);
#define AT_TR(cb, ks) ({ const v4i16_t lo_ = __builtin_amdgcn_ds_read_tr16_b64_v4i16((LAS v4i16_t*)(T + tb_[2 * (cb)] + 4096 * (ks))), hi_ = __builtin_amdgcn_ds_read_tr16_b64_v4i16((LAS v4i16_t*)(T + tb_[2 * (cb) + 1] + 4096 * (ks))); \
                (bf16x8){lo_[0], lo_[1], lo_[2], lo_[3], hi_[0], hi_[1], hi_[2], hi_[3]}; })
#pragma unroll
            for (int d0 = 0; d0 < 4; ++d0) {
                const bf16x8 v0 = AT_TR(d0, 0), v1 = AT_TR(d0, 1), v2 = AT_TR(d0, 2), v3 = AT_TR(d0, 3);
                o[d0] = __builtin_amdgcn_mfma_f32_32x32x16_bf16(pa0, v0, o[d0], 0, 0, 0);
                o[d0] = __builtin_amdgcn_mfma_f32_32x32x16_bf16(pa1, v1, o[d0], 0, 0, 0);
                o[d0] = __builtin_amdgcn_mfma_f32_32x32x16_bf16(pa2, v2, o[d0], 0, 0, 0);
                o[d0] = __builtin_amdgcn_mfma_f32_32x32x16_bf16(pa3, v3, o[d0], 0, 0, 0);
            }
#undef AT_TR
        }
        __syncthreads();
    }
#undef AT_STAGE
    LAS float* M = (LAS float*)(L + h * 17408);
    if (g == 1) {
#pragma unroll
        for (int d = 0; d < 4; ++d)
#pragma unroll
            for (int r = 0; r < 16; ++r) M[(d * 16 + r) * 64 + lane] = o[d][r];
        M[4096 + lane] = m_reg; M[4160 + lane] = l_reg;
    }
    __syncthreads();
    if (g == 0) {
        const float m1 = M[4096 + lane], l1 = M[4160 + lane];
        const float mm = fmaxf(m_reg, m1), f0 = __builtin_amdgcn_exp2f((m_reg - mm) * LOG2E), f1 = __builtin_amdgcn_exp2f((m1 - mm) * LOG2E);
        const float rl = __builtin_amdgcn_rcpf(l_reg * f0 + l1 * f1), s0 = f0 * rl, s1 = f1 * rl;
#pragma unroll
        for (int r = 0; r < 16; ++r) { const int qi = crow(r, hi); const float a0 = __shfl(s0, qi), a1 = __shfl(s1, qi);
            bf16* op = MIXA + (size_t)(qrow0 + qi) * DM + 512 + h * 128 + r32;
#pragma unroll
            for (int d0 = 0; d0 < 4; ++d0) { const float v = o[d0][r] * a0 + M[(d0 * 16 + r) * 64 + lane] * a1; if (qi < nq) op[32 * d0] = (bf16)f2bf(v); } }
    }
    __syncthreads();
}

struct RetItem { int kind, bh, n; };
__device__ __forceinline__ void ret_geom(const RetItem& it, int& h, int& rowbase, int& tlo, int& thi, int& T) {
    if (it.kind == 0) { h = it.bh; rowbase = -48; tlo = 48; thi = 64; T = 64; }
    else if (it.kind == 1) { h = it.bh & 3; rowbase = R_PROMPT + (it.bh >> 2) * SEQ + 64 * (it.n - 1); tlo = 0; thi = 64; T = 64; }
    else { h = it.bh & 3; rowbase = R_SAMPLE + TS * (it.bh >> 2); tlo = 0; thi = TS; T = TS; }
}
__device__ __forceinline__ int kvn_index(const RetItem& it) { return it.kind == 0 ? it.bh : 4 + it.bh * 64 + (it.n - 1); }
__device__ __forceinline__ RetItem ret_item(int i) {
    if (i < 4) return RetItem{0, i, 0};
    if (i < 1028) { const int j = i - 4; return RetItem{1, j >> 6, (j & 63) + 1}; }
    return RetItem{2, i - 1028, 0};
}
constexpr int NRET = 4 + NB * 4 * 64 + DBS * 4;
template <bool DEC> __device__ __forceinline__ void ret_stage(LAS unsigned char* T_, const bf16* X, int rowbase, int h, int tlo, int thi, float lg2, int T, int tid) {
    const int ch = tid & 15;
#pragma unroll
    for (int i = 0; i < 2; ++i) {
        const int t = (tid >> 4) + 32 * i; v4u v = {0u, 0u, 0u, 0u};
        if (t >= tlo && t < thi) {
            v = *(const v4u*)(X + (size_t)(rowbase + t) * 512 + h * 128 + ch * 8);
            if (DEC) { const float d = __builtin_amdgcn_exp2f(lg2 * (float)(T - 1 - t));
                v.x = pk2(bflo(v.x) * d, bfhi(v.x) * d); v.y = pk2(bflo(v.y) * d, bfhi(v.y) * d); v.z = pk2(bflo(v.z) * d, bfhi(v.z) * d); v.w = pk2(bflo(v.w) * d, bfhi(v.w) * d); }
        }
        *(LAS v4u*)(T_ + offb(t, ch)) = v;
    }
}
__device__ __forceinline__ void ret_kv_item(const Args& a, LAS unsigned char* L, const RetItem& it, int tid) {
    asm volatile("" : "+v"(tid));
    unsigned char* ws = a.ws;
    const bf16* KR = (const bf16*)(ws + WS_KR); const bf16* VR = (const bf16*)(ws + WS_VR); bf16* KVN = (bf16*)(ws + WS_KVN);
    int h, rowbase, tlo, thi, T; ret_geom(it, h, rowbase, tlo, thi, T);
    const float lg2 = lg2gamma(h); const int lane = tid & 63, w = __builtin_amdgcn_readfirstlane(tid >> 6), r32 = lane & 31, hi = lane >> 5, ib = w >> 1, jb0 = 2 * (w & 1);
    LAS unsigned char* TK = L; LAS unsigned char* TV = L + 16384;
    ret_stage<false>(TK, KR, rowbase, h, tlo, thi, lg2, T, tid);
    ret_stage<true>(TV, VR, rowbase, h, tlo, thi, lg2, T, tid);
    __syncthreads();
    f32x16 c0, c1;
#pragma unroll
    for (int r = 0; r < 16; ++r) { c0[r] = 0.f; c1[r] = 0.f; }
#pragma unroll
    for (int ks = 0; ks < 4; ++ks) {
        const bf16x8 af = trfrag(TK, lane, ib, ks), b0 = trfrag(TV, lane, jb0, ks), b1 = trfrag(TV, lane, jb0 + 1, ks);
        c0 = __builtin_amdgcn_mfma_f32_32x32x16_bf16(af, b0, c0, 0, 0, 0);
        c1 = __builtin_amdgcn_mfma_f32_32x32x16_bf16(af, b1, c1, 0, 0, 0);
    }
    if (it.kind != 2) {
        bf16* dst = KVN + (size_t)kvn_index(it) * 16384;
#pragma unroll
        for (int rg = 0; rg < 4; ++rg) { const int dk0 = 32 * ib + 8 * rg + 4 * hi;
            v2u w0; w0.x = pk2(c0[4 * rg], c0[4 * rg + 1]); w0.y = pk2(c0[4 * rg + 2], c0[4 * rg + 3]);
            v2u w1; w1.x = pk2(c1[4 * rg], c1[4 * rg + 1]); w1.y = pk2(c1[4 * rg + 2], c1[4 * rg + 3]);
            *(v2u*)(dst + (size_t)(32 * jb0 + r32) * 128 + dk0) = w0; *(v2u*)(dst + (size_t)(32 * (jb0 + 1) + r32) * 128 + dk0) = w1; }
    } else {
        const float dec = __builtin_amdgcn_exp2f(lg2 * (float)T);
        const float* s0 = a.in[4] + (size_t)it.bh * 16384; float* so = a.out + O_SST + (size_t)it.bh * 16384;
#pragma unroll
        for (int r = 0; r < 16; ++r) { const size_t e = (size_t)(32 * ib + crow(r, hi)) * 128 + 32 * jb0 + r32;
            so[e] = dec * s0[e] + c0[r]; so[e + 32] = dec * s0[e + 32] + c1[r]; }
    }
    __syncthreads();
}
__device__ __forceinline__ void ret_out_item(const Args& a, LAS unsigned char* L, const RetItem& it, int tid) {
    asm volatile("" : "+v"(tid));
    unsigned char* ws = a.ws;
    const bf16* QR = (const bf16*)(ws + WS_QR); const bf16* KR = (const bf16*)(ws + WS_KR); const bf16* VR = (const bf16*)(ws + WS_VR); const bf16* GS = (const bf16*)(ws + WS_GS);
    const bf16* KVN = (const bf16*)(ws + WS_KVN); bf16* MIXA = (bf16*)(ws + WS_A16A);
    int h, rowbase, tlo, thi, T; ret_geom(it, h, rowbase, tlo, thi, T);
    const float lg2 = lg2gamma(h); const int lane = tid & 63, w = __builtin_amdgcn_readfirstlane(tid >> 6), r32 = lane & 31, hi = lane >> 5, qhalf = w & 1, cb = w >> 1;
    LAS unsigned char* TQ = L; LAS unsigned char* TK = L + 16384; LAS unsigned char* TV = L + 32768; LAS unsigned char* TS_ = L + 49152;
    LAS float* ST = (LAS float*)(L + 81920);
    ret_stage<false>(TQ, QR, rowbase, h, tlo, thi, lg2, T, tid);
    ret_stage<false>(TK, KR, rowbase, h, tlo, thi, lg2, T, tid);
    ret_stage<false>(TV, VR, rowbase, h, tlo, thi, lg2, T, tid);
    if (it.kind == 1) {
        const bf16* st = KVN + (size_t)kvn_index(it) * 16384;
#pragma unroll
        for (int i = 0; i < 4; ++i) { const int dv = (tid >> 4) + 32 * i, ch = tid & 15; *(LAS v4u*)(TS_ + offb(dv, ch)) = *(const v4u*)(st + (size_t)dv * 128 + ch * 8); }
    } else if (it.kind == 2) {
        const float* s0 = a.in[4] + (size_t)it.bh * 16384;
        for (int e = tid; e < 16384; e += 512) { const int dk = e >> 7, dv = e & 127; *(LAS unsigned short*)(TS_ + offb(dv, dk >> 3) + 2 * (dk & 7)) = (unsigned short)f2bf(s0[e]); }
    }
    __syncthreads();
    f32x16 o;
#pragma unroll
    for (int r = 0; r < 16; ++r) o[r] = 0.f;
    bf16x8 qr[8];
#pragma unroll
    for (int d0 = 0; d0 < 8; ++d0) qr[d0] = rowfrag(TQ, 32 * qhalf, lane, d0);
    if (it.kind != 0) {
#pragma unroll
        for (int kd = 0; kd < 8; ++kd) o = __builtin_amdgcn_mfma_f32_32x32x16_bf16(qr[kd], rowfrag(TS_, 32 * cb, lane, kd), o, 0, 0, 0);
#pragma unroll
        for (int r = 0; r < 16; ++r) o[r] *= __builtin_amdgcn_exp2f(lg2 * (float)(32 * qhalf + crow(r, hi) + 1));
    }
    f32x16 p0, p1;
#pragma unroll
    for (int r = 0; r < 16; ++r) { p0[r] = 0.f; p1[r] = 0.f; }
#pragma unroll
    for (int d0 = 0; d0 < 8; ++d0) {
        p0 = __builtin_amdgcn_mfma_f32_32x32x16_bf16(rowfrag(TK, 0, lane, d0), qr[d0], p0, 0, 0, 0);
        p1 = __builtin_amdgcn_mfma_f32_32x32x16_bf16(rowfrag(TK, 32, lane, d0), qr[d0], p1, 0, 0, 0);
    }
    const int tq = 32 * qhalf + r32;
#pragma unroll
    for (int r = 0; r < 16; ++r) { const int k0 = crow(r, hi), k1 = k0 + 32;
        p0[r] = tq >= k0 ? p0[r] * __builtin_amdgcn_exp2f(lg2 * (float)(tq - k0)) : 0.f;
        p1[r] = tq >= k1 ? p1[r] * __builtin_amdgcn_exp2f(lg2 * (float)(tq - k1)) : 0.f; }
    bf16x8 pa0, pa1, pa2, pa3;
    PK4(p0, 0, pa0); PK4(p0, 8, pa1); PK4(p1, 0, pa2); PK4(p1, 8, pa3);
    o = __builtin_amdgcn_mfma_f32_32x32x16_bf16(pa0, trfrag(TV, lane, cb, 0), o, 0, 0, 0);
    o = __builtin_amdgcn_mfma_f32_32x32x16_bf16(pa1, trfrag(TV, lane, cb, 1), o, 0, 0, 0);
    o = __builtin_amdgcn_mfma_f32_32x32x16_bf16(pa2, trfrag(TV, lane, cb, 2), o, 0, 0, 0);
    o = __builtin_amdgcn_mfma_f32_32x32x16_bf16(pa3, trfrag(TV, lane, cb, 3), o, 0, 0, 0);
#pragma unroll
    for (int r = 0; r < 16; ++r) {
        float s = o[r], q = o[r] * o[r];
#pragma unroll
        for (int off = 1; off < 32; off <<= 1) { s += __shfl_xor(s, off); q += __shfl_xor(q, off); }
        if (r32 == 0) { const int row = 32 * qhalf + crow(r, hi); ST[(row * 4 + cb) * 2] = s; ST[(row * 4 + cb) * 2 + 1] = q; }
    }
    __syncthreads();
    const float gain = a.in[11][h * 128 + 32 * cb + r32];
#pragma unroll
    for (int r = 0; r < 16; ++r) {
        const int t = 32 * qhalf + crow(r, hi);
        const LAS f32x4* sp = (const LAS f32x4*)(ST + t * 8);
        const f32x4 u0 = sp[0], u1 = sp[1];
        const float mean = ((u0.x + u0.z) + (u1.x + u1.z)) * (1.f / 128), var = fmaxf(((u0.y + u0.w) + (u1.y + u1.w)) * (1.f / 128) - mean * mean, 0.f);
        const float rstd = 1.0f / sqrtf(var + LN_EPS);
        if (t >= tlo && t < thi) { const size_t rb = (size_t)(rowbase + t); const int col = h * 128 + 32 * cb + r32;
            MIXA[rb * DM + col] = (bf16)f2bf((o[r] - mean) * rstd * gain * bf2f(GS[rb * 512 + col])); }
    }
    __syncthreads();
}


__device__ __forceinline__ void ret_scan(const Args& a, int gtid, int gthreads) {
    unsigned* KVN = (unsigned*)(a.ws + WS_KVN);
    for (int g = gtid; g < NB * 4 * 8192; g += gthreads) {
        const int bh = g >> 13, e2 = g & 8191, h = bh & 3;
        const float dec = __builtin_amdgcn_exp2f(lg2gamma(h) * 64.f);
        const unsigned w0 = KVN[(size_t)h * 8192 + e2];
        float s0 = bflo(w0), s1 = bfhi(w0);
        unsigned* p = KVN + (size_t)(4 + bh * 64) * 8192 + e2;
#pragma unroll 16
        for (int n = 0; n < 64; ++n) { const unsigned kv = p[(size_t)n * 8192]; p[(size_t)n * 8192] = pk2(s0, s1); s0 = dec * s0 + bflo(kv); s1 = dec * s1 + bfhi(kv); }
        const int dv = e2 >> 6, dk = (e2 & 63) * 2;
        float* so = a.out + O_PST + (size_t)bh * 16384;
        so[(size_t)dk * 128 + dv] = s0; so[(size_t)(dk + 1) * 128 + dv] = s1;
    }
}


#ifndef PROBE_DUP
#define PROBE_DUP -1
#endif
#define REPS(k) for (int rep_ = 0; rep_ < ((PROBE_DUP == (k)) ? 2 : 1); ++rep_)
constexpr int NWAVES = 8, LDS_BYTES = 147456, RING_BYTES = 131072, MISC_OFF = RING_BYTES + 320;

__global__ void __launch_bounds__(NWAVES * 64, 2) fwd_mega(Args a) {
    extern __shared__ __attribute__((aligned(16))) unsigned char lds[];
    LAS unsigned char* L = (LAS unsigned char*)lds;
    volatile LAS unsigned* MISC = (volatile LAS unsigned*)(L + MISC_OFF);
    int tid = threadIdx.x, lane = tid & 63, wave = __builtin_amdgcn_readfirstlane(tid >> 6);
    const int G = gridDim.x, bx = blockIdx.x;
    const int vcu = (G % 8 == 0) ? (bx % 8) * (G / 8) + bx / 8 : bx;
    int gw = vcu * NWAVES + wave, gtid = vcu * (NWAVES * 64) + tid; const int NGW = G * NWAVES, gthreads = G * NWAVES * 64;
#define PHASE_BEGIN() do { tid = threadIdx.x; asm volatile("" : "+v"(tid)); lane = tid & 63; wave = __builtin_amdgcn_readfirstlane(tid >> 6); gw = vcu * NWAVES + wave; gtid = vcu * (NWAVES * 64) + tid; } while (0)
    unsigned char* ws = a.ws;
    for (int u = tid; u < (LDS_BYTES - RING_BYTES) / 4; u += NWAVES * 64) ((LAS unsigned*)(L + RING_BYTES))[u] = 0u;
    __syncthreads();
    XcdBarrier bar = xcd_barrier_post((unsigned*)(ws + WS_CTL) + CW_BAR, MISC + 8);
#define GRID_BAR() do { xcd_barrier(bar); PHASE_BEGIN(); } while (0)
#define SCR ((LAS float*)(L + wave * 16384))

    bf16* WFI = (bf16*)(ws + WS_WFI); bf16* WFO = (bf16*)(ws + WS_WFO); bf16* WMI = (bf16*)(ws + WS_WMI); bf16* WMO = (bf16*)(ws + WS_WMO); bf16* WUQ = (bf16*)(ws + WS_WUQ);
    f32x2* R128 = (f32x2*)(ws + WS_R128); f32x2* R64 = (f32x2*)(ws + WS_R64);
    bf16* A16A = (bf16*)(ws + WS_A16A); bf16* A16B = (bf16*)(ws + WS_A16B); float* Z = (float*)(ws + WS_Z); bf16* HID = (bf16*)(ws + WS_HID);

    REPS(0) {
        transpose_matrix(a.in[6], DM, 2 * FF, WFI, 2 * FF, DM, 0, 0, SCR, gw, NGW, lane);
        transpose_matrix(a.in[7], FF, DM, WFO, DM, FF, 0, 1, SCR, gw, NGW, lane);
        transpose_matrix(a.in[10], DM, DIN, WMI, DINP, DM, 0, 2, SCR, gw, NGW, lane);
        transpose_matrix(a.in[16], 512, DM, WMO, DM, DM, 0, 1, SCR, gw, NGW, lane);
        transpose_matrix(a.in[13], 256, NQA, WUQ, 256, 256, 512, 3, SCR, gw, NGW, lane);
        const float* wuq = a.in[13]; const float* wukv = a.in[15]; const float* wmo = a.in[16];
        for (int idx = gtid; idx < 512 * 256; idx += gthreads) {
            const int k = idx & 255, np = idx >> 8, head = np >> 7, c = np & 127;
            const f32x4* x = (const f32x4*)(wuq + (size_t)k * NQA + head * KVW); const f32x4* y = (const f32x4*)(wukv + (size_t)c * 1024 + head * 256);
            float s = 0.f;
#pragma unroll 8
            for (int n = 0; n < 32; ++n) { const f32x4 xv = x[n], yv = y[n]; s += (xv.x * yv.x + xv.y * yv.y) + (xv.z * yv.z + xv.w * yv.w); }
            WUQ[(size_t)np * 256 + k] = (bf16)f2bf(s);
        }
        for (int idx = gtid; idx < 1024 * 64; idx += gthreads) {
            const int n = idx & 1023, hc = idx >> 10, head = hc >> 4, c8 = hc & 15;
            float s[8];
#pragma unroll
            for (int j = 0; j < 8; ++j) s[j] = 0.f;
            const float* wm = wmo + (size_t)(512 + head * 128) * DM + n; const float* uk = wukv + (size_t)(c8 * 8) * 1024 + head * 256 + 128;
            for (int v = 0; v < 128; ++v) { const float m = wm[(size_t)v * DM];
#pragma unroll
                for (int j = 0; j < 8; ++j) s[j] += uk[(size_t)j * 1024 + v] * m; }
            v4u w; w.x = pk2(s[0], s[1]); w.y = pk2(s[2], s[3]); w.z = pk2(s[4], s[5]); w.w = pk2(s[6], s[7]);
            *(v4u*)(WMO + (size_t)n * DM + 512 + head * 128 + c8 * 8) = w;
        }
        for (int idx = gtid; idx < LP * 64; idx += gthreads) {
            const int pos = idx >> 6, i = idx & 63;
            const float inv = (float)exp2(-(double)(2 * i) * (13.287712379549449 / 128.0));
            float sn, cs; sincos_acc((float)pos * inv, sn, cs);
            R128[idx] = (f32x2){cs, sn};
            if ((i & 1) == 0) R64[(size_t)pos * 32 + (i >> 1)] = (f32x2){cs, sn};
        }
        for (int r = gw; r < MTOT; r += NGW) {
            const float* xr = x_row(a, r); v2u* o = (v2u*)(A16A + (size_t)r * DM) + lane;
#pragma unroll
            for (int j = 0; j < 4; ++j) { v2u w = {0u, 0u}; if (xr) { const f32x4 v = *((const f32x4*)xr + lane + 64 * j); w.x = pk2(v.x, v.y); w.y = pk2(v.z, v.w); } o[64 * j] = w; }
        }
    }
    GRID_BAR();
#ifndef NO_P1
    REPS(1) { pg8::Gemm g{A16A, WFI, MTOT, 2 * FF, DM}; pg8::StaticOrder S; S.init(MTOT, 2 * FF, G, bx); EpiSwiglu E{HID};
      pg8::gemm_phase<EpiSwiglu, pg8::StaticOrder, true, true>(L, g, S, E); }
#endif
    GRID_BAR();
#ifndef NO_P2
    REPS(2) { pg8::Gemm g{HID, WFO, MTOT, DM, FF}; pg8::StaticOrder S; S.init(MTOT, DM, G, bx); EpiResZ<0> E{Z, nullptr, a, 0.5f};
      pg8::gemm_phase<EpiResZ<0>, pg8::StaticOrder, true, true>(L, g, S, E); }
#endif
    GRID_BAR();
    REPS(3) ln_rows<false>(a, Z, a.in[8], a.in[9], A16B, gw, NGW, lane);
    GRID_BAR();
#ifndef NO_P4
    REPS(4) { pg8::Gemm g{A16B, WMI, MTOT, DINP, DM}; pg8::StaticOrder S; S.init(MTOT, DINP, G, bx);
      EpiMixIn E{(bf16*)(ws + WS_QR), (bf16*)(ws + WS_KR), (bf16*)(ws + WS_VR), (bf16*)(ws + WS_GS), (float*)(ws + WS_P2RAW), R128};
      pg8::gemm_phase<EpiMixIn, pg8::StaticOrder, true, true>(L, g, S, E); }
#endif
    GRID_BAR();
    REPS(5) { post_rows(a, gw, NGW, lane);
    transpose_matrix(a.in[19], DM, 2 * FF, WFI, 2 * FF, DM, 0, 0, SCR, gw, NGW, lane);
    transpose_matrix(a.in[20], FF, DM, WFO, DM, FF, 0, 1, SCR, gw, NGW, lane); }
    GRID_BAR();
#ifndef NO_P6
    REPS(6) { int kq = 256; asm volatile("" : "+s"(kq));
      pg8::Gemm g{(const bf16*)(ws + WS_CQB), WUQ, MTOT, NQA, kq}; pg8::StaticOrder S; S.init(MTOT, NQA, G, bx); EpiUq E{(bf16*)(ws + WS_QA), R64};
      pg8::gemm_phase<EpiUq, pg8::StaticOrder, true, true>(L, g, S, E); }
#endif
    GRID_BAR();
    {
        REPS(70) for (int i = vcu; i < NRET; i += G) ret_kv_item(a, L, ret_item(i), tid);
        REPS(71) {
            const int b = vcu & 3, j = vcu >> 2, c1 = j >> 1, qh = j & 1, e = vcu / 15;
            const int nu = (vcu % 15 == 0 && e < DBS + 1) ? 3 : 2;
            for (int ui = 0; ui < nu; ++ui) {
                const int type = ui < 2 ? 0 : (e < DBS ? 1 : 2), bi = ui < 2 ? b : (e < DBS ? e : 0), cc = ui == 0 ? 63 - c1 : c1;
                attn_unit(a, L, type, bi, cc, qh, tid);
            }
        }
    }
    GRID_BAR();
    ret_scan(a, gtid, gthreads);
    GRID_BAR();
    REPS(9) for (int i = vcu; i < NRET; i += G) ret_out_item(a, L, ret_item(i), tid);
    GRID_BAR();
#ifndef NO_P10
    REPS(10) { pg8::Gemm g{A16A, WMO, MTOT, DM, DM}; pg8::StaticOrder S; S.init(MTOT, DM, G, bx); EpiResZ<1> E{Z, A16B, a, 1.0f};
      pg8::gemm_phase<EpiResZ<1>, pg8::StaticOrder, true, true>(L, g, S, E); }
#endif
    GRID_BAR();
    ln_rows<false>(a, Z, a.in[17], a.in[18], A16B, gw, NGW, lane);
    GRID_BAR();
#ifndef NO_P12
    REPS(12) { pg8::Gemm g{A16B, WFI, MTOT, 2 * FF, DM}; pg8::StaticOrder S; S.init(MTOT, 2 * FF, G, bx); EpiSwiglu E{HID};
      pg8::gemm_phase<EpiSwiglu, pg8::StaticOrder, true, true>(L, g, S, E); }
#endif
    GRID_BAR();
#ifndef NO_P13
    REPS(13) { pg8::Gemm g{HID, WFO, MTOT, DM, FF}; pg8::StaticOrder S; S.init(MTOT, DM, G, bx); EpiResZ<1> E{Z, A16B, a, 0.5f};
      pg8::gemm_phase<EpiResZ<1>, pg8::StaticOrder, true, true>(L, g, S, E); }
#endif
    GRID_BAR();
    ln_rows<true>(a, Z, a.in[21], a.in[22], nullptr, gw, NGW, lane);
#undef GRID_BAR
}

extern "C" void kernel_launch(void* const* d_in, const int* in_sizes, int n_in, void* d_out, int out_size, void* d_ws, size_t ws_size, hipStream_t stream) {
    static int grid = 0;
    if (grid == 0) {
        if (n_in != 23 || out_size != (int)O_END || ws_size < WS_END) { fprintf(stderr, "kernel_launch: unexpected shapes (n_in %d, out %d, ws %zu; need 23, %zu, >= %zu)\n", n_in, out_size, ws_size, (size_t)O_END, (size_t)WS_END); grid = -1; return; }
        int dev = 0, cus = 0, per_cu = 0;
        if (hipGetDevice(&dev) != hipSuccess || hipDeviceGetAttribute(&cus, hipDeviceAttributeMultiprocessorCount, dev) != hipSuccess) { grid = -1; return; }
        if (hipFuncSetAttribute((const void*)fwd_mega, hipFuncAttributeMaxDynamicSharedMemorySize, LDS_BYTES) != hipSuccess) { fprintf(stderr, "kernel_launch: hipFuncSetAttribute failed\n"); grid = -1; return; }
        if (hipOccupancyMaxActiveBlocksPerMultiprocessor(&per_cu, (const void*)fwd_mega, NWAVES * 64, LDS_BYTES) != hipSuccess || per_cu < 1) { fprintf(stderr, "kernel_launch: occupancy query says %d blocks per CU\n", per_cu); per_cu = 1; }
        (void)hipGetLastError();
        grid = cus;
    }
    if (grid < 0) return;
    (void)hipMemsetAsync((char*)d_ws + WS_CTL, 0, CTL_BYTES, stream);
    Args a{};
    for (int i = 0; i < 23; ++i) a.in[i] = (const float*)d_in[i];
    a.out = (float*)d_out; a.ws = (unsigned char*)d_ws;
    void* args[] = {&a};
    hipError_t e = hipLaunchCooperativeKernel((const void*)fwd_mega, dim3(grid), dim3(NWAVES * 64), args, LDS_BYTES, stream);
    if (e != hipSuccess) fprintf(stderr, "kernel_launch: cooperative launch failed: %s (grid %d)\n", hipGetErrorString(e), grid);
}
```

```cpp
#include <hip/hip_runtime.h>
#include <hip/hip_cooperative_groups.h>
#include <cstdio>
#include <cstdint>

namespace pg8 {
#define PG8_LAS __attribute__((address_space(3)))
typedef unsigned short bf16_t;
typedef short bf16x8 __attribute__((ext_vector_type(8)));
typedef float f32x4 __attribute__((ext_vector_type(4)));
typedef unsigned u32x4 __attribute__((ext_vector_type(4)));
constexpr int BM = 256, BK = 64, HALF = 128, HTB = HALF * BK * 2  , STAGE_BYTES = 8 * HTB, NXCD = 8, WGM = 8;

__host__ __device__ __forceinline__ int lds_byte(int r, int c) { const int st = (r >> 4) * 2 + (c >> 5), rr = r & 15, cc = c & 31, ob = rr * 64 + cc * 2; return st * 1024 + (ob ^ (((ob >> 9) & 1) << 5)); }
__host__ __device__ __forceinline__ void stage_rc(int b, int& R, int& C) { const int st = b / 1024, sb = b % 1024, swz = sb ^ (((sb >> 9) & 1) << 5); R = (st >> 1) * 16 + swz / 64; C = (st & 1) * 32 + (swz % 64) / 2; }
__host__ __device__ __forceinline__ int perm32(int rho) { const int n = rho >> 4, i = rho & 15; return 8 * (i >> 2) + 4 * n + (i & 3); }

struct Unit { int pm, pn, kt0, nkt, slab; };
struct SplitOrder;
struct Gemm { const bf16_t* A; const bf16_t* Bt; int M, N, K; };

struct StaticOrder {
    int nM, nN, nwg, G, c, nkt;
    __host__ __device__ void init(int M, int N, int G_, int c_, int K_) { nM = M / BM; nN = N / BM; nwg = nM * nN; G = G_; c = c_; nkt = K_ / BK; }
    __host__ __device__ bool next(int i, Unit& u) const {
        const long L = (long)i * G + c; if (L >= nwg) return false;
        int wgid = (int)L; { const int q = nwg / NXCD, r = nwg % NXCD, xcd = wgid % NXCD, off = wgid / NXCD; wgid = (xcd < r ? xcd * (q + 1) : r * (q + 1) + (xcd - r) * q) + off; }
        const int nig = WGM * nN, gid = wgid / nig, fm = gid * WGM, gsz = (nM - fm) < WGM ? (nM - fm) : WGM;
        u.pm = fm + ((wgid % nig) % gsz); u.pn = (wgid % nig) / gsz; u.kt0 = 0; u.nkt = nkt; u.slab = -1; return true;
    }
    __device__ __forceinline__ void a_ready(const Unit&) const {}
    __device__ __forceinline__ void done(const Unit&) const {}
};
struct SplitOrder {
    StaticOrder main; int nMain, nN, spu, kts, nslice, c;
    __host__ __device__ void init(int Mmain, int Mtot, int N, int G_, int c_, int K_, int spu_) { main.init(Mmain, N, G_, c_, K_); nMain = Mmain / BM; nN = N / BM; spu = spu_; kts = (K_ / BK) / spu_; nslice = (Mtot / BM - nMain) * nN * spu_; c = c_; }
    __host__ __device__ bool next(int i, Unit& u) const {
        if (i == 0) return main.next(0, u);
        if (i > 1 || c >= nslice) return false;
        const int e = c / spu, s = c % spu; u.pm = nMain + e / nN; u.pn = e % nN; u.kt0 = s * kts; u.nkt = kts; u.slab = c; return true;
    }
    __device__ __forceinline__ void a_ready(const Unit&) const {}
    __device__ __forceinline__ void done(const Unit&) const {}
};


__device__ __forceinline__ unsigned cvt_pk_bf16(float lo, float hi) { unsigned r; asm volatile("v_cvt_pk_bf16_f32 %0, %1, %2" : "=v"(r) : "v"(lo), "v"(hi)); return r; }
typedef float f32x2 __attribute__((ext_vector_type(2)));

template <class Epi, class Sched, bool ALIGN_EPI = false, bool SP2 = false>
__device__ __forceinline__ void gemm_phase(PG8_LAS unsigned char* lds, const Gemm g, const Sched& S, const Epi& E, float* slabs = nullptr) {
    int tid_ = threadIdx.x; asm volatile("" : "+v"(tid_));
    const int tid = tid_, wid = __builtin_amdgcn_readfirstlane(tid >> 6), lane = tid & 63, wr = wid >> 2, wc = wid & 3, fr = lane & 15, fq = lane >> 4;
    const int K = g.K;
    unsigned voffA[2], voffB[2];
#pragma unroll
    for (int i = 0; i < 2; ++i) { int R, C; stage_rc(tid * 16 + i * 8192, R, C); const int Rb = Epi::PERM ? ((R & ~31) + perm32(R & 31)) : R;
        voffA[i] = (unsigned)(R * K + C) * 2u; voffB[i] = (unsigned)(Rb * K + C) * 2u; }
    const size_t kstep = (size_t)(BK * 2);
    const size_t hstep = (size_t)HALF * K * 2;
    const size_t tstep = 2 * hstep;
    const unsigned ldsw = (unsigned)wid * 1024u;
    const int aoff = lds_byte(wr * 64 + fr, fq * 8), boff = lds_byte(wc * 32 + fr, fq * 8);
#define PG8_SA(b, h) (((b) * 2 + (h)) * HTB)
#define PG8_SB(b, h) ((4 + (b) * 2 + (h)) * HTB)
#define PG8_STAGE(bufoff, gbase, voff) do { _Pragma("unroll") for (int _i = 0; _i < 2; ++_i) \
        __builtin_amdgcn_global_load_lds((const unsigned*)((const char*)(gbase) + (voff)[_i]), (PG8_LAS unsigned*)(lds + (bufoff) + ldsw + _i * 8192), 16, 0, 0); } while (0)
#define PG8_LDA(dst, b, h) do { _Pragma("unroll") for (int m = 0; m < 4; ++m) _Pragma("unroll") for (int k = 0; k < 2; ++k) dst[m][k] = *(const PG8_LAS bf16x8*)(lds + PG8_SA(b, h) + aoff + m * 2048 + k * 1024); } while (0)
#define PG8_LDB(dst, b, h) do { _Pragma("unroll") for (int n = 0; n < 2; ++n) _Pragma("unroll") for (int k = 0; k < 2; ++k) dst[n][k] = *(const PG8_LAS bf16x8*)(lds + PG8_SB(b, h) + boff + n * 2048 + k * 1024); } while (0)
#define PG8_MMA(ai, bj, At, Bt) do { __builtin_amdgcn_s_setprio(1); _Pragma("unroll") for (int m = 0; m < 4; ++m) _Pragma("unroll") for (int n = 0; n < 2; ++n) _Pragma("unroll") for (int k = 0; k < 2; ++k) \
        acc[ai][bj][m][n] = __builtin_amdgcn_mfma_f32_16x16x32_bf16(Bt[n][k], At[m][k], acc[ai][bj][m][n], 0, 0, 0); __builtin_amdgcn_s_setprio(0); } while (0)
#define PG8_WAIT_V(n) asm volatile("s_waitcnt vmcnt(" #n ")" ::: "memory")
#define PG8_WAIT_L(n) asm volatile("s_waitcnt lgkmcnt(" #n ")" ::: "memory")
#define PG8_BAR __builtin_amdgcn_s_barrier()
#define PG8_SCHED __builtin_amdgcn_sched_barrier(0)
    Unit cur, nxt; int ui = 0;
    if (!S.next(0, cur)) return;
    f32x4 acc[2][2][4][2];
#pragma unroll
    for (int a = 0; a < 2; ++a)
#pragma unroll
        for (int b = 0; b < 2; ++b)
#pragma unroll
            for (int m = 0; m < 4; ++m)
#pragma unroll
                for (int n = 0; n < 2; ++n) acc[a][b][m][n] = (f32x4){0.f, 0.f, 0.f, 0.f};
    bf16x8 At[4][2], B0[2][2], B1[2][2];
    const char* cA = (const char*)g.A + (size_t)cur.pm * tstep + (size_t)cur.kt0 * kstep; const char* cB = (const char*)g.Bt + (size_t)cur.pn * tstep + (size_t)cur.kt0 * kstep;
    S.a_ready(cur);
    if constexpr (SP2) {
        PG8_STAGE(PG8_SB(0, 0), cB, voffB); PG8_STAGE(PG8_SB(0, 1), cB + hstep, voffB); PG8_STAGE(PG8_SA(0, 0), cA, voffA); PG8_STAGE(PG8_SA(0, 1), cA + hstep, voffA);
        if (wr == 1) PG8_BAR;
        PG8_WAIT_V(2); PG8_BAR;
        PG8_STAGE(PG8_SB(1, 0), cB + kstep, voffB); PG8_STAGE(PG8_SA(1, 0), cA + kstep, voffA); PG8_STAGE(PG8_SB(1, 1), cB + hstep + kstep, voffB);
        PG8_WAIT_V(6); PG8_BAR;
    } else {
        PG8_STAGE(PG8_SB(0, 0), cB, voffB); PG8_STAGE(PG8_SA(0, 0), cA, voffA); PG8_STAGE(PG8_SB(0, 1), cB + hstep, voffB); PG8_STAGE(PG8_SA(0, 1), cA + hstep, voffA);
        if (wr == 1) PG8_BAR;
        PG8_WAIT_V(4); PG8_BAR;
        PG8_STAGE(PG8_SB(1, 0), cB + kstep, voffB); PG8_STAGE(PG8_SA(1, 0), cA + kstep, voffA); PG8_STAGE(PG8_SB(1, 1), cB + hstep + kstep, voffB);
        PG8_WAIT_V(6); PG8_BAR;
    }
    for (;;) {
        const bool has_next = S.next(ui + 1, nxt);
        const char* nA = has_next ? (const char*)g.A + (size_t)nxt.pm * tstep + (size_t)nxt.kt0 * kstep : cA; const char* nB = has_next ? (const char*)g.Bt + (size_t)nxt.pn * tstep + (size_t)nxt.kt0 * kstep : cB;
        const int nt = cur.nkt;
        for (int t = 0; t < nt; t += 2) {
            const bool last = (t == nt - 2);
            const char* a1 = cA + (size_t)(t + 1) * kstep;
            const char* a2 = last ? nA : cA + (size_t)(t + 2) * kstep; const char* b2 = last ? nB : cB + (size_t)(t + 2) * kstep;
            const char* a3 = a2 + kstep; const char* b3 = b2 + kstep;
            if (last && has_next) S.a_ready(nxt);
            if constexpr (SP2) {
            PG8_LDB(B0, 0, 0); PG8_LDB(B1, 0, 1); PG8_SCHED; PG8_LDA(At, 0, 0); PG8_STAGE(PG8_SA(1, 1), a1 + hstep, voffA);
            PG8_WAIT_V(8); PG8_WAIT_L(0); PG8_BAR; PG8_MMA(0, 0, At, B0); PG8_MMA(0, 1, At, B1); PG8_BAR; PG8_SCHED;
            PG8_LDA(At, 0, 1); PG8_STAGE(PG8_SB(0, 0), b2, voffB); PG8_STAGE(PG8_SB(0, 1), b2 + hstep, voffB); PG8_STAGE(PG8_SA(0, 0), a2, voffA);
            PG8_WAIT_V(8); PG8_WAIT_L(0); PG8_BAR; PG8_MMA(1, 0, At, B0); PG8_MMA(1, 1, At, B1); PG8_BAR; PG8_SCHED;
            PG8_LDB(B0, 1, 0); PG8_LDB(B1, 1, 1); PG8_SCHED; PG8_LDA(At, 1, 0); PG8_STAGE(PG8_SA(0, 1), a2 + hstep, voffA);
            PG8_WAIT_V(8); PG8_WAIT_L(0); PG8_BAR; PG8_MMA(0, 0, At, B0); PG8_MMA(0, 1, At, B1); PG8_BAR; PG8_SCHED;
            PG8_LDA(At, 1, 1); PG8_STAGE(PG8_SB(1, 0), b3, voffB); PG8_STAGE(PG8_SB(1, 1), b3 + hstep, voffB); PG8_STAGE(PG8_SA(1, 0), a3, voffA);
            PG8_WAIT_V(8); PG8_WAIT_L(0); PG8_BAR; PG8_MMA(1, 0, At, B0); PG8_MMA(1, 1, At, B1); PG8_BAR; PG8_SCHED;
            } else {
            PG8_LDB(B0, 0, 0); PG8_SCHED; PG8_LDA(At, 0, 0); PG8_STAGE(PG8_SA(1, 1), a1 + hstep, voffA);
            PG8_WAIT_L(8); PG8_BAR; PG8_WAIT_L(0); PG8_MMA(0, 0, At, B0); PG8_BAR; PG8_SCHED;
            PG8_LDB(B1, 0, 1); PG8_STAGE(PG8_SB(0, 0), b2, voffB);
            PG8_BAR; PG8_WAIT_L(0); PG8_MMA(0, 1, At, B1); PG8_BAR;
            PG8_LDA(At, 0, 1); PG8_STAGE(PG8_SA(0, 0), a2, voffA);
            PG8_BAR; PG8_WAIT_L(0); PG8_MMA(1, 0, At, B0); PG8_BAR; PG8_SCHED;
            PG8_STAGE(PG8_SB(0, 1), b2 + hstep, voffB);
            PG8_WAIT_V(6); PG8_BAR; PG8_MMA(1, 1, At, B1); PG8_BAR;
            PG8_LDB(B0, 1, 0); PG8_SCHED; PG8_LDA(At, 1, 0); PG8_STAGE(PG8_SA(0, 1), a2 + hstep, voffA);
            PG8_WAIT_L(8); PG8_BAR; PG8_WAIT_L(0); PG8_MMA(0, 0, At, B0); PG8_BAR; PG8_SCHED;
            PG8_LDB(B1, 1, 1); PG8_STAGE(PG8_SB(1, 0), b3, voffB);
            PG8_BAR; PG8_WAIT_L(0); PG8_MMA(0, 1, At, B1); PG8_BAR;
            PG8_LDA(At, 1, 1); PG8_STAGE(PG8_SA(1, 0), a3, voffA);
            PG8_BAR; PG8_WAIT_L(0); PG8_MMA(1, 0, At, B0); PG8_BAR; PG8_SCHED;
            PG8_STAGE(PG8_SB(1, 1), b3 + hstep, voffB);
            PG8_WAIT_V(6); PG8_BAR; PG8_MMA(1, 1, At, B1); PG8_BAR;
            }
        }
        if constexpr (ALIGN_EPI) { if (wr == 0) PG8_BAR; }
        if constexpr (!Epi::AFTER_DRAIN) {
            if (cur.slab >= 0) {
                float* sb = slabs + (size_t)cur.slab * 65536 + (size_t)(wr * 64 + fr) * 256 + wc * 32 + 4 * fq;
#pragma unroll
                for (int ai = 0; ai < 2; ++ai)
#pragma unroll
                    for (int m = 0; m < 4; ++m)
#pragma unroll
                        for (int bj = 0; bj < 2; ++bj)
#pragma unroll
                            for (int n = 0; n < 2; ++n) *(f32x4*)(sb + (size_t)(ai * 128 + m * 16) * 256 + bj * 128 + n * 16) = acc[ai][bj][m][n];
            } else E(acc, cur, wr, wc, fr, fq);
            S.done(cur); }
        if (!has_next) break;
#pragma unroll
        for (int a = 0; a < 2; ++a)
#pragma unroll
            for (int b = 0; b < 2; ++b)
#pragma unroll
                for (int m = 0; m < 4; ++m)
#pragma unroll
                    for (int n = 0; n < 2; ++n) acc[a][b][m][n] = (f32x4){0.f, 0.f, 0.f, 0.f};
        cur = nxt; cA = nA; cB = nB; ++ui;
        if constexpr (ALIGN_EPI) { if (wr == 1) PG8_BAR; }
    }
    PG8_WAIT_V(0);
    if constexpr (!ALIGN_EPI) { if (wr == 0) PG8_BAR; }
    PG8_BAR;
    if constexpr (Epi::AFTER_DRAIN) { E.fused(acc, cur, wr, wc, fr, fq, lds, wid, lane); S.done(cur); }
#undef PG8_SA
#undef PG8_SB
#undef PG8_STAGE
#undef PG8_LDA
#undef PG8_LDB
#undef PG8_MMA
#undef PG8_WAIT_V
#undef PG8_WAIT_L
#undef PG8_BAR
#undef PG8_SCHED
}
}

#define LAS __attribute__((address_space(3)))

#define XB_TMO      128
#define XB_XCNT(j)  (256  + 64 * (j))
#define XB_XSUB(j)  (1280 + 64 * (j))
#define XB_XGEN(j)  (2304 + 64 * (j))
#define XB_TOP      3328
#define XB_TOPGEN   3392
#define XCD_BAR_WORDS 3456
#define XB_SPIN_CAP (1u << 18)

__device__ __forceinline__ unsigned xb_ld(unsigned* p)              { return __hip_atomic_load(p, __ATOMIC_RELAXED, __HIP_MEMORY_SCOPE_AGENT); }
__device__ __forceinline__ unsigned xb_add(unsigned* p, unsigned v) { return __hip_atomic_fetch_add(p, v, __ATOMIC_RELAXED, __HIP_MEMORY_SCOPE_AGENT); }
__device__ __forceinline__ unsigned xb_xcc_id() { return (unsigned)__builtin_amdgcn_s_getreg((3 << 11) | 20) & 0xFu; }
#define XB_SPIN(cond, bar) do { unsigned _sp = 0; while (cond) { __builtin_amdgcn_s_sleep(1); \
    if ((++_sp & 255u) == 0u) { if (xb_ld(&(bar)[XB_TMO])) break; if (_sp > XB_SPIN_CAP) { atomicAdd(&(bar)[XB_TMO], 1u); break; } } } } while (0)

struct XcdBarrier {
    unsigned* bar; unsigned x;
    volatile LAS unsigned* st;
};

__device__ __forceinline__ XcdBarrier xcd_barrier_post(unsigned* bar, volatile LAS unsigned* st) {
    XcdBarrier b; b.bar = bar; b.x = xb_xcc_id(); b.st = st;
    if (threadIdx.x == 0) (void)xb_add(&bar[XB_XCNT(b.x)], 1u);
    return b;
}
__device__ __forceinline__ void xcd_barrier_complete(unsigned* bar, unsigned x, unsigned& nloc, unsigned& nx) {
    const unsigned G = gridDim.x * gridDim.y * gridDim.z;
    unsigned sum, cnt, mine, sp = 0u;
    for (;;) {
        sum = 0u; cnt = 0u; mine = 0u;
#pragma unroll
        for (unsigned j = 0; j < 16; ++j) { const unsigned c = xb_ld(&bar[XB_XCNT(j)]); sum += c; cnt += (c > 0u) ? 1u : 0u; mine = (j == x) ? c : mine; }
        if (sum == G) break;
        __builtin_amdgcn_s_sleep(1);
        if ((++sp & 255u) == 0u) { if (xb_ld(&bar[XB_TMO])) break; if (sp > XB_SPIN_CAP) { atomicAdd(&bar[XB_TMO], 1u); break; } }
    }
    nloc = mine > 0u ? mine : 1u; nx = cnt > 0u ? cnt : 1u;
}

__device__ __forceinline__ void xcd_barrier(const XcdBarrier& b) {
    asm volatile("s_waitcnt vmcnt(0)" ::: "memory");
    __syncthreads();
    if (threadIdx.x == 0) {
        unsigned* bar = b.bar;
        __builtin_amdgcn_s_waitcnt(0);
        unsigned nloc = b.st[0], nx = b.st[1];
        if (nloc == 0u) { xcd_barrier_complete(bar, b.x, nloc, nx); b.st[0] = nloc; b.st[1] = nx; }
        const unsigned old = xb_add(&bar[XB_XSUB(b.x)], 1u);
        const unsigned gen = old / nloc;
        if (old + 1u == (gen + 1u) * nloc) {
            __builtin_amdgcn_fence(__ATOMIC_RELEASE, "agent");
            asm volatile("s_waitcnt vmcnt(0)" ::: "memory");
            const unsigned og = xb_add(&bar[XB_TOP], 1u);
            const unsigned tg = og / nx;
            if (og + 1u == (tg + 1u) * nx) xb_add(&bar[XB_TOPGEN], 1u);
            else XB_SPIN(xb_ld(&bar[XB_TOPGEN]) == tg, bar);
            __builtin_amdgcn_fence(__ATOMIC_ACQUIRE, "agent");
            xb_add(&bar[XB_XGEN(b.x)], 1u);
            asm volatile("s_waitcnt vmcnt(0)" ::: "memory");
        } else {
            XB_SPIN(xb_ld(&bar[XB_XGEN(b.x)]) == gen, bar);
            __builtin_amdgcn_fence(__ATOMIC_ACQUIRE, "agent");
            asm volatile("s_waitcnt vmcnt(0)" ::: "memory");
        }
    }
    __syncthreads();
}


#define GAS __attribute__((address_space(1)))

typedef unsigned short bf16;
typedef unsigned v4u __attribute__((ext_vector_type(4)));
typedef unsigned v2u __attribute__((ext_vector_type(2)));
typedef float f32x4 __attribute__((ext_vector_type(4)));
typedef float f32x2 __attribute__((ext_vector_type(2)));
typedef float f32x16 __attribute__((ext_vector_type(16)));
typedef short bf16x8 __attribute__((ext_vector_type(8)));
#define LDS_WAIT() asm volatile("s_waitcnt lgkmcnt(0)" ::: "memory")
#define VM_WAIT() asm volatile("s_waitcnt vmcnt(0)" ::: "memory")

constexpr int DM = 1024, NMETA = 16, SEQ = 4096, NB = 4, DBS = 16, TS = 32, PAST = 1024, FF = 2816, LP = NMETA + SEQ;
constexpr int R_PROMPT = 16, R_SAMPLE = R_PROMPT + NB * SEQ, R_VALID = R_SAMPLE + DBS * TS, MTOT = 17152;
static_assert(R_SAMPLE == 16400 && R_VALID == 16912 && MTOT % 256 == 0 && MTOT >= R_VALID + 64, "row space");
constexpr int DIN = 2496, DINP = 2560, NQA = 768, KVW = 192;
constexpr float DN_ALPHA = 1.189207115002721f, LN_EPS = 1e-5f, RMS_EPS = 1e-6f, LOG2E = 1.4426950408889634f;
constexpr float SM_SCALE = 0.07216878364870322f;
constexpr float KR_SCALE = 0.08838834764831845f;
constexpr size_t O_YP = 0, O_YS = O_YP + (size_t)NB * SEQ * DM, O_PCKV = O_YS + (size_t)DBS * TS * DM, O_PKPE = O_PCKV + (size_t)NB * LP * 128, O_PST = O_PKPE + (size_t)NB * LP * 64,
                 O_SCKV = O_PST + (size_t)NB * 4 * 128 * 128, O_SKPE = O_SCKV + (size_t)DBS * TS * 128, O_SST = O_SKPE + (size_t)DBS * TS * 64, O_END = O_SST + (size_t)DBS * 4 * 128 * 128;
static_assert(O_END == 21868544, "d_out size");

constexpr size_t al256(size_t x) { return (x + 255) & ~(size_t)255; }
constexpr size_t WS_CTL = 0, CTL_BYTES = 1u << 20;
constexpr size_t WS_WFI = WS_CTL + CTL_BYTES;
constexpr size_t WS_WFO = WS_WFI + (size_t)5632 * 1024 * 2;
constexpr size_t WS_WMI = WS_WFO + (size_t)1024 * 2816 * 2;
constexpr size_t WS_WMO = WS_WMI + (size_t)2560 * 1024 * 2;
constexpr size_t WS_WUQ = WS_WMO + (size_t)1024 * 1024 * 2;
constexpr size_t WS_R128 = WS_WUQ + (size_t)768 * 256 * 2;
constexpr size_t WS_R64 = WS_R128 + (size_t)LP * 64 * 8;
constexpr size_t WS_A16A = al256(WS_R64 + (size_t)LP * 32 * 8);
constexpr size_t A16_BYTES = (size_t)MTOT * 1024 * 2;
constexpr size_t WS_A16B = WS_A16A + A16_BYTES;
constexpr size_t WS_Z = WS_A16B + A16_BYTES;
constexpr size_t Z_BYTES = (size_t)MTOT * 1024 * 4;
constexpr size_t WS_HID = WS_Z + Z_BYTES;
constexpr size_t HID_BYTES = (size_t)MTOT * 2816 * 2;
constexpr size_t WS_END = WS_HID + HID_BYTES;
static_assert(WS_END <= 268435456, "workspace map exceeds 256 MiB");
constexpr size_t WS_P2RAW = WS_Z;
constexpr size_t WS_QA = WS_Z;
constexpr size_t WS_KVN = WS_QA + (size_t)MTOT * 768 * 2;
constexpr int KVN_ITEMS = 4 + NB * 4 * 64;
constexpr size_t WS_KVCT = WS_KVN + (size_t)KVN_ITEMS * 32768;
constexpr size_t WS_CKVT = WS_KVCT + (size_t)DBS * 128 * PAST * 2;
static_assert(WS_CKVT + (size_t)128 * MTOT * 2 <= WS_Z + Z_BYTES && WS_KVCT >= WS_P2RAW + (size_t)MTOT * 512 * 4, "Z overlays");
constexpr size_t RB_BYTES = (size_t)MTOT * 512 * 2;
constexpr size_t WS_QR = WS_HID, WS_KR = WS_QR + RB_BYTES, WS_VR = WS_KR + RB_BYTES, WS_GS = WS_VR + RB_BYTES;
constexpr size_t WS_KVB = WS_GS + RB_BYTES;
constexpr size_t WS_KVC = WS_KVB + (size_t)MTOT * KVW * 2;
constexpr size_t WS_CQB = WS_KVC + (size_t)DBS * PAST * KVW * 2;
static_assert(WS_CQB + (size_t)MTOT * 256 * 2 <= WS_HID + HID_BYTES, "HID overlays");
constexpr int CW_BAR = 4096;

__device__ __forceinline__ float lg2gamma(int h) { return h == 0 ? -0.04580368961312479f : h == 1 ? -0.02272007650008353f : h == 2 ? -0.011315313227834146f : -0.005646563141142063f; }

__device__ __forceinline__ int row_pos(int r) { return r < R_PROMPT ? r : (r < R_SAMPLE ? NMETA + ((r - R_PROMPT) & (SEQ - 1)) : (r < R_VALID ? NMETA + PAST + ((r - R_SAMPLE) & (TS - 1)) : 0)); }
__device__ __forceinline__ unsigned f2bf(float f) { unsigned u = __builtin_bit_cast(unsigned, f); return (u + 0x7fffu + ((u >> 16) & 1u)) >> 16; }
__device__ __forceinline__ unsigned pk2(float lo, float hi) { return pg8::cvt_pk_bf16(lo, hi); }
__device__ __forceinline__ float bf2f(unsigned short b) { return __builtin_bit_cast(float, (unsigned)b << 16); }
__device__ __forceinline__ float bflo(unsigned w) { return __builtin_bit_cast(float, w << 16); }
__device__ __forceinline__ float bfhi(unsigned w) { return __builtin_bit_cast(float, w & 0xffff0000u); }
__device__ __forceinline__ float siluf(float x) { return x * __builtin_amdgcn_rcpf(1.0f + __builtin_amdgcn_exp2f(-x * LOG2E)); }
__device__ __forceinline__ float wave_sum(float v) {
#pragma unroll
    for (int o = 1; o < 64; o <<= 1) v += __shfl_xor(v, o);
    return v;
}

struct Args { const float* in[23]; float* out; unsigned char* ws; };

__device__ __forceinline__ const float* x_row(const Args& a, int r) {
    if (r < R_PROMPT) return a.in[5] + (size_t)r * DM;
    if (r < R_SAMPLE) return a.in[0] + (size_t)(r - R_PROMPT) * DM;
    if (r < R_VALID) return a.in[1] + (size_t)(r - R_SAMPLE) * DM;
    return nullptr;
}

struct EpiSwiglu {
    static constexpr bool PERM = true, AFTER_DRAIN = false;
    bf16* H;
    __device__ __forceinline__ void operator()(const pg8::f32x4 (&acc)[2][2][4][2], const pg8::Unit& u, int wr, int wc, int fr, int fq) const {
        asm volatile("" : "+v"(fr), "+v"(fq));
        const int row0 = u.pm * 256 + wr * 64 + fr, col0 = u.pn * 128 + wc * 32 + 8 * fq;
#pragma unroll
        for (int ai = 0; ai < 2; ++ai)
#pragma unroll
            for (int m = 0; m < 4; ++m) {
                const int row = row0 + ai * 128 + m * 16;
                const pg8::f32x4 g0 = acc[ai][0][m][0], g1 = acc[ai][0][m][1], u0 = acc[ai][1][m][0], u1 = acc[ai][1][m][1];
                v4u w;
                w.x = pk2(siluf(g0[0]) * u0[0], siluf(g0[1]) * u0[1]); w.y = pk2(siluf(g0[2]) * u0[2], siluf(g0[3]) * u0[3]);
                w.z = pk2(siluf(g1[0]) * u1[0], siluf(g1[1]) * u1[1]); w.w = pk2(siluf(g1[2]) * u1[2], siluf(g1[3]) * u1[3]);
                *(v4u*)(H + (size_t)row * FF + col0) = w;
            }
    }
};
template <int SRC> struct EpiResZ {
    static constexpr bool PERM = false, AFTER_DRAIN = false;
    float* Z; const bf16* resb; Args a; float scale;
    __device__ __forceinline__ void operator()(const pg8::f32x4 (&acc)[2][2][4][2], const pg8::Unit& u, int wr, int wc, int fr, int fq) const {
        asm volatile("" : "+v"(fr), "+v"(fq));
        const int row0 = u.pm * 256 + wr * 64 + fr, col0 = u.pn * 256 + wc * 32 + 4 * fq;
#pragma unroll
        for (int ai = 0; ai < 2; ++ai)
#pragma unroll
            for (int m = 0; m < 4; ++m) {
                const int row = row0 + ai * 128 + m * 16;
                const float* xr = SRC == 0 ? x_row(a, row) : nullptr;
#pragma unroll
                for (int bj = 0; bj < 2; ++bj)
#pragma unroll
                    for (int n = 0; n < 2; ++n) {
                        const int c = col0 + bj * 128 + n * 16;
                        f32x4 rv;
                        if (SRC == 0) rv = xr ? *(const f32x4*)(xr + c) : (f32x4){0.f, 0.f, 0.f, 0.f};
                        else { const v2u w = *(const v2u*)(resb + (size_t)row * DM + c); rv = (f32x4){bflo(w.x), bfhi(w.x), bflo(w.y), bfhi(w.y)}; }
                        const pg8::f32x4 av = acc[ai][bj][m][n];
                        f32x4 o; o.x = DN_ALPHA * rv.x + scale * av[0]; o.y = DN_ALPHA * rv.y + scale * av[1]; o.z = DN_ALPHA * rv.z + scale * av[2]; o.w = DN_ALPHA * rv.w + scale * av[3];
                        *(f32x4*)(Z + (size_t)row * DM + c) = o;
                    }
                asm volatile("" ::: "memory");
            }
    }
};
struct EpiMixIn {
    static constexpr bool PERM = true, AFTER_DRAIN = false;
    bf16 *QR, *KR, *VR, *GS; float* P2; const f32x2* R128;
    __device__ __forceinline__ void operator()(const pg8::f32x4 (&acc)[2][2][4][2], const pg8::Unit& u, int wr, int wc, int fr, int fq) const {
        asm volatile("" : "+v"(fr), "+v"(fq));
        const int row0 = u.pm * 256 + wr * 64 + fr, pn = u.pn;
        if (pn < 4) {
            bf16* dst = pn < 2 ? QR : KR; const float sc = pn < 2 ? 1.0f : KR_SCALE;
            const int head = 2 * (pn & 1) + (wc >> 1), i0 = (wc & 1) * 32 + 8 * fq;
#pragma unroll
            for (int ai = 0; ai < 2; ++ai)
#pragma unroll
                for (int m = 0; m < 4; ++m) {
                    const int row = row0 + ai * 128 + m * 16;
                    const f32x2* cs = R128 + (size_t)row_pos(row) * 64 + i0;
                    float o1[8], o2[8];
#pragma unroll
                    for (int n = 0; n < 2; ++n)
#pragma unroll
                        for (int j = 0; j < 4; ++j) { const f32x2 t = cs[4 * n + j]; const float x1 = acc[ai][0][m][n][j], x2 = acc[ai][1][m][n][j];
                            o1[4 * n + j] = (x1 * t.x - x2 * t.y) * sc; o2[4 * n + j] = (x1 * t.y + x2 * t.x) * sc; }
                    v4u w1, w2;
                    w1.x = pk2(o1[0], o1[1]); w1.y = pk2(o1[2], o1[3]); w1.z = pk2(o1[4], o1[5]); w1.w = pk2(o1[6], o1[7]);
                    w2.x = pk2(o2[0], o2[1]); w2.y = pk2(o2[2], o2[3]); w2.z = pk2(o2[4], o2[5]); w2.w = pk2(o2[6], o2[7]);
                    bf16* p = dst + (size_t)row * 512 + head * 128 + i0;
                    *(v4u*)p = w1; *(v4u*)(p + 64) = w2;
                    asm volatile("" ::: "memory");
                }
        } else if (pn < 8) {
            bf16* dst = pn < 6 ? VR : GS; const bool act = pn >= 6;
            const int cb = (pn & 1) * 256 + wc * 32 + 8 * fq;
#pragma unroll
            for (int ai = 0; ai < 2; ++ai)
#pragma unroll
                for (int m = 0; m < 4; ++m) {
                    const int row = row0 + ai * 128 + m * 16;
#pragma unroll
                    for (int bj = 0; bj < 2; ++bj) {
                        pg8::f32x4 v0 = acc[ai][bj][m][0], v1 = acc[ai][bj][m][1];
                        if (act) {
#pragma unroll
                            for (int j = 0; j < 4; ++j) { v0[j] = siluf(v0[j]); v1[j] = siluf(v1[j]); } }
                        v4u w; w.x = pk2(v0[0], v0[1]); w.y = pk2(v0[2], v0[3]); w.z = pk2(v1[0], v1[1]); w.w = pk2(v1[2], v1[3]);
                        *(v4u*)(dst + (size_t)row * 512 + cb + bj * 128) = w;
                    }
                }
        } else {
            const int cb = (pn - 8) * 256 + wc * 32 + 8 * fq;
#pragma unroll
            for (int ai = 0; ai < 2; ++ai)
#pragma unroll
                for (int m = 0; m < 4; ++m) {
                    const int row = row0 + ai * 128 + m * 16;
#pragma unroll
                    for (int bj = 0; bj < 2; ++bj) {
                        float* p = P2 + (size_t)row * 512 + cb + bj * 128;
                        const pg8::f32x4 v0 = acc[ai][bj][m][0], v1 = acc[ai][bj][m][1];
                        *(f32x4*)p = (f32x4){v0[0], v0[1], v0[2], v0[3]}; *(f32x4*)(p + 4) = (f32x4){v1[0], v1[1], v1[2], v1[3]};
                    }
                }
        }
    }
};
struct EpiUq {
    static constexpr bool PERM = true, AFTER_DRAIN = false;
    bf16* QA; const f32x2* R64;
    __device__ __forceinline__ void operator()(const pg8::f32x4 (&acc)[2][2][4][2], const pg8::Unit& u, int wr, int wc, int fr, int fq) const {
        asm volatile("" : "+v"(fr), "+v"(fq));
        const int row0 = u.pm * 256 + wr * 64 + fr, pn = u.pn;
        if (pn < 2) {
#pragma unroll
            for (int ai = 0; ai < 2; ++ai)
#pragma unroll
                for (int m = 0; m < 4; ++m) {
                    const int row = row0 + ai * 128 + m * 16;
#pragma unroll
                    for (int bj = 0; bj < 2; ++bj) {
                        const pg8::f32x4 v0 = acc[ai][bj][m][0] * SM_SCALE, v1 = acc[ai][bj][m][1] * SM_SCALE;
                        v4u w; w.x = pk2(v0[0], v0[1]); w.y = pk2(v0[2], v0[3]); w.z = pk2(v1[0], v1[1]); w.w = pk2(v1[2], v1[3]);
                        *(v4u*)(QA + (size_t)row * NQA + (2 * pn + bj) * KVW + wc * 32 + 8 * fq) = w;
                    }
                }
        } else {
            const int head = wc, i0 = 8 * fq;
#pragma unroll
            for (int ai = 0; ai < 2; ++ai)
#pragma unroll
                for (int m = 0; m < 4; ++m) {
                    const int row = row0 + ai * 128 + m * 16;
                    const f32x2* cs = R64 + (size_t)row_pos(row) * 32 + i0;
                    float o1[8], o2[8];
#pragma unroll
                    for (int n = 0; n < 2; ++n)
#pragma unroll
                        for (int j = 0; j < 4; ++j) { const f32x2 t = cs[4 * n + j]; const float x1 = acc[ai][0][m][n][j], x2 = acc[ai][1][m][n][j];
                            o1[4 * n + j] = (x1 * t.x - x2 * t.y) * SM_SCALE; o2[4 * n + j] = (x1 * t.y + x2 * t.x) * SM_SCALE; }
                    v4u w1, w2;
                    w1.x = pk2(o1[0], o1[1]); w1.y = pk2(o1[2], o1[3]); w1.z = pk2(o1[4], o1[5]); w1.w = pk2(o1[6], o1[7]);
                    w2.x = pk2(o2[0], o2[1]); w2.y = pk2(o2[2], o2[3]); w2.z = pk2(o2[4], o2[5]); w2.w = pk2(o2[6], o2[7]);
                    bf16* p = QA + (size_t)row * NQA + head * KVW + 128 + i0;
                    *(v4u*)p = w1; *(v4u*)(p + 32) = w2;
                    asm volatile("" ::: "memory");
                }
        }
    }
};

__device__ __forceinline__ int src_col(int mat, int n) {
    if (mat == 0) { const int pn = n >> 8, bj = (n >> 7) & 1, i = n & 127; return bj * FF + 128 * pn + i; }
    if (mat == 2) {
        if (n < 1024) { const int pn = n >> 8, bj = (n >> 7) & 1, ip = n & 127, hh = ip >> 6, i = ip & 63; return (pn >> 1) * 512 + (2 * (pn & 1) + hh) * 128 + 64 * bj + i; }
        return n < DIN ? n : -1; }
    if (mat == 3) { const int bj = n >> 7, ip = n & 127, head = ip >> 5, i = ip & 31; return head * KVW + 128 + 32 * bj + i; }
    return n;
}
__device__ __forceinline__ void transpose_item(const float* __restrict__ W, int srcN, bf16* WT, int dstPitch, int dstRowOff, int mat, int k0, int n0, LAS float* scr, int lane) {
    const int sc = src_col(mat, n0 + (lane & 31));
#pragma unroll 8
    for (int i = 0; i < 32; ++i) { const int kk = 2 * i + (lane >> 5); scr[kk * 33 + (lane & 31)] = sc >= 0 ? W[(size_t)(k0 + kk) * srcN + sc] : 0.f; }
    LDS_WAIT();
    const int c = lane & 7;
#pragma unroll
    for (int j = 0; j < 4; ++j) { const int n = (lane >> 3) + 8 * j; const LAS float* s = scr + (8 * c) * 33 + n;
        v4u o; o.x = pk2(s[0 * 33], s[1 * 33]); o.y = pk2(s[2 * 33], s[3 * 33]); o.z = pk2(s[4 * 33], s[5 * 33]); o.w = pk2(s[6 * 33], s[7 * 33]);
        *(v4u*)(WT + (size_t)(dstRowOff + n0 + n) * dstPitch + k0 + 8 * c) = o; }
    LDS_WAIT();
}
__device__ __forceinline__ void transpose_matrix(const float* W, int Kdim, int srcN, bf16* WT, int Ndst, int dstPitch, int dstRowOff, int mat, LAS float* scr, int gw, int NGW, int lane) {
    const int nblk = Ndst / 32, nitems = (Kdim / 64) * nblk;
    for (int it = gw; it < nitems; it += NGW) transpose_item(W, srcN, WT, dstPitch, dstRowOff, mat, 64 * (it / nblk), 32 * (it % nblk), scr, lane);
}
__device__ __forceinline__ void sincos_acc(float ang, float& sn, float& cs) {
    const double x = (double)ang; const double kq = __builtin_rint(x * 0.63661977236758134308);
    const double r = (x - kq * 1.57079632679489655800e+00) - kq * 6.12323399573676603587e-17;
    const double r2 = r * r;
    const double s = r * (1.0 + r2 * (-1.0 / 6 + r2 * (1.0 / 120 + r2 * (-1.0 / 5040 + r2 * (1.0 / 362880 + r2 * (-1.0 / 39916800 + r2 * (1.0 / 6227020800.0)))))));
    const double c = 1.0 + r2 * (-0.5 + r2 * (1.0 / 24 + r2 * (-1.0 / 720 + r2 * (1.0 / 40320 + r2 * (-1.0 / 3628800 + r2 * (1.0 / 479001600 + r2 * (-1.0 / 87178291200.0)))))));
    const int q = (int)((long long)kq & 3);
    const double ss = (q == 0) ? s : (q == 1) ? c : (q == 2) ? -s : -c;
    const double cc = (q == 0) ? c : (q == 1) ? -s : (q == 2) ? -c : s;
    sn = (float)ss; cs = (float)cc;
}

constexpr int MAIN_ROWS = 16384;
template <bool FINAL, int RES> __device__ __forceinline__ void ln_rows(const Args& a, const float* Z, const float* g, const float* b, bf16* outB, const float* slabs, int spu, const bf16* resb, float scale, int gw, int NGW, int lane) {
    f32x4 gv[4], bv[4];
#pragma unroll
    for (int j = 0; j < 4; ++j) { gv[j] = *(const f32x4*)(g + 4 * lane + 256 * j); bv[j] = *(const f32x4*)(b + 4 * lane + 256 * j); }
    for (int r = gw; r < (FINAL ? R_VALID : MTOT); r += NGW) {
        if (FINAL && r < R_PROMPT) continue;
        f32x4 v[4]; float s = 0.f;
        if (r < MAIN_ROWS) {
            const f32x4* zr = (const f32x4*)(Z + (size_t)r * DM) + lane;
#pragma unroll
            for (int j = 0; j < 4; ++j) v[j] = zr[64 * j];
        } else {
            const int pm = r >> 8, rl = r & 255; const float* xr = RES == 0 ? x_row(a, r) : nullptr;
#pragma unroll
            for (int j = 0; j < 4; ++j) {
                f32x4 acc = {0.f, 0.f, 0.f, 0.f};
                const float* sp = slabs + (size_t)(((pm - MAIN_ROWS / 256) * 4 + j) * spu) * 65536 + (size_t)rl * 256 + 4 * lane;
                for (int q = 0; q < spu; ++q) acc += *(const f32x4*)(sp + (size_t)q * 65536);
                f32x4 rv;
                if (RES == 0) rv = xr ? *((const f32x4*)xr + lane + 64 * j) : (f32x4){0.f, 0.f, 0.f, 0.f};
                else { const v2u w = *((const v2u*)(resb + (size_t)r * DM) + lane + 64 * j); rv = (f32x4){bflo(w.x), bfhi(w.x), bflo(w.y), bfhi(w.y)}; }
                v[j] = rv * DN_ALPHA + acc * scale;
            }
        }
#pragma unroll
        for (int j = 0; j < 4; ++j) s += (v[j].x + v[j].y) + (v[j].z + v[j].w);
        const float mean = wave_sum(s) * (1.f / DM); float s2 = 0.f;
#pragma unroll
        for (int j = 0; j < 4; ++j) { v[j] = v[j] - mean; s2 += (v[j].x * v[j].x + v[j].y * v[j].y) + (v[j].z * v[j].z + v[j].w * v[j].w); }
        const float rstd = 1.0f / sqrtf(wave_sum(s2) * (1.f / DM) + LN_EPS);
        if (FINAL) {
            float* o = a.out + (r < R_SAMPLE ? O_YP + (size_t)(r - R_PROMPT) * DM : O_YS + (size_t)(r - R_SAMPLE) * DM);
#pragma unroll
            for (int j = 0; j < 4; ++j) *((f32x4*)o + lane + 64 * j) = v[j] * rstd * gv[j] + bv[j];
        } else {
            v2u* o = (v2u*)(outB + (size_t)r * DM) + lane;
#pragma unroll
            for (int j = 0; j < 4; ++j) { const f32x4 y = v[j] * rstd * gv[j] + bv[j]; v2u w; w.x = pk2(y.x, y.y); w.y = pk2(y.z, y.w); o[64 * j] = w; }
        }
    }
}

__device__ __forceinline__ void post_rows(const Args& a, int gw, int NGW, int lane) {
    unsigned char* ws = a.ws;
    const float* P2 = (const float*)(ws + WS_P2RAW); bf16* CQB = (bf16*)(ws + WS_CQB); bf16* KVB = (bf16*)(ws + WS_KVB);
    const f32x2* R64 = (const f32x2*)(ws + WS_R64);
    const f32x4 gq = *(const f32x4*)(a.in[12] + 4 * lane);
    const float gk0 = a.in[14][lane], gk1 = a.in[14][64 + lane];
    for (int r0 = gw; r0 < MTOT; r0 += 4 * NGW) {
        f32x4 cq[4]; float c0[4], c1[4], k1[4], k2[4]; f32x2 cs[4];
#pragma unroll
        for (int u = 0; u < 4; ++u) { const int row = r0 + u * NGW; if (row < MTOT) { const float* p = P2 + (size_t)row * 512;
            cq[u] = *(const f32x4*)(p + 4 * lane); c0[u] = p[256 + lane]; c1[u] = p[320 + lane]; k1[u] = p[384 + (lane & 31)]; k2[u] = p[416 + (lane & 31)]; cs[u] = R64[(size_t)row_pos(row) * 32 + (lane & 31)]; } }
#pragma unroll
        for (int u = 0; u < 4; ++u) { const int row = r0 + u * NGW; if (row < MTOT) {
            const float ssq = wave_sum((cq[u].x * cq[u].x + cq[u].y * cq[u].y) + (cq[u].z * cq[u].z + cq[u].w * cq[u].w));
            const float ssk = wave_sum(c0[u] * c0[u] + c1[u] * c1[u]);
            const float rq = 1.0f / sqrtf(ssq * (1.f / 256) + RMS_EPS), rk = 1.0f / sqrtf(ssk * (1.f / 128) + RMS_EPS);
            v2u w; w.x = pk2(cq[u].x * rq * gq.x, cq[u].y * rq * gq.y); w.y = pk2(cq[u].z * rq * gq.z, cq[u].w * rq * gq.w);
            *((v2u*)(CQB + (size_t)row * 256) + lane) = w;
            const float v0 = c0[u] * rk * gk0, v1 = c1[u] * rk * gk1;
            const float kp = lane < 32 ? k1[u] * cs[u].x - k2[u] * cs[u].y : k1[u] * cs[u].y + k2[u] * cs[u].x;
            KVB[(size_t)row * KVW + lane] = (bf16)f2bf(v0); KVB[(size_t)row * KVW + 64 + lane] = (bf16)f2bf(v1); KVB[(size_t)row * KVW + 128 + lane] = (bf16)f2bf(kp);
            if (row < R_PROMPT) {
#pragma unroll
                for (int b = 0; b < NB; ++b) { float* oc = a.out + O_PCKV + ((size_t)b * LP + row) * 128; oc[lane] = v0; oc[64 + lane] = v1; a.out[O_PKPE + ((size_t)b * LP + row) * 64 + lane] = kp; }
            } else if (row < R_SAMPLE) {
                const int b = (row - R_PROMPT) >> 12, sq = (row - R_PROMPT) & (SEQ - 1);
                float* oc = a.out + O_PCKV + ((size_t)b * LP + NMETA + sq) * 128; oc[lane] = v0; oc[64 + lane] = v1; a.out[O_PKPE + ((size_t)b * LP + NMETA + sq) * 64 + lane] = kp;
            } else if (row < R_VALID) {
                float* oc = a.out + O_SCKV + (size_t)(row - R_SAMPLE) * 128; oc[lane] = v0; oc[64 + lane] = v1; a.out[O_SKPE + (size_t)(row - R_SAMPLE) * 64 + lane] = kp;
            } } }
    }
    bf16* KVC = (bf16*)(ws + WS_KVC);
#pragma unroll 4
    for (int r = gw; r < DBS * PAST; r += NGW) {
        const float v0 = a.in[2][(size_t)r * 128 + lane], v1 = a.in[2][(size_t)r * 128 + 64 + lane], kp = a.in[3][(size_t)r * 64 + lane];
        KVC[(size_t)r * KVW + lane] = (bf16)f2bf(v0); KVC[(size_t)r * KVW + 64 + lane] = (bf16)f2bf(v1); KVC[(size_t)r * KVW + 128 + lane] = (bf16)f2bf(kp);
    }
}

__device__ __forceinline__ int crow(int r, int hi) { return (r & 3) + 8 * (r >> 2) + 4 * hi; }
#define PK4(P, BASE, OUT) do { unsigned a0_ = pk2(P[BASE + 0], P[BASE + 1]), a1_ = pk2(P[BASE + 2], P[BASE + 3]);   \
    unsigned b0_ = pk2(P[BASE + 4], P[BASE + 5]), b1_ = pk2(P[BASE + 6], P[BASE + 7]);                              \
    auto r0_ = __builtin_amdgcn_permlane32_swap(a0_, b0_, false, false); auto r1_ = __builtin_amdgcn_permlane32_swap(a1_, b1_, false, false); \
    v4u w_ = {r0_[0], r1_[0], r0_[1], r1_[1]}; OUT = __builtin_bit_cast(bf16x8, w_); } while (0)
__device__ __forceinline__ float half_swap_max(float x) { auto rr = __builtin_amdgcn_permlane32_swap(__float_as_uint(x), __float_as_uint(x), false, false); return fmaxf(__uint_as_float(rr[0]), __uint_as_float(rr[1])); }
__device__ __forceinline__ float half_swap_sum(float x) { auto rr = __builtin_amdgcn_permlane32_swap(__float_as_uint(x), __float_as_uint(x), false, false); return __uint_as_float(rr[0]) + __uint_as_float(rr[1]); }


typedef short v4i16_t __attribute__((ext_vector_type(4)));
__device__ __forceinline__ unsigned offb(unsigned row, unsigned ch) { return 256u * row + 16u * (ch ^ (((row & 3) << 2) | ((row >> 2) & 3))); }
__device__ __forceinline__ unsigned offk(unsigned row, unsigned ch) { return 128u * row + 16u * (ch ^ ((row >> 1) & 7)); }
__device__ __forceinline__ bf16x8 rowfrag(LAS unsigned char* T, unsigned rb, unsigned lane, unsigned s) { return *(LAS bf16x8*)(T + offb(rb + (lane & 31), 2 * s + (lane >> 5))); }
__device__ __forceinline__ bf16x8 rowfrag64(LAS unsigned char* T, unsigned rb, unsigned lane, unsigned s) { return *(LAS bf16x8*)(T + offk(rb + (lane & 31), 2 * s + (lane >> 5))); }
__device__ __forceinline__ bf16x8 trfrag(LAS unsigned char* T, unsigned lane, unsigned c, unsigned ks) {
    const unsigned h = lane >> 5, blk = (lane >> 4) & 1, q = (lane & 15) >> 2, p = lane & 3, row = 16 * ks + 8 * h + q, ch = 4 * c + 2 * blk + (p >> 1);
    const v4i16_t lo = __builtin_amdgcn_ds_read_tr16_b64_v4i16((LAS v4i16_t*)(T + offb(row, ch) + 8 * (p & 1)));
    const v4i16_t hi = __builtin_amdgcn_ds_read_tr16_b64_v4i16((LAS v4i16_t*)(T + offb(row + 4, ch) + 8 * (p & 1)));
    return (bf16x8){lo[0], lo[1], lo[2], lo[3], hi[0], hi[1], hi[2], hi[3]};
}

constexpr int AT_TILE = 24576;
__device__ __forceinline__ const bf16* attn_tile_src(unsigned char* ws, int type, int bi, int t, int& nvalid) {
    const bf16* KVB = (const bf16*)(ws + WS_KVB); const bf16* KVC = (const bf16*)(ws + WS_KVC);
    if (t == 0) { nvalid = NMETA; return KVB; }
    if (type == 0) { nvalid = 64; return KVB + (size_t)(R_PROMPT + bi * SEQ + 64 * (t - 1)) * KVW; }
    if (t <= 16) { nvalid = 64; return KVC + ((size_t)bi * PAST + 64 * (t - 1)) * KVW; }
    nvalid = TS; return KVB + (size_t)(R_SAMPLE + TS * bi) * KVW;
}
__device__ __forceinline__ void attn_unit(const Args& a, LAS unsigned char* L, int type, int bi, int c, int qh, int tid) {
    asm volatile("" : "+v"(tid));
    unsigned char* ws = a.ws;
    const bf16* QA = (const bf16*)(ws + WS_QA); bf16* MIXA = (bf16*)(ws + WS_A16A);
    const int lane = tid & 63, wave = __builtin_amdgcn_readfirstlane(tid >> 6), g = wave >> 2, h = wave & 3, r32 = lane & 31, hi = lane >> 5;
    int qrow0, nq, nt;
    if (type == 0) { qrow0 = R_PROMPT + bi * SEQ + 64 * c + 32 * qh; nq = 32; nt = c + 2; }
    else if (type == 1) { qrow0 = R_SAMPLE + TS * bi; nq = 32; nt = 18; }
    else { qrow0 = 0; nq = 16; nt = 1; }
    const int nsteps = (nt + 1) >> 1;
    bf16x8 qr[12];
    { const bf16* qp = QA + (size_t)(qrow0 + r32) * NQA + h * KVW + hi * 8;
#pragma unroll
      for (int d0 = 0; d0 < 12; ++d0) qr[d0] = *(const bf16x8*)(qp + d0 * 16); }
    f32x16 o[4];
#pragma unroll
    for (int d = 0; d < 4; ++d)
#pragma unroll
        for (int r = 0; r < 16; ++r) o[d][r] = 0.f;
    float m_reg = -1e30f, l_reg = 0.f;
    unsigned rb_[8], kb_[4], tb_[8];
    { const unsigned X = ((r32 & 3) << 2) | ((r32 >> 2) & 3);
#pragma unroll
      for (int s = 0; s < 8; ++s) rb_[s] = 256u * r32 + 32u * (s ^ (X >> 1)) + 16u * (hi ^ (X & 1));
#pragma unroll
      for (int s = 0; s < 4; ++s) kb_[s] = 16384u + offk(r32, 2 * s + hi);
      const unsigned blk = (lane >> 4) & 1, q = (lane & 15) >> 2, p = lane & 3;
#pragma unroll
      for (int cb = 0; cb < 4; ++cb)
#pragma unroll
          for (int t = 0; t < 2; ++t) tb_[2 * cb + t] = 256u * (8 * hi + 4 * t + q) + 64u * (cb ^ q) + 16u * ((2 * blk + (p >> 1)) ^ ((2 * hi + t) & 3)) + 8u * (p & 1); }
    unsigned so_[6];
#pragma unroll
    for (int i = 0; i < 6; ++i) { const int pid = wave * 6 + i, pp = pid >= 24 ? pid - 24 : pid;
        if (pp < 16) { const unsigned row = 4 * pp + (lane >> 4), slot = lane & 15; so_[i] = row * KVW + 8 * (slot ^ (((row & 3) << 2) | ((row >> 2) & 3))); }
        else { const unsigned row = 8 * (pp - 16) + (lane >> 3), slot = lane & 7; so_[i] = row * KVW + 128 + 8 * (slot ^ ((row >> 1) & 7)); } }
#define AT_STAGE(step) do { _Pragma("unroll") for (int i_ = 0; i_ < 6; ++i_) { const int pid_ = wave * 6 + i_, tt_ = pid_ >= 24 ? 1 : 0, pp_ = pid_ - 24 * tt_, t_ = 2 * (step) + tt_; \
        if (t_ < nt) { int nv_; const bf16* src_ = attn_tile_src(ws, type, bi, t_, nv_); LAS unsigned char* T_ = L + (((step) & 1) * 2 + tt_) * AT_TILE + (pp_ < 16 ? pp_ * 1024 : 16384 + (pp_ - 16) * 1024); \
            __builtin_amdgcn_global_load_lds((const unsigned*)(src_ + so_[i_]), (LAS unsigned*)T_, 16, 0, 0); } } } while (0)
    AT_STAGE(0);
    __syncthreads();
    for (int s = 0; s < nsteps; ++s) {
        if (s + 1 < nsteps) AT_STAGE(s + 1);
        const int t = 2 * s + g;
        if (t < nt) {
            int nvalid; (void)attn_tile_src(ws, type, bi, t, nvalid);
            LAS unsigned char* T = L + ((s & 1) * 2 + g) * AT_TILE;
            f32x16 p0, p1;
#pragma unroll
            for (int r = 0; r < 16; ++r) { p0[r] = 0.f; p1[r] = 0.f; }
#pragma unroll
            for (int d0 = 0; d0 < 8; ++d0) {
                const bf16x8 k0 = *(LAS bf16x8*)(T + rb_[d0]), k1 = *(LAS bf16x8*)(T + rb_[d0] + 8192);
                p0 = __builtin_amdgcn_mfma_f32_32x32x16_bf16(k0, qr[d0], p0, 0, 0, 0);
                p1 = __builtin_amdgcn_mfma_f32_32x32x16_bf16(k1, qr[d0], p1, 0, 0, 0);
            }
#pragma unroll
            for (int d0 = 0; d0 < 4; ++d0) {
                const bf16x8 k0 = *(LAS bf16x8*)(T + kb_[d0]), k1 = *(LAS bf16x8*)(T + kb_[d0] + 4096);
                p0 = __builtin_amdgcn_mfma_f32_32x32x16_bf16(k0, qr[8 + d0], p0, 0, 0, 0);
                p1 = __builtin_amdgcn_mfma_f32_32x32x16_bf16(k1, qr[8 + d0], p1, 0, 0, 0);
            }
            if (nvalid < 64) {
#pragma unroll
                for (int r = 0; r < 16; ++r) { const int key = crow(r, hi); if (key >= nvalid) p0[r] = -1e30f; if (key + 32 >= nvalid) p1[r] = -1e30f; }
            }
            float pmax = p0[0];
#pragma unroll
            for (int r = 1; r < 16; ++r) pmax = fmaxf(pmax, p0[r]);
#pragma unroll
            for (int r = 0; r < 16; ++r) pmax = fmaxf(pmax, p1[r]);
            pmax = half_swap_max(pmax);
            const float mn = fmaxf(m_reg, pmax), alpha = __builtin_amdgcn_exp2f((m_reg - mn) * LOG2E); m_reg = mn;
            const float mnC = -mn * LOG2E; float ps = 0.f;
#pragma unroll
            for (int r = 0; r < 16; ++r) { p0[r] = __builtin_amdgcn_exp2f(fmaf(p0[r], LOG2E, mnC)); p1[r] = __builtin_amdgcn_exp2f(fmaf(p1[r], LOG2E, mnC)); ps += p0[r] + p1[r]; }
            ps = half_swap_sum(ps);
            l_reg = l_reg * alpha + ps;
            if (__any(alpha < 1.f)) {
#pragma unroll
                for (int r = 0; r < 16; ++r) { const float ar = __shfl(alpha, crow(r, hi));
#pragma unroll
                    for (int d = 0; d < 4; ++d) o[d][r] *= ar; }
            }
            bf16x8 pa0, pa1, pa2, pa3;
            PK4(p0, 0, pa0); PK4(p0, 8, pa1); PK4(p1, 0, pa2); PK4(p1, 8, pa3);
#define AT_TR(cb, ks) ({ const v4i16_t lo_ = __builtin_amdgcn_ds_read_tr16_b64_v4i16((LAS v4i16_t*)(T + tb_[2 * (cb)] + 4096 * (ks))), hi_ = __builtin_amdgcn_ds_read_tr16_b64_v4i16((LAS v4i16_t*)(T + tb_[2 * (cb) + 1] + 4096 * (ks))); \
                (bf16x8){lo_[0], lo_[1], lo_[2], lo_[3], hi_[0], hi_[1], hi_[2], hi_[3]}; })
#pragma unroll
            for (int d0 = 0; d0 < 4; ++d0) {
                const bf16x8 v0 = AT_TR(d0, 0), v1 = AT_TR(d0, 1), v2 = AT_TR(d0, 2), v3 = AT_TR(d0, 3);
                o[d0] = __builtin_amdgcn_mfma_f32_32x32x16_bf16(pa0, v0, o[d0], 0, 0, 0);
                o[d0] = __builtin_amdgcn_mfma_f32_32x32x16_bf16(pa1, v1, o[d0], 0, 0, 0);
                o[d0] = __builtin_amdgcn_mfma_f32_32x32x16_bf16(pa2, v2, o[d0], 0, 0, 0);
                o[d0] = __builtin_amdgcn_mfma_f32_32x32x16_bf16(pa3, v3, o[d0], 0, 0, 0);
            }
#undef AT_TR
        }
        __syncthreads();
    }
#undef AT_STAGE
    LAS float* M = (LAS float*)(L + h * 17408);
    if (g == 1) {
#pragma unroll
        for (int d = 0; d < 4; ++d)
#pragma unroll
            for (int r = 0; r < 16; ++r) M[(d * 16 + r) * 64 + lane] = o[d][r];
        M[4096 + lane] = m_reg; M[4160 + lane] = l_reg;
    }
    __syncthreads();
    if (g == 0) {
        const float m1 = M[4096 + lane], l1 = M[4160 + lane];
        const float mm = fmaxf(m_reg, m1), f0 = __builtin_amdgcn_exp2f((m_reg - mm) * LOG2E), f1 = __builtin_amdgcn_exp2f((m1 - mm) * LOG2E);
        const float rl = __builtin_amdgcn_rcpf(l_reg * f0 + l1 * f1), s0 = f0 * rl, s1 = f1 * rl;
#pragma unroll
        for (int r = 0; r < 16; ++r) { const int qi = crow(r, hi); const float a0 = __shfl(s0, qi), a1 = __shfl(s1, qi);
            bf16* op = MIXA + (size_t)(qrow0 + qi) * DM + 512 + h * 128 + r32;
#pragma unroll
            for (int d0 = 0; d0 < 4; ++d0) { const float v = o[d0][r] * a0 + M[(d0 * 16 + r) * 64 + lane] * a1; if (qi < nq) op[32 * d0] = (bf16)f2bf(v); } }
    }
    __syncthreads();
}

struct RetItem { int kind, bh, n; };
__device__ __forceinline__ void ret_geom(const RetItem& it, int& h, int& rowbase, int& tlo, int& thi, int& T) {
    if (it.kind == 0) { h = it.bh; rowbase = -48; tlo = 48; thi = 64; T = 64; }
    else if (it.kind == 1) { h = it.bh & 3; rowbase = R_PROMPT + (it.bh >> 2) * SEQ + 64 * (it.n - 1); tlo = 0; thi = 64; T = 64; }
    else { h = it.bh & 3; rowbase = R_SAMPLE + TS * (it.bh >> 2); tlo = 0; thi = TS; T = TS; }
}
__device__ __forceinline__ int kvn_index(const RetItem& it) { return it.kind == 0 ? it.bh : 4 + it.bh * 64 + (it.n - 1); }
__device__ __forceinline__ RetItem ret_item(int i) {
    if (i < 4) return RetItem{0, i, 0};
    if (i < 1028) { const int j = i - 4; return RetItem{1, j >> 6, (j & 63) + 1}; }
    return RetItem{2, i - 1028, 0};
}
constexpr int NRET = 4 + NB * 4 * 64 + DBS * 4;
template <bool DEC> __device__ __forceinline__ void ret_stage(LAS unsigned char* T_, const bf16* X, int rowbase, int h, int tlo, int thi, float lg2, int T, int tid) {
    const int ch = tid & 15;
#pragma unroll
    for (int i = 0; i < 2; ++i) {
        const int t = (tid >> 4) + 32 * i; v4u v = {0u, 0u, 0u, 0u};
        if (t >= tlo && t < thi) {
            v = *(const v4u*)(X + (size_t)(rowbase + t) * 512 + h * 128 + ch * 8);
            if (DEC) { const float d = __builtin_amdgcn_exp2f(lg2 * (float)(T - 1 - t));
                v.x = pk2(bflo(v.x) * d, bfhi(v.x) * d); v.y = pk2(bflo(v.y) * d, bfhi(v.y) * d); v.z = pk2(bflo(v.z) * d, bfhi(v.z) * d); v.w = pk2(bflo(v.w) * d, bfhi(v.w) * d); }
        }
        *(LAS v4u*)(T_ + offb(t, ch)) = v;
    }
}
__device__ __forceinline__ void ret_kv_item(const Args& a, LAS unsigned char* L, const RetItem& it, int tid) {
    asm volatile("" : "+v"(tid));
    unsigned char* ws = a.ws;
    const bf16* KR = (const bf16*)(ws + WS_KR); const bf16* VR = (const bf16*)(ws + WS_VR); bf16* KVN = (bf16*)(ws + WS_KVN);
    int h, rowbase, tlo, thi, T; ret_geom(it, h, rowbase, tlo, thi, T);
    const float lg2 = lg2gamma(h); const int lane = tid & 63, w = __builtin_amdgcn_readfirstlane(tid >> 6), r32 = lane & 31, hi = lane >> 5, ib = w >> 1, jb0 = 2 * (w & 1);
    LAS unsigned char* TK = L; LAS unsigned char* TV = L + 16384;
    ret_stage<false>(TK, KR, rowbase, h, tlo, thi, lg2, T, tid);
    ret_stage<true>(TV, VR, rowbase, h, tlo, thi, lg2, T, tid);
    __syncthreads();
    f32x16 c0, c1;
#pragma unroll
    for (int r = 0; r < 16; ++r) { c0[r] = 0.f; c1[r] = 0.f; }
#pragma unroll
    for (int ks = 0; ks < 4; ++ks) {
        const bf16x8 af = trfrag(TK, lane, ib, ks), b0 = trfrag(TV, lane, jb0, ks), b1 = trfrag(TV, lane, jb0 + 1, ks);
        c0 = __builtin_amdgcn_mfma_f32_32x32x16_bf16(af, b0, c0, 0, 0, 0);
        c1 = __builtin_amdgcn_mfma_f32_32x32x16_bf16(af, b1, c1, 0, 0, 0);
    }
    if (it.kind != 2) {
        bf16* dst = KVN + (size_t)kvn_index(it) * 16384;
#pragma unroll
        for (int rg = 0; rg < 4; ++rg) { const int dk0 = 32 * ib + 8 * rg + 4 * hi;
            v2u w0; w0.x = pk2(c0[4 * rg], c0[4 * rg + 1]); w0.y = pk2(c0[4 * rg + 2], c0[4 * rg + 3]);
            v2u w1; w1.x = pk2(c1[4 * rg], c1[4 * rg + 1]); w1.y = pk2(c1[4 * rg + 2], c1[4 * rg + 3]);
            *(v2u*)(dst + (size_t)(32 * jb0 + r32) * 128 + dk0) = w0; *(v2u*)(dst + (size_t)(32 * (jb0 + 1) + r32) * 128 + dk0) = w1; }
    } else {
        const float dec = __builtin_amdgcn_exp2f(lg2 * (float)T);
        const float* s0 = a.in[4] + (size_t)it.bh * 16384; float* so = a.out + O_SST + (size_t)it.bh * 16384;
#pragma unroll
        for (int r = 0; r < 16; ++r) { const size_t e = (size_t)(32 * ib + crow(r, hi)) * 128 + 32 * jb0 + r32;
            so[e] = dec * s0[e] + c0[r]; so[e + 32] = dec * s0[e + 32] + c1[r]; }
    }
    __syncthreads();
}
__device__ __forceinline__ void ret_out_item(const Args& a, LAS unsigned char* L, const RetItem& it, int tid) {
    asm volatile("" : "+v"(tid));
    unsigned char* ws = a.ws;
    const bf16* QR = (const bf16*)(ws + WS_QR); const bf16* KR = (const bf16*)(ws + WS_KR); const bf16* VR = (const bf16*)(ws + WS_VR); const bf16* GS = (const bf16*)(ws + WS_GS);
    const bf16* KVN = (const bf16*)(ws + WS_KVN); bf16* MIXA = (bf16*)(ws + WS_A16A);
    int h, rowbase, tlo, thi, T; ret_geom(it, h, rowbase, tlo, thi, T);
    const float lg2 = lg2gamma(h); const int lane = tid & 63, w = __builtin_amdgcn_readfirstlane(tid >> 6), r32 = lane & 31, hi = lane >> 5, qhalf = w & 1, cb = w >> 1;
    LAS unsigned char* TQ = L; LAS unsigned char* TK = L + 16384; LAS unsigned char* TV = L + 32768; LAS unsigned char* TS_ = L + 49152;
    LAS float* ST = (LAS float*)(L + 81920);
    ret_stage<false>(TQ, QR, rowbase, h, tlo, thi, lg2, T, tid);
    ret_stage<false>(TK, KR, rowbase, h, tlo, thi, lg2, T, tid);
    ret_stage<false>(TV, VR, rowbase, h, tlo, thi, lg2, T, tid);
    if (it.kind == 1) {
        const bf16* st = KVN + (size_t)kvn_index(it) * 16384;
#pragma unroll
        for (int i = 0; i < 4; ++i) { const int dv = (tid >> 4) + 32 * i, ch = tid & 15; *(LAS v4u*)(TS_ + offb(dv, ch)) = *(const v4u*)(st + (size_t)dv * 128 + ch * 8); }
    } else if (it.kind == 2) {
        const float* s0 = a.in[4] + (size_t)it.bh * 16384;
        for (int e = tid; e < 16384; e += 512) { const int dk = e >> 7, dv = e & 127; *(LAS unsigned short*)(TS_ + offb(dv, dk >> 3) + 2 * (dk & 7)) = (unsigned short)f2bf(s0[e]); }
    }
    __syncthreads();
    f32x16 o;
#pragma unroll
    for (int r = 0; r < 16; ++r) o[r] = 0.f;
    bf16x8 qr[8];
#pragma unroll
    for (int d0 = 0; d0 < 8; ++d0) qr[d0] = rowfrag(TQ, 32 * qhalf, lane, d0);
    if (it.kind != 0) {
#pragma unroll
        for (int kd = 0; kd < 8; ++kd) o = __builtin_amdgcn_mfma_f32_32x32x16_bf16(qr[kd], rowfrag(TS_, 32 * cb, lane, kd), o, 0, 0, 0);
#pragma unroll
        for (int r = 0; r < 16; ++r) o[r] *= __builtin_amdgcn_exp2f(lg2 * (float)(32 * qhalf + crow(r, hi) + 1));
    }
    f32x16 p0, p1;
#pragma unroll
    for (int r = 0; r < 16; ++r) { p0[r] = 0.f; p1[r] = 0.f; }
#pragma unroll
    for (int d0 = 0; d0 < 8; ++d0) {
        p0 = __builtin_amdgcn_mfma_f32_32x32x16_bf16(rowfrag(TK, 0, lane, d0), qr[d0], p0, 0, 0, 0);
        p1 = __builtin_amdgcn_mfma_f32_32x32x16_bf16(rowfrag(TK, 32, lane, d0), qr[d0], p1, 0, 0, 0);
    }
    const int tq = 32 * qhalf + r32;
#pragma unroll
    for (int r = 0; r < 16; ++r) { const int k0 = crow(r, hi), k1 = k0 + 32;
        p0[r] = tq >= k0 ? p0[r] * __builtin_amdgcn_exp2f(lg2 * (float)(tq - k0)) : 0.f;
        p1[r] = tq >= k1 ? p1[r] * __builtin_amdgcn_exp2f(lg2 * (float)(tq - k1)) : 0.f; }
    bf16x8 pa0, pa1, pa2, pa3;
    PK4(p0, 0, pa0); PK4(p0, 8, pa1); PK4(p1, 0, pa2); PK4(p1, 8, pa3);
    o = __builtin_amdgcn_mfma_f32_32x32x16_bf16(pa0, trfrag(TV, lane, cb, 0), o, 0, 0, 0);
    o = __builtin_amdgcn_mfma_f32_32x32x16_bf16(pa1, trfrag(TV, lane, cb, 1), o, 0, 0, 0);
    o = __builtin_amdgcn_mfma_f32_32x32x16_bf16(pa2, trfrag(TV, lane, cb, 2), o, 0, 0, 0);
    o = __builtin_amdgcn_mfma_f32_32x32x16_bf16(pa3, trfrag(TV, lane, cb, 3), o, 0, 0, 0);
#pragma unroll
    for (int r = 0; r < 16; ++r) {
        float s = o[r], q = o[r] * o[r];
#pragma unroll
        for (int off = 1; off < 32; off <<= 1) { s += __shfl_xor(s, off); q += __shfl_xor(q, off); }
        if (r32 == 0) { const int row = 32 * qhalf + crow(r, hi); ST[(row * 4 + cb) * 2] = s; ST[(row * 4 + cb) * 2 + 1] = q; }
    }
    __syncthreads();
    const float gain = a.in[11][h * 128 + 32 * cb + r32];
#pragma unroll
    for (int r = 0; r < 16; ++r) {
        const int t = 32 * qhalf + crow(r, hi);
        const LAS f32x4* sp = (const LAS f32x4*)(ST + t * 8);
        const f32x4 u0 = sp[0], u1 = sp[1];
        const float mean = ((u0.x + u0.z) + (u1.x + u1.z)) * (1.f / 128), var = fmaxf(((u0.y + u0.w) + (u1.y + u1.w)) * (1.f / 128) - mean * mean, 0.f);
        const float rstd = 1.0f / sqrtf(var + LN_EPS);
        if (t >= tlo && t < thi) { const size_t rb = (size_t)(rowbase + t); const int col = h * 128 + 32 * cb + r32;
            MIXA[rb * DM + col] = (bf16)f2bf((o[r] - mean) * rstd * gain * bf2f(GS[rb * 512 + col])); }
    }
    __syncthreads();
}


__device__ __forceinline__ void ret_scan(const Args& a, int gtid, int gthreads) {
    unsigned* KVN = (unsigned*)(a.ws + WS_KVN);
    for (int g = gtid; g < NB * 4 * 8192; g += gthreads) {
        const int bh = g >> 13, e2 = g & 8191, h = bh & 3;
        const float dec = __builtin_amdgcn_exp2f(lg2gamma(h) * 64.f);
        const unsigned w0 = KVN[(size_t)h * 8192 + e2];
        float s0 = bflo(w0), s1 = bfhi(w0);
        unsigned* p = KVN + (size_t)(4 + bh * 64) * 8192 + e2;
#pragma unroll 16
        for (int n = 0; n < 64; ++n) { const unsigned kv = p[(size_t)n * 8192]; p[(size_t)n * 8192] = pk2(s0, s1); s0 = dec * s0 + bflo(kv); s1 = dec * s1 + bfhi(kv); }
        const int dv = e2 >> 6, dk = (e2 & 63) * 2;
        float* so = a.out + O_PST + (size_t)bh * 16384;
        so[(size_t)dk * 128 + dv] = s0; so[(size_t)(dk + 1) * 128 + dv] = s1;
    }
}


#ifndef PROBE_DUP
#define PROBE_DUP -1
#endif
#define REPS(k) for (int rep_ = 0; rep_ < ((PROBE_DUP == (k)) ? 2 : 1); ++rep_)
constexpr int NWAVES = 8, LDS_BYTES = 147456, RING_BYTES = 131072, MISC_OFF = RING_BYTES + 320;

__global__ void __launch_bounds__(NWAVES * 64, 2) fwd_mega(Args a) {
    extern __shared__ __attribute__((aligned(16))) unsigned char lds[];
    LAS unsigned char* L = (LAS unsigned char*)lds;
    volatile LAS unsigned* MISC = (volatile LAS unsigned*)(L + MISC_OFF);
    int tid = threadIdx.x, lane = tid & 63, wave = __builtin_amdgcn_readfirstlane(tid >> 6);
    const int G = gridDim.x, bx = blockIdx.x;
    const int vcu = (G % 8 == 0) ? (bx % 8) * (G / 8) + bx / 8 : bx;
    int gw = vcu * NWAVES + wave, gtid = vcu * (NWAVES * 64) + tid; const int NGW = G * NWAVES, gthreads = G * NWAVES * 64;
#define PHASE_BEGIN() do { tid = threadIdx.x; asm volatile("" : "+v"(tid)); lane = tid & 63; wave = __builtin_amdgcn_readfirstlane(tid >> 6); gw = vcu * NWAVES + wave; gtid = vcu * (NWAVES * 64) + tid; } while (0)
    unsigned char* ws = a.ws;
    for (int u = tid; u < (LDS_BYTES - RING_BYTES) / 4; u += NWAVES * 64) ((LAS unsigned*)(L + RING_BYTES))[u] = 0u;
    __syncthreads();
    XcdBarrier bar = xcd_barrier_post((unsigned*)(ws + WS_CTL) + CW_BAR, MISC + 8);
#define GRID_BAR() do { xcd_barrier(bar); PHASE_BEGIN(); } while (0)
#define SCR ((LAS float*)(L + wave * 16384))

    bf16* WFI = (bf16*)(ws + WS_WFI); bf16* WFO = (bf16*)(ws + WS_WFO); bf16* WMI = (bf16*)(ws + WS_WMI); bf16* WMO = (bf16*)(ws + WS_WMO); bf16* WUQ = (bf16*)(ws + WS_WUQ);
    f32x2* R128 = (f32x2*)(ws + WS_R128); f32x2* R64 = (f32x2*)(ws + WS_R64);
    bf16* A16A = (bf16*)(ws + WS_A16A); bf16* A16B = (bf16*)(ws + WS_A16B); float* Z = (float*)(ws + WS_Z); bf16* HID = (bf16*)(ws + WS_HID);

    REPS(0) {
        REPS(100) {
        transpose_matrix(a.in[6], DM, 2 * FF, WFI, 2 * FF, DM, 0, 0, SCR, gw, NGW, lane);
        transpose_matrix(a.in[7], FF, DM, WFO, DM, FF, 0, 1, SCR, gw, NGW, lane);
        transpose_matrix(a.in[10], DM, DIN, WMI, DINP, DM, 0, 2, SCR, gw, NGW, lane);
        transpose_matrix(a.in[16], 512, DM, WMO, DM, DM, 0, 1, SCR, gw, NGW, lane);
        transpose_matrix(a.in[13], 256, NQA, WUQ, 256, 256, 512, 3, SCR, gw, NGW, lane);
        }
        REPS(101) {
        const float* wuq = a.in[13]; const float* wukv = a.in[15]; const float* wmo = a.in[16];
        for (int idx = gtid; idx < 512 * 256; idx += gthreads) {
            const int k = idx & 255, np = idx >> 8, head = np >> 7, c = np & 127;
            const f32x4* x = (const f32x4*)(wuq + (size_t)k * NQA + head * KVW); const f32x4* y = (const f32x4*)(wukv + (size_t)c * 1024 + head * 256);
            float s = 0.f;
#pragma unroll 8
            for (int n = 0; n < 32; ++n) { const f32x4 xv = x[n], yv = y[n]; s += (xv.x * yv.x + xv.y * yv.y) + (xv.z * yv.z + xv.w * yv.w); }
            WUQ[(size_t)np * 256 + k] = (bf16)f2bf(s);
        }
        for (int idx = gtid; idx < 1024 * 64; idx += gthreads) {
            const int n = idx & 1023, hc = idx >> 10, head = hc >> 4, c8 = hc & 15;
            float s[8];
#pragma unroll
            for (int j = 0; j < 8; ++j) s[j] = 0.f;
            const float* wm = wmo + (size_t)(512 + head * 128) * DM + n; const float* uk = wukv + (size_t)(c8 * 8) * 1024 + head * 256 + 128;
#pragma unroll 2
            for (int v = 0; v < 128; v += 4) {
                float m[4];
#pragma unroll
                for (int q = 0; q < 4; ++q) m[q] = wm[(size_t)(v + q) * DM];
#pragma unroll
                for (int j = 0; j < 8; ++j) { const f32x4 u = *(const f32x4*)(uk + (size_t)j * 1024 + v); s[j] += (u.x * m[0] + u.y * m[1]) + (u.z * m[2] + u.w * m[3]); } }
            v4u w; w.x = pk2(s[0], s[1]); w.y = pk2(s[2], s[3]); w.z = pk2(s[4], s[5]); w.w = pk2(s[6], s[7]);
            *(v4u*)(WMO + (size_t)n * DM + 512 + head * 128 + c8 * 8) = w;
        }
        }
        REPS(102) {
        for (int idx = gtid; idx < LP * 64; idx += gthreads) {
            const int pos = idx >> 6, i = idx & 63;
            const float inv = (float)exp2(-(double)(2 * i) * (13.287712379549449 / 128.0));
            float sn, cs; sincos_acc((float)pos * inv, sn, cs);
            R128[idx] = (f32x2){cs, sn};
            if ((i & 1) == 0) R64[(size_t)pos * 32 + (i >> 1)] = (f32x2){cs, sn};
        }
        }
        REPS(103) {
        for (int r = gw; r < MTOT; r += NGW) {
            const float* xr = x_row(a, r); v2u* o = (v2u*)(A16A + (size_t)r * DM) + lane;
#pragma unroll
            for (int j = 0; j < 4; ++j) { v2u w = {0u, 0u}; if (xr) { const f32x4 v = *((const f32x4*)xr + lane + 64 * j); w.x = pk2(v.x, v.y); w.y = pk2(v.z, v.w); } o[64 * j] = w; }
        }
        }
    }
    GRID_BAR();
#ifndef NO_P1
    REPS(1) { pg8::Gemm g{A16A, WFI, MTOT, 2 * FF, DM}; pg8::StaticOrder S; S.init(MTOT, 2 * FF, G, bx, DM); EpiSwiglu E{HID};
      pg8::gemm_phase<EpiSwiglu, pg8::StaticOrder, true, true>(L, g, S, E); }
#endif
    GRID_BAR();
#ifndef NO_P2
    REPS(2) { pg8::Gemm g{HID, WFO, MTOT, DM, FF}; pg8::SplitOrder S; S.init(MAIN_ROWS, MTOT, DM, G, bx, FF, 11); EpiResZ<0> E{Z, nullptr, a, 0.5f};
      pg8::gemm_phase<EpiResZ<0>, pg8::SplitOrder, true, true>(L, g, S, E, (float*)A16A); }
#endif
    GRID_BAR();
    REPS(3) ln_rows<false, 0>(a, Z, a.in[8], a.in[9], A16B, (const float*)A16A, 11, nullptr, 0.5f, gw, NGW, lane);
    GRID_BAR();
#ifndef NO_P4
    REPS(4) { pg8::Gemm g{A16B, WMI, MTOT, DINP, DM}; pg8::StaticOrder S; S.init(MTOT, DINP, G, bx, DM);
      EpiMixIn E{(bf16*)(ws + WS_QR), (bf16*)(ws + WS_KR), (bf16*)(ws + WS_VR), (bf16*)(ws + WS_GS), (float*)(ws + WS_P2RAW), R128};
      pg8::gemm_phase<EpiMixIn, pg8::StaticOrder, true, true>(L, g, S, E); }
#endif
    GRID_BAR();
    REPS(5) { post_rows(a, gw, NGW, lane);
    transpose_matrix(a.in[19], DM, 2 * FF, WFI, 2 * FF, DM, 0, 0, SCR, gw, NGW, lane);
    transpose_matrix(a.in[20], FF, DM, WFO, DM, FF, 0, 1, SCR, gw, NGW, lane); }
    GRID_BAR();
#ifndef NO_P6
    REPS(6) { int kq = 256; asm volatile("" : "+s"(kq));
      pg8::Gemm g{(const bf16*)(ws + WS_CQB), WUQ, MTOT, NQA, kq}; pg8::StaticOrder S; S.init(MTOT, NQA, G, bx, kq); EpiUq E{(bf16*)(ws + WS_QA), R64};
      pg8::gemm_phase<EpiUq, pg8::StaticOrder, true, true>(L, g, S, E); }
#endif
    GRID_BAR();
    {
        REPS(70) for (int i = vcu; i < NRET; i += G) ret_kv_item(a, L, ret_item(i), tid);
        REPS(71) {
            const int b = vcu & 3, j = vcu >> 2, c1 = j >> 1, qh = j & 1, e = vcu / 15;
            const int nu = (vcu % 15 == 0 && e < DBS + 1) ? 3 : 2;
            for (int ui = 0; ui < nu; ++ui) {
                const int type = ui < 2 ? 0 : (e < DBS ? 1 : 2), bi = ui < 2 ? b : (e < DBS ? e : 0), cc = ui == 0 ? 63 - c1 : c1;
                attn_unit(a, L, type, bi, cc, qh, tid);
            }
        }
    }
    GRID_BAR();
    ret_scan(a, gtid, gthreads);
    GRID_BAR();
    REPS(9) for (int i = vcu; i < NRET; i += G) ret_out_item(a, L, ret_item(i), tid);
    GRID_BAR();
#ifndef NO_P10
    REPS(10) { pg8::Gemm g{A16A, WMO, MTOT, DM, DM}; pg8::SplitOrder S; S.init(MAIN_ROWS, MTOT, DM, G, bx, DM, 4); EpiResZ<1> E{Z, A16B, a, 1.0f};
      pg8::gemm_phase<EpiResZ<1>, pg8::SplitOrder, true, true>(L, g, S, E, (float*)HID); }
#endif
    GRID_BAR();
    ln_rows<false, 1>(a, Z, a.in[17], a.in[18], A16B, (const float*)HID, 4, A16B, 1.0f, gw, NGW, lane);
    GRID_BAR();
#ifndef NO_P12
    REPS(12) { pg8::Gemm g{A16B, WFI, MTOT, 2 * FF, DM}; pg8::StaticOrder S; S.init(MTOT, 2 * FF, G, bx, DM); EpiSwiglu E{HID};
      pg8::gemm_phase<EpiSwiglu, pg8::StaticOrder, true, true>(L, g, S, E); }
#endif
    GRID_BAR();
#ifndef NO_P13
    REPS(13) { pg8::Gemm g{HID, WFO, MTOT, DM, FF}; pg8::SplitOrder S; S.init(MAIN_ROWS, MTOT, DM, G, bx, FF, 11); EpiResZ<1> E{Z, A16B, a, 0.5f};
      pg8::gemm_phase<EpiResZ<1>, pg8::SplitOrder, true, true>(L, g, S, E, (float*)A16A); }
#endif
    GRID_BAR();
    ln_rows<true, 1>(a, Z, a.in[21], a.in[22], nullptr, (const float*)A16A, 11, A16B, 0.5f, gw, NGW, lane);
#undef GRID_BAR
}

extern "C" void kernel_launch(void* const* d_in, const int* in_sizes, int n_in, void* d_out, int out_size, void* d_ws, size_t ws_size, hipStream_t stream) {
    static int grid = 0;
    if (grid == 0) {
        if (n_in != 23 || out_size != (int)O_END || ws_size < WS_END) { fprintf(stderr, "kernel_launch: unexpected shapes (n_in %d, out %d, ws %zu; need 23, %zu, >= %zu)\n", n_in, out_size, ws_size, (size_t)O_END, (size_t)WS_END); grid = -1; return; }
        int dev = 0, cus = 0, per_cu = 0;
        if (hipGetDevice(&dev) != hipSuccess || hipDeviceGetAttribute(&cus, hipDeviceAttributeMultiprocessorCount, dev) != hipSuccess) { grid = -1; return; }
        if (hipFuncSetAttribute((const void*)fwd_mega, hipFuncAttributeMaxDynamicSharedMemorySize, LDS_BYTES) != hipSuccess) { fprintf(stderr, "kernel_launch: hipFuncSetAttribute failed\n"); grid = -1; return; }
        if (hipOccupancyMaxActiveBlocksPerMultiprocessor(&per_cu, (const void*)fwd_mega, NWAVES * 64, LDS_BYTES) != hipSuccess || per_cu < 1) { fprintf(stderr, "kernel_launch: occupancy query says %d blocks per CU\n", per_cu); per_cu = 1; }
        (void)hipGetLastError();
        grid = cus;
    }
    if (grid < 0) return;
    (void)hipMemsetAsync((char*)d_ws + WS_CTL, 0, CTL_BYTES, stream);
    Args a{};
    for (int i = 0; i < 23; ++i) a.in[i] = (const float*)d_in[i];
    a.out = (float*)d_out; a.ws = (unsigned char*)d_ws;
    void* args[] = {&a};
    hipError_t e = hipLaunchCooperativeKernel((const void*)fwd_mega, dim3(grid), dim3(NWAVES * 64), args, LDS_BYTES, stream);
    if (e != hipSuccess) fprintf(stderr, "kernel_launch: cooperative launch failed: %s (grid %d)\n", hipGetErrorString(e), grid);
}
```

```cpp
#include <hip/hip_runtime.h>
#include <hip/hip_cooperative_groups.h>
#include <cstdio>
#include <cstdint>

namespace pg8 {
#define PG8_LAS __attribute__((address_space(3)))
typedef unsigned short bf16_t;
typedef short bf16x8 __attribute__((ext_vector_type(8)));
typedef float f32x4 __attribute__((ext_vector_type(4)));
typedef unsigned u32x4 __attribute__((ext_vector_type(4)));
constexpr int BM = 256, BK = 64, HALF = 128, HTB = HALF * BK * 2  , STAGE_BYTES = 8 * HTB, NXCD = 8, WGM = 8;

__host__ __device__ __forceinline__ int lds_byte(int r, int c) { const int st = (r >> 4) * 2 + (c >> 5), rr = r & 15, cc = c & 31, ob = rr * 64 + cc * 2; return st * 1024 + (ob ^ (((ob >> 9) & 1) << 5)); }
__host__ __device__ __forceinline__ void stage_rc(int b, int& R, int& C) { const int st = b / 1024, sb = b % 1024, swz = sb ^ (((sb >> 9) & 1) << 5); R = (st >> 1) * 16 + swz / 64; C = (st & 1) * 32 + (swz % 64) / 2; }
__host__ __device__ __forceinline__ int perm32(int rho) { const int n = rho >> 4, i = rho & 15; return 8 * (i >> 2) + 4 * n + (i & 3); }

struct Unit { int pm, pn, kt0, nkt, slab; };
struct SplitOrder;
struct Gemm { const bf16_t* A; const bf16_t* Bt; int M, N, K; };

struct StaticOrder {
    int nM, nN, nwg, G, c, nkt;
    __host__ __device__ void init(int M, int N, int G_, int c_, int K_) { nM = M / BM; nN = N / BM; nwg = nM * nN; G = G_; c = c_; nkt = K_ / BK; }
    __host__ __device__ bool next(int i, Unit& u) const {
        const long L = (long)i * G + c; if (L >= nwg) return false;
        int wgid = (int)L; { const int q = nwg / NXCD, r = nwg % NXCD, xcd = wgid % NXCD, off = wgid / NXCD; wgid = (xcd < r ? xcd * (q + 1) : r * (q + 1) + (xcd - r) * q) + off; }
        const int nig = WGM * nN, gid = wgid / nig, fm = gid * WGM, gsz = (nM - fm) < WGM ? (nM - fm) : WGM;
        u.pm = fm + ((wgid % nig) % gsz); u.pn = (wgid % nig) / gsz; u.kt0 = 0; u.nkt = nkt; u.slab = -1; return true;
    }
    __device__ __forceinline__ void a_ready(const Unit&) const {}
    __device__ __forceinline__ void done(const Unit&) const {}
};
struct SplitOrder {
    StaticOrder main; int nMain, nN, spu, kts, nslice, c;
    __host__ __device__ void init(int Mmain, int Mtot, int N, int G_, int c_, int K_, int spu_) { main.init(Mmain, N, G_, c_, K_); nMain = Mmain / BM; nN = N / BM; spu = spu_; kts = (K_ / BK) / spu_; nslice = (Mtot / BM - nMain) * nN * spu_; c = c_; }
    __host__ __device__ bool next(int i, Unit& u) const {
        if (i == 0) return main.next(0, u);
        if (i > 1 || c >= nslice) return false;
        const int e = c / spu, s = c % spu; u.pm = nMain + e / nN; u.pn = e % nN; u.kt0 = s * kts; u.nkt = kts; u.slab = c; return true;
    }
    __device__ __forceinline__ void a_ready(const Unit&) const {}
    __device__ __forceinline__ void done(const Unit&) const {}
};


__device__ __forceinline__ unsigned cvt_pk_bf16(float lo, float hi) { unsigned r; asm volatile("v_cvt_pk_bf16_f32 %0, %1, %2" : "=v"(r) : "v"(lo), "v"(hi)); return r; }
typedef float f32x2 __attribute__((ext_vector_type(2)));

template <class Epi, class Sched, bool ALIGN_EPI = false, bool SP2 = false>
__device__ __forceinline__ void gemm_phase(PG8_LAS unsigned char* lds, const Gemm g, const Sched& S, const Epi& E, float* slabs = nullptr) {
    int tid_ = threadIdx.x; asm volatile("" : "+v"(tid_));
    const int tid = tid_, wid = __builtin_amdgcn_readfirstlane(tid >> 6), lane = tid & 63, wr = wid >> 2, wc = wid & 3, fr = lane & 15, fq = lane >> 4;
    const int K = g.K;
    unsigned voffA[2], voffB[2];
#pragma unroll
    for (int i = 0; i < 2; ++i) { int R, C; stage_rc(tid * 16 + i * 8192, R, C); const int Rb = Epi::PERM ? ((R & ~31) + perm32(R & 31)) : R;
        voffA[i] = (unsigned)(R * K + C) * 2u; voffB[i] = (unsigned)(Rb * K + C) * 2u; }
    const size_t kstep = (size_t)(BK * 2);
    const size_t hstep = (size_t)HALF * K * 2;
    const size_t tstep = 2 * hstep;
    const unsigned ldsw = (unsigned)wid * 1024u;
    const int aoff = lds_byte(wr * 64 + fr, fq * 8), boff = lds_byte(wc * 32 + fr, fq * 8);
#define PG8_SA(b, h) (((b) * 2 + (h)) * HTB)
#define PG8_SB(b, h) ((4 + (b) * 2 + (h)) * HTB)
#define PG8_STAGE(bufoff, gbase, voff) do { _Pragma("unroll") for (int _i = 0; _i < 2; ++_i) \
        __builtin_amdgcn_global_load_lds((const unsigned*)((const char*)(gbase) + (voff)[_i]), (PG8_LAS unsigned*)(lds + (bufoff) + ldsw + _i * 8192), 16, 0, 0); } while (0)
#define PG8_LDA(dst, b, h) do { _Pragma("unroll") for (int m = 0; m < 4; ++m) _Pragma("unroll") for (int k = 0; k < 2; ++k) dst[m][k] = *(const PG8_LAS bf16x8*)(lds + PG8_SA(b, h) + aoff + m * 2048 + k * 1024); } while (0)
#define PG8_LDB(dst, b, h) do { _Pragma("unroll") for (int n = 0; n < 2; ++n) _Pragma("unroll") for (int k = 0; k < 2; ++k) dst[n][k] = *(const PG8_LAS bf16x8*)(lds + PG8_SB(b, h) + boff + n * 2048 + k * 1024); } while (0)
#define PG8_MMA(ai, bj, At, Bt) do { __builtin_amdgcn_s_setprio(1); _Pragma("unroll") for (int m = 0; m < 4; ++m) _Pragma("unroll") for (int n = 0; n < 2; ++n) _Pragma("unroll") for (int k = 0; k < 2; ++k) \
        acc[ai][bj][m][n] = __builtin_amdgcn_mfma_f32_16x16x32_bf16(Bt[n][k], At[m][k], acc[ai][bj][m][n], 0, 0, 0); __builtin_amdgcn_s_setprio(0); } while (0)
#define PG8_WAIT_V(n) asm volatile("s_waitcnt vmcnt(" #n ")" ::: "memory")
#define PG8_WAIT_L(n) asm volatile("s_waitcnt lgkmcnt(" #n ")" ::: "memory")
#define PG8_BAR __builtin_amdgcn_s_barrier()
#define PG8_SCHED __builtin_amdgcn_sched_barrier(0)
    Unit cur, nxt; int ui = 0;
    if (!S.next(0, cur)) return;
    f32x4 acc[2][2][4][2];
#pragma unroll
    for (int a = 0; a < 2; ++a)
#pragma unroll
        for (int b = 0; b < 2; ++b)
#pragma unroll
            for (int m = 0; m < 4; ++m)
#pragma unroll
                for (int n = 0; n < 2; ++n) acc[a][b][m][n] = (f32x4){0.f, 0.f, 0.f, 0.f};
    bf16x8 At[4][2], B0[2][2], B1[2][2];
    const char* cA = (const char*)g.A + (size_t)cur.pm * tstep + (size_t)cur.kt0 * kstep; const char* cB = (const char*)g.Bt + (size_t)cur.pn * tstep + (size_t)cur.kt0 * kstep;
    S.a_ready(cur);
    if constexpr (SP2) {
        PG8_STAGE(PG8_SB(0, 0), cB, voffB); PG8_STAGE(PG8_SB(0, 1), cB + hstep, voffB); PG8_STAGE(PG8_SA(0, 0), cA, voffA); PG8_STAGE(PG8_SA(0, 1), cA + hstep, voffA);
        if (wr == 1) PG8_BAR;
        PG8_WAIT_V(2); PG8_BAR;
        PG8_STAGE(PG8_SB(1, 0), cB + kstep, voffB); PG8_STAGE(PG8_SA(1, 0), cA + kstep, voffA); PG8_STAGE(PG8_SB(1, 1), cB + hstep + kstep, voffB);
        PG8_WAIT_V(6); PG8_BAR;
    } else {
        PG8_STAGE(PG8_SB(0, 0), cB, voffB); PG8_STAGE(PG8_SA(0, 0), cA, voffA); PG8_STAGE(PG8_SB(0, 1), cB + hstep, voffB); PG8_STAGE(PG8_SA(0, 1), cA + hstep, voffA);
        if (wr == 1) PG8_BAR;
        PG8_WAIT_V(4); PG8_BAR;
        PG8_STAGE(PG8_SB(1, 0), cB + kstep, voffB); PG8_STAGE(PG8_SA(1, 0), cA + kstep, voffA); PG8_STAGE(PG8_SB(1, 1), cB + hstep + kstep, voffB);
        PG8_WAIT_V(6); PG8_BAR;
    }
    for (;;) {
        const bool has_next = S.next(ui + 1, nxt);
        const char* nA = has_next ? (const char*)g.A + (size_t)nxt.pm * tstep + (size_t)nxt.kt0 * kstep : cA; const char* nB = has_next ? (const char*)g.Bt + (size_t)nxt.pn * tstep + (size_t)nxt.kt0 * kstep : cB;
        const int nt = cur.nkt;
        for (int t = 0; t < nt; t += 2) {
            const bool last = (t == nt - 2);
            const char* a1 = cA + (size_t)(t + 1) * kstep;
            const char* a2 = last ? nA : cA + (size_t)(t + 2) * kstep; const char* b2 = last ? nB : cB + (size_t)(t + 2) * kstep;
            const char* a3 = a2 + kstep; const char* b3 = b2 + kstep;
            if (last && has_next) S.a_ready(nxt);
            if constexpr (SP2) {
            PG8_LDB(B0, 0, 0); PG8_LDB(B1, 0, 1); PG8_SCHED; PG8_LDA(At, 0, 0); PG8_STAGE(PG8_SA(1, 1), a1 + hstep, voffA);
            PG8_WAIT_V(8); PG8_WAIT_L(0); PG8_BAR; PG8_MMA(0, 0, At, B0); PG8_MMA(0, 1, At, B1); PG8_BAR; PG8_SCHED;
            PG8_LDA(At, 0, 1); PG8_STAGE(PG8_SB(0, 0), b2, voffB); PG8_STAGE(PG8_SB(0, 1), b2 + hstep, voffB); PG8_STAGE(PG8_SA(0, 0), a2, voffA);
            PG8_WAIT_V(8); PG8_WAIT_L(0); PG8_BAR; PG8_MMA(1, 0, At, B0); PG8_MMA(1, 1, At, B1); PG8_BAR; PG8_SCHED;
            PG8_LDB(B0, 1, 0); PG8_LDB(B1, 1, 1); PG8_SCHED; PG8_LDA(At, 1, 0); PG8_STAGE(PG8_SA(0, 1), a2 + hstep, voffA);
            PG8_WAIT_V(8); PG8_WAIT_L(0); PG8_BAR; PG8_MMA(0, 0, At, B0); PG8_MMA(0, 1, At, B1); PG8_BAR; PG8_SCHED;
            PG8_LDA(At, 1, 1); PG8_STAGE(PG8_SB(1, 0), b3, voffB); PG8_STAGE(PG8_SB(1, 1), b3 + hstep, voffB); PG8_STAGE(PG8_SA(1, 0), a3, voffA);
            PG8_WAIT_V(8); PG8_WAIT_L(0); PG8_BAR; PG8_MMA(1, 0, At, B0); PG8_MMA(1, 1, At, B1); PG8_BAR; PG8_SCHED;
            } else {
            PG8_LDB(B0, 0, 0); PG8_SCHED; PG8_LDA(At, 0, 0); PG8_STAGE(PG8_SA(1, 1), a1 + hstep, voffA);
            PG8_WAIT_L(8); PG8_BAR; PG8_WAIT_L(0); PG8_MMA(0, 0, At, B0); PG8_BAR; PG8_SCHED;
            PG8_LDB(B1, 0, 1); PG8_STAGE(PG8_SB(0, 0), b2, voffB);
            PG8_BAR; PG8_WAIT_L(0); PG8_MMA(0, 1, At, B1); PG8_BAR;
            PG8_LDA(At, 0, 1); PG8_STAGE(PG8_SA(0, 0), a2, voffA);
            PG8_BAR; PG8_WAIT_L(0); PG8_MMA(1, 0, At, B0); PG8_BAR; PG8_SCHED;
            PG8_STAGE(PG8_SB(0, 1), b2 + hstep, voffB);
            PG8_WAIT_V(6); PG8_BAR; PG8_MMA(1, 1, At, B1); PG8_BAR;
            PG8_LDB(B0, 1, 0); PG8_SCHED; PG8_LDA(At, 1, 0); PG8_STAGE(PG8_SA(0, 1), a2 + hstep, voffA);
            PG8_WAIT_L(8); PG8_BAR; PG8_WAIT_L(0); PG8_MMA(0, 0, At, B0); PG8_BAR; PG8_SCHED;
            PG8_LDB(B1, 1, 1); PG8_STAGE(PG8_SB(1, 0), b3, voffB);
            PG8_BAR; PG8_WAIT_L(0); PG8_MMA(0, 1, At, B1); PG8_BAR;
            PG8_LDA(At, 1, 1); PG8_STAGE(PG8_SA(1, 0), a3, voffA);
            PG8_BAR; PG8_WAIT_L(0); PG8_MMA(1, 0, At, B0); PG8_BAR; PG8_SCHED;
            PG8_STAGE(PG8_SB(1, 1), b3 + hstep, voffB);
            PG8_WAIT_V(6); PG8_BAR; PG8_MMA(1, 1, At, B1); PG8_BAR;
            }
        }
        if constexpr (ALIGN_EPI) { if (wr == 0) PG8_BAR; }
        if constexpr (!Epi::AFTER_DRAIN) {
            if (cur.slab >= 0) {
                float* sb = slabs + (size_t)cur.slab * 65536 + (size_t)(wr * 64 + fr) * 256 + wc * 32 + 4 * fq;
#pragma unroll
                for (int ai = 0; ai < 2; ++ai)
#pragma unroll
                    for (int m = 0; m < 4; ++m)
#pragma unroll
                        for (int bj = 0; bj < 2; ++bj)
#pragma unroll
                            for (int n = 0; n < 2; ++n) *(f32x4*)(sb + (size_t)(ai * 128 + m * 16) * 256 + bj * 128 + n * 16) = acc[ai][bj][m][n];
            } else E(acc, cur, wr, wc, fr, fq);
            S.done(cur); }
        if (!has_next) break;
#pragma unroll
        for (int a = 0; a < 2; ++a)
#pragma unroll
            for (int b = 0; b < 2; ++b)
#pragma unroll
                for (int m = 0; m < 4; ++m)
#pragma unroll
                    for (int n = 0; n < 2; ++n) acc[a][b][m][n] = (f32x4){0.f, 0.f, 0.f, 0.f};
        cur = nxt; cA = nA; cB = nB; ++ui;
        if constexpr (ALIGN_EPI) { if (wr == 1) PG8_BAR; }
    }
    PG8_WAIT_V(0);
    if constexpr (!ALIGN_EPI) { if (wr == 0) PG8_BAR; }
    PG8_BAR;
    if constexpr (Epi::AFTER_DRAIN) { E.fused(acc, cur, wr, wc, fr, fq, lds, wid, lane); S.done(cur); }
#undef PG8_SA
#undef PG8_SB
#undef PG8_STAGE
#undef PG8_LDA
#undef PG8_LDB
#undef PG8_MMA
#undef PG8_WAIT_V
#undef PG8_WAIT_L
#undef PG8_BAR
#undef PG8_SCHED
}
}

#define LAS __attribute__((address_space(3)))

#define XB_TMO      128
#define XB_XCNT(j)  (256  + 64 * (j))
#define XB_XSUB(j)  (1280 + 64 * (j))
#define XB_XGEN(j)  (2304 + 64 * (j))
#define XB_TOP      3328
#define XB_TOPGEN   3392
#define XCD_BAR_WORDS 3456
#define XB_SPIN_CAP (1u << 18)

__device__ __forceinline__ unsigned xb_ld(unsigned* p)              { return __hip_atomic_load(p, __ATOMIC_RELAXED, __HIP_MEMORY_SCOPE_AGENT); }
__device__ __forceinline__ unsigned xb_add(unsigned* p, unsigned v) { return __hip_atomic_fetch_add(p, v, __ATOMIC_RELAXED, __HIP_MEMORY_SCOPE_AGENT); }
__device__ __forceinline__ unsigned xb_xcc_id() { return (unsigned)__builtin_amdgcn_s_getreg((3 << 11) | 20) & 0xFu; }
#define XB_SPIN(cond, bar) do { unsigned _sp = 0; while (cond) { __builtin_amdgcn_s_sleep(1); \
    if ((++_sp & 255u) == 0u) { if (xb_ld(&(bar)[XB_TMO])) break; if (_sp > XB_SPIN_CAP) { atomicAdd(&(bar)[XB_TMO], 1u); break; } } } } while (0)

struct XcdBarrier {
    unsigned* bar; unsigned x;
    volatile LAS unsigned* st;
};

__device__ __forceinline__ XcdBarrier xcd_barrier_post(unsigned* bar, volatile LAS unsigned* st) {
    XcdBarrier b; b.bar = bar; b.x = xb_xcc_id(); b.st = st;
    if (threadIdx.x == 0) (void)xb_add(&bar[XB_XCNT(b.x)], 1u);
    return b;
}
__device__ __forceinline__ void xcd_barrier_complete(unsigned* bar, unsigned x, unsigned& nloc, unsigned& nx) {
    const unsigned G = gridDim.x * gridDim.y * gridDim.z;
    unsigned sum, cnt, mine, sp = 0u;
    for (;;) {
        sum = 0u; cnt = 0u; mine = 0u;
#pragma unroll
        for (unsigned j = 0; j < 16; ++j) { const unsigned c = xb_ld(&bar[XB_XCNT(j)]); sum += c; cnt += (c > 0u) ? 1u : 0u; mine = (j == x) ? c : mine; }
        if (sum == G) break;
        __builtin_amdgcn_s_sleep(1);
        if ((++sp & 255u) == 0u) { if (xb_ld(&bar[XB_TMO])) break; if (sp > XB_SPIN_CAP) { atomicAdd(&bar[XB_TMO], 1u); break; } }
    }
    nloc = mine > 0u ? mine : 1u; nx = cnt > 0u ? cnt : 1u;
}

__device__ __forceinline__ void xcd_barrier(const XcdBarrier& b) {
    asm volatile("s_waitcnt vmcnt(0)" ::: "memory");
    __syncthreads();
    if (threadIdx.x == 0) {
        unsigned* bar = b.bar;
        __builtin_amdgcn_s_waitcnt(0);
        unsigned nloc = b.st[0], nx = b.st[1];
        if (nloc == 0u) { xcd_barrier_complete(bar, b.x, nloc, nx); b.st[0] = nloc; b.st[1] = nx; }
        const unsigned old = xb_add(&bar[XB_XSUB(b.x)], 1u);
        const unsigned gen = old / nloc;
        if (old + 1u == (gen + 1u) * nloc) {
            __builtin_amdgcn_fence(__ATOMIC_RELEASE, "agent");
            asm volatile("s_waitcnt vmcnt(0)" ::: "memory");
            const unsigned og = xb_add(&bar[XB_TOP], 1u);
            const unsigned tg = og / nx;
            if (og + 1u == (tg + 1u) * nx) xb_add(&bar[XB_TOPGEN], 1u);
            else XB_SPIN(xb_ld(&bar[XB_TOPGEN]) == tg, bar);
            __builtin_amdgcn_fence(__ATOMIC_ACQUIRE, "agent");
            xb_add(&bar[XB_XGEN(b.x)], 1u);
            asm volatile("s_waitcnt vmcnt(0)" ::: "memory");
        } else {
            XB_SPIN(xb_ld(&bar[XB_XGEN(b.x)]) == gen, bar);
            __builtin_amdgcn_fence(__ATOMIC_ACQUIRE, "agent");
            asm volatile("s_waitcnt vmcnt(0)" ::: "memory");
        }
    }
    __syncthreads();
}


#define GAS __attribute__((address_space(1)))

typedef unsigned short bf16;
typedef unsigned v4u __attribute__((ext_vector_type(4)));
typedef unsigned v2u __attribute__((ext_vector_type(2)));
typedef float f32x4 __attribute__((ext_vector_type(4)));
typedef float f32x2 __attribute__((ext_vector_type(2)));
typedef float f32x16 __attribute__((ext_vector_type(16)));
typedef short bf16x8 __attribute__((ext_vector_type(8)));
#define LDS_WAIT() asm volatile("s_waitcnt lgkmcnt(0)" ::: "memory")
#define VM_WAIT() asm volatile("s_waitcnt vmcnt(0)" ::: "memory")

constexpr int DM = 1024, NMETA = 16, SEQ = 4096, NB = 4, DBS = 16, TS = 32, PAST = 1024, FF = 2816, LP = NMETA + SEQ;
constexpr int R_PROMPT = 16, R_SAMPLE = R_PROMPT + NB * SEQ, R_VALID = R_SAMPLE + DBS * TS, MTOT = 17152;
static_assert(R_SAMPLE == 16400 && R_VALID == 16912 && MTOT % 256 == 0 && MTOT >= R_VALID + 64, "row space");
constexpr int DIN = 2496, DINP = 2560, NQA = 768, KVW = 192;
constexpr float DN_ALPHA = 1.189207115002721f, LN_EPS = 1e-5f, RMS_EPS = 1e-6f, LOG2E = 1.4426950408889634f;
constexpr float SM_SCALE = 0.07216878364870322f;
constexpr float KR_SCALE = 0.08838834764831845f;
constexpr size_t O_YP = 0, O_YS = O_YP + (size_t)NB * SEQ * DM, O_PCKV = O_YS + (size_t)DBS * TS * DM, O_PKPE = O_PCKV + (size_t)NB * LP * 128, O_PST = O_PKPE + (size_t)NB * LP * 64,
                 O_SCKV = O_PST + (size_t)NB * 4 * 128 * 128, O_SKPE = O_SCKV + (size_t)DBS * TS * 128, O_SST = O_SKPE + (size_t)DBS * TS * 64, O_END = O_SST + (size_t)DBS * 4 * 128 * 128;
static_assert(O_END == 21868544, "d_out size");

constexpr size_t al256(size_t x) { return (x + 255) & ~(size_t)255; }
constexpr size_t WS_CTL = 0, CTL_BYTES = 1u << 20;
constexpr size_t WS_WFI = WS_CTL + CTL_BYTES;
constexpr size_t WS_WFO = WS_WFI + (size_t)5632 * 1024 * 2;
constexpr size_t WS_WMI = WS_WFO + (size_t)1024 * 2816 * 2;
constexpr size_t WS_WMO = WS_WMI + (size_t)2560 * 1024 * 2;
constexpr size_t WS_WUQ = WS_WMO + (size_t)1024 * 1024 * 2;
constexpr size_t WS_R128 = WS_WUQ + (size_t)768 * 256 * 2;
constexpr size_t WS_R64 = WS_R128 + (size_t)LP * 64 * 8;
constexpr size_t WS_A16A = al256(WS_R64 + (size_t)LP * 32 * 8);
constexpr size_t A16_BYTES = (size_t)MTOT * 1024 * 2;
constexpr size_t WS_A16B = WS_A16A + A16_BYTES;
constexpr size_t WS_Z = WS_A16B + A16_BYTES;
constexpr size_t Z_BYTES = (size_t)MTOT * 1024 * 4;
constexpr size_t WS_HID = WS_Z + Z_BYTES;
constexpr size_t HID_BYTES = (size_t)MTOT * 2816 * 2;
constexpr size_t WS_END = WS_HID + HID_BYTES;
static_assert(WS_END <= 268435456, "workspace map exceeds 256 MiB");
constexpr size_t WS_P2RAW = WS_Z;
constexpr size_t WS_QA = WS_Z;
constexpr size_t WS_KVN = WS_QA + (size_t)MTOT * 768 * 2;
constexpr int KVN_ITEMS = 4 + NB * 4 * 64;
constexpr size_t WS_KVCT = WS_KVN + (size_t)KVN_ITEMS * 32768;
constexpr size_t WS_CKVT = WS_KVCT + (size_t)DBS * 128 * PAST * 2;
static_assert(WS_CKVT + (size_t)128 * MTOT * 2 <= WS_Z + Z_BYTES && WS_KVCT >= WS_P2RAW + (size_t)MTOT * 512 * 4, "Z overlays");
constexpr size_t RB_BYTES = (size_t)MTOT * 512 * 2;
constexpr size_t WS_QR = WS_HID, WS_KR = WS_QR + RB_BYTES, WS_VR = WS_KR + RB_BYTES, WS_GS = WS_VR + RB_BYTES;
constexpr size_t WS_KVB = WS_GS + RB_BYTES;
constexpr size_t WS_KVC = WS_KVB + (size_t)MTOT * KVW * 2;
constexpr size_t WS_CQB = WS_KVC + (size_t)DBS * PAST * KVW * 2;
static_assert(WS_CQB + (size_t)MTOT * 256 * 2 <= WS_HID + HID_BYTES, "HID overlays");
constexpr int CW_BAR = 4096;
constexpr int CW_ATTQ = 16384;

__device__ __forceinline__ float lg2gamma(int h) { return h == 0 ? -0.04580368961312479f : h == 1 ? -0.02272007650008353f : h == 2 ? -0.011315313227834146f : -0.005646563141142063f; }

__device__ __forceinline__ int row_pos(int r) { return r < R_PROMPT ? r : (r < R_SAMPLE ? NMETA + ((r - R_PROMPT) & (SEQ - 1)) : (r < R_VALID ? NMETA + PAST + ((r - R_SAMPLE) & (TS - 1)) : 0)); }
__device__ __forceinline__ unsigned f2bf(float f) { unsigned u = __builtin_bit_cast(unsigned, f); return (u + 0x7fffu + ((u >> 16) & 1u)) >> 16; }
__device__ __forceinline__ unsigned pk2(float lo, float hi) { return pg8::cvt_pk_bf16(lo, hi); }
__device__ __forceinline__ float bf2f(unsigned short b) { return __builtin_bit_cast(float, (unsigned)b << 16); }
__device__ __forceinline__ float bflo(unsigned w) { return __builtin_bit_cast(float, w << 16); }
__device__ __forceinline__ float bfhi(unsigned w) { return __builtin_bit_cast(float, w & 0xffff0000u); }
__device__ __forceinline__ float siluf(float x) { return x * __builtin_amdgcn_rcpf(1.0f + __builtin_amdgcn_exp2f(-x * LOG2E)); }
__device__ __forceinline__ float wave_sum(float v) {
#pragma unroll
    for (int o = 1; o < 64; o <<= 1) v += __shfl_xor(v, o);
    return v;
}

struct Args { const float* in[23]; float* out; unsigned char* ws; };

__device__ __forceinline__ const float* x_row(const Args& a, int r) {
    if (r < R_PROMPT) return a.in[5] + (size_t)r * DM;
    if (r < R_SAMPLE) return a.in[0] + (size_t)(r - R_PROMPT) * DM;
    if (r < R_VALID) return a.in[1] + (size_t)(r - R_SAMPLE) * DM;
    return nullptr;
}

struct EpiSwiglu {
    static constexpr bool PERM = true, AFTER_DRAIN = false;
    bf16* H;
    __device__ __forceinline__ void operator()(const pg8::f32x4 (&acc)[2][2][4][2], const pg8::Unit& u, int wr, int wc, int fr, int fq) const {
        asm volatile("" : "+v"(fr), "+v"(fq));
        const int row0 = u.pm * 256 + wr * 64 + fr, col0 = u.pn * 128 + wc * 32 + 8 * fq;
#pragma unroll
        for (int ai = 0; ai < 2; ++ai)
#pragma unroll
            for (int m = 0; m < 4; ++m) {
                const int row = row0 + ai * 128 + m * 16;
                const pg8::f32x4 g0 = acc[ai][0][m][0], g1 = acc[ai][0][m][1], u0 = acc[ai][1][m][0], u1 = acc[ai][1][m][1];
                v4u w;
                w.x = pk2(siluf(g0[0]) * u0[0], siluf(g0[1]) * u0[1]); w.y = pk2(siluf(g0[2]) * u0[2], siluf(g0[3]) * u0[3]);
                w.z = pk2(siluf(g1[0]) * u1[0], siluf(g1[1]) * u1[1]); w.w = pk2(siluf(g1[2]) * u1[2], siluf(g1[3]) * u1[3]);
                *(v4u*)(H + (size_t)row * FF + col0) = w;
            }
    }
};
template <int SRC> struct EpiResZ {
    static constexpr bool PERM = false, AFTER_DRAIN = false;
    float* Z; const bf16* resb; Args a; float scale;
    __device__ __forceinline__ void operator()(const pg8::f32x4 (&acc)[2][2][4][2], const pg8::Unit& u, int wr, int wc, int fr, int fq) const {
        asm volatile("" : "+v"(fr), "+v"(fq));
        const int row0 = u.pm * 256 + wr * 64 + fr, col0 = u.pn * 256 + wc * 32 + 4 * fq;
#pragma unroll
        for (int ai = 0; ai < 2; ++ai)
#pragma unroll
            for (int m = 0; m < 4; ++m) {
                const int row = row0 + ai * 128 + m * 16;
                const float* xr = SRC == 0 ? x_row(a, row) : nullptr;
#pragma unroll
                for (int bj = 0; bj < 2; ++bj)
#pragma unroll
                    for (int n = 0; n < 2; ++n) {
                        const int c = col0 + bj * 128 + n * 16;
                        f32x4 rv;
                        if (SRC == 0) rv = xr ? *(const f32x4*)(xr + c) : (f32x4){0.f, 0.f, 0.f, 0.f};
                        else { const v2u w = *(const v2u*)(resb + (size_t)row * DM + c); rv = (f32x4){bflo(w.x), bfhi(w.x), bflo(w.y), bfhi(w.y)}; }
                        const pg8::f32x4 av = acc[ai][bj][m][n];
                        f32x4 o; o.x = DN_ALPHA * rv.x + scale * av[0]; o.y = DN_ALPHA * rv.y + scale * av[1]; o.z = DN_ALPHA * rv.z + scale * av[2]; o.w = DN_ALPHA * rv.w + scale * av[3];
                        *(f32x4*)(Z + (size_t)row * DM + c) = o;
                    }
                asm volatile("" ::: "memory");
            }
    }
};
struct EpiMixIn {
    static constexpr bool PERM = true, AFTER_DRAIN = false;
    bf16 *QR, *KR, *VR, *GS; float* P2; const f32x2* R128;
    __device__ __forceinline__ void operator()(const pg8::f32x4 (&acc)[2][2][4][2], const pg8::Unit& u, int wr, int wc, int fr, int fq) const {
        asm volatile("" : "+v"(fr), "+v"(fq));
        const int row0 = u.pm * 256 + wr * 64 + fr, pn = u.pn;
        if (pn < 4) {
            bf16* dst = pn < 2 ? QR : KR; const float sc = pn < 2 ? 1.0f : KR_SCALE;
            const int head = 2 * (pn & 1) + (wc >> 1), i0 = (wc & 1) * 32 + 8 * fq;
#pragma unroll
            for (int ai = 0; ai < 2; ++ai)
#pragma unroll
                for (int m = 0; m < 4; ++m) {
                    const int row = row0 + ai * 128 + m * 16;
                    const f32x2* cs = R128 + (size_t)row_pos(row) * 64 + i0;
                    float o1[8], o2[8];
#pragma unroll
                    for (int n = 0; n < 2; ++n)
#pragma unroll
                        for (int j = 0; j < 4; ++j) { const f32x2 t = cs[4 * n + j]; const float x1 = acc[ai][0][m][n][j], x2 = acc[ai][1][m][n][j];
                            o1[4 * n + j] = (x1 * t.x - x2 * t.y) * sc; o2[4 * n + j] = (x1 * t.y + x2 * t.x) * sc; }
                    v4u w1, w2;
                    w1.x = pk2(o1[0], o1[1]); w1.y = pk2(o1[2], o1[3]); w1.z = pk2(o1[4], o1[5]); w1.w = pk2(o1[6], o1[7]);
                    w2.x = pk2(o2[0], o2[1]); w2.y = pk2(o2[2], o2[3]); w2.z = pk2(o2[4], o2[5]); w2.w = pk2(o2[6], o2[7]);
                    bf16* p = dst + (size_t)row * 512 + head * 128 + i0;
                    *(v4u*)p = w1; *(v4u*)(p + 64) = w2;
                    asm volatile("" ::: "memory");
                }
        } else if (pn < 8) {
            bf16* dst = pn < 6 ? VR : GS; const bool act = pn >= 6;
            const int cb = (pn & 1) * 256 + wc * 32 + 8 * fq;
#pragma unroll
            for (int ai = 0; ai < 2; ++ai)
#pragma unroll
                for (int m = 0; m < 4; ++m) {
                    const int row = row0 + ai * 128 + m * 16;
#pragma unroll
                    for (int bj = 0; bj < 2; ++bj) {
                        pg8::f32x4 v0 = acc[ai][bj][m][0], v1 = acc[ai][bj][m][1];
                        if (act) {
#pragma unroll
                            for (int j = 0; j < 4; ++j) { v0[j] = siluf(v0[j]); v1[j] = siluf(v1[j]); } }
                        v4u w; w.x = pk2(v0[0], v0[1]); w.y = pk2(v0[2], v0[3]); w.z = pk2(v1[0], v1[1]); w.w = pk2(v1[2], v1[3]);
                        *(v4u*)(dst + (size_t)row * 512 + cb + bj * 128) = w;
                    }
                }
        } else {
            const int cb = (pn - 8) * 256 + wc * 32 + 8 * fq;
#pragma unroll
            for (int ai = 0; ai < 2; ++ai)
#pragma unroll
                for (int m = 0; m < 4; ++m) {
                    const int row = row0 + ai * 128 + m * 16;
#pragma unroll
                    for (int bj = 0; bj < 2; ++bj) {
                        float* p = P2 + (size_t)row * 512 + cb + bj * 128;
                        const pg8::f32x4 v0 = acc[ai][bj][m][0], v1 = acc[ai][bj][m][1];
                        *(f32x4*)p = (f32x4){v0[0], v0[1], v0[2], v0[3]}; *(f32x4*)(p + 4) = (f32x4){v1[0], v1[1], v1[2], v1[3]};
                    }
                }
        }
    }
};
struct EpiUq {
    static constexpr bool PERM = true, AFTER_DRAIN = false;
    bf16* QA; const f32x2* R64;
    __device__ __forceinline__ void operator()(const pg8::f32x4 (&acc)[2][2][4][2], const pg8::Unit& u, int wr, int wc, int fr, int fq) const {
        asm volatile("" : "+v"(fr), "+v"(fq));
        const int row0 = u.pm * 256 + wr * 64 + fr, pn = u.pn;
        if (pn < 2) {
#pragma unroll
            for (int ai = 0; ai < 2; ++ai)
#pragma unroll
                for (int m = 0; m < 4; ++m) {
                    const int row = row0 + ai * 128 + m * 16;
#pragma unroll
                    for (int bj = 0; bj < 2; ++bj) {
                        const pg8::f32x4 v0 = acc[ai][bj][m][0] * SM_SCALE, v1 = acc[ai][bj][m][1] * SM_SCALE;
                        v4u w; w.x = pk2(v0[0], v0[1]); w.y = pk2(v0[2], v0[3]); w.z = pk2(v1[0], v1[1]); w.w = pk2(v1[2], v1[3]);
                        *(v4u*)(QA + (size_t)row * NQA + (2 * pn + bj) * KVW + wc * 32 + 8 * fq) = w;
                    }
                }
        } else {
            const int head = wc, i0 = 8 * fq;
#pragma unroll
            for (int ai = 0; ai < 2; ++ai)
#pragma unroll
                for (int m = 0; m < 4; ++m) {
                    const int row = row0 + ai * 128 + m * 16;
                    const f32x2* cs = R64 + (size_t)row_pos(row) * 32 + i0;
                    float o1[8], o2[8];
#pragma unroll
                    for (int n = 0; n < 2; ++n)
#pragma unroll
                        for (int j = 0; j < 4; ++j) { const f32x2 t = cs[4 * n + j]; const float x1 = acc[ai][0][m][n][j], x2 = acc[ai][1][m][n][j];
                            o1[4 * n + j] = (x1 * t.x - x2 * t.y) * SM_SCALE; o2[4 * n + j] = (x1 * t.y + x2 * t.x) * SM_SCALE; }
                    v4u w1, w2;
                    w1.x = pk2(o1[0], o1[1]); w1.y = pk2(o1[2], o1[3]); w1.z = pk2(o1[4], o1[5]); w1.w = pk2(o1[6], o1[7]);
                    w2.x = pk2(o2[0], o2[1]); w2.y = pk2(o2[2], o2[3]); w2.z = pk2(o2[4], o2[5]); w2.w = pk2(o2[6], o2[7]);
                    bf16* p = QA + (size_t)row * NQA + head * KVW + 128 + i0;
                    *(v4u*)p = w1; *(v4u*)(p + 32) = w2;
                    asm volatile("" ::: "memory");
                }
        }
    }
};

__device__ __forceinline__ int src_col(int mat, int n) {
    if (mat == 0) { const int pn = n >> 8, bj = (n >> 7) & 1, i = n & 127; return bj * FF + 128 * pn + i; }
    if (mat == 2) {
        if (n < 1024) { const int pn = n >> 8, bj = (n >> 7) & 1, ip = n & 127, hh = ip >> 6, i = ip & 63; return (pn >> 1) * 512 + (2 * (pn & 1) + hh) * 128 + 64 * bj + i; }
        return n < DIN ? n : -1; }
    if (mat == 3) { const int bj = n >> 7, ip = n & 127, head = ip >> 5, i = ip & 31; return head * KVW + 128 + 32 * bj + i; }
    return n;
}
__device__ __forceinline__ void transpose_item(const float* __restrict__ W, int srcN, bf16* WT, int dstPitch, int dstRowOff, int mat, int k0, int n0, LAS float* scr, int lane) {
    const int sc = src_col(mat, n0 + (lane & 31));
#pragma unroll 8
    for (int i = 0; i < 32; ++i) { const int kk = 2 * i + (lane >> 5); scr[kk * 33 + (lane & 31)] = sc >= 0 ? W[(size_t)(k0 + kk) * srcN + sc] : 0.f; }
    LDS_WAIT();
    const int c = lane & 7;
#pragma unroll
    for (int j = 0; j < 4; ++j) { const int n = (lane >> 3) + 8 * j; const LAS float* s = scr + (8 * c) * 33 + n;
        v4u o; o.x = pk2(s[0 * 33], s[1 * 33]); o.y = pk2(s[2 * 33], s[3 * 33]); o.z = pk2(s[4 * 33], s[5 * 33]); o.w = pk2(s[6 * 33], s[7 * 33]);
        *(v4u*)(WT + (size_t)(dstRowOff + n0 + n) * dstPitch + k0 + 8 * c) = o; }
    LDS_WAIT();
}
__device__ __forceinline__ void transpose_matrix(const float* W, int Kdim, int srcN, bf16* WT, int Ndst, int dstPitch, int dstRowOff, int mat, LAS float* scr, int gw, int NGW, int lane) {
    const int nblk = Ndst / 32, nitems = (Kdim / 64) * nblk;
    for (int it = gw; it < nitems; it += NGW) transpose_item(W, srcN, WT, dstPitch, dstRowOff, mat, 64 * (it / nblk), 32 * (it % nblk), scr, lane);
}
__device__ __forceinline__ void sincos_acc(float ang, float& sn, float& cs) {
    const double x = (double)ang; const double kq = __builtin_rint(x * 0.63661977236758134308);
    const double r = (x - kq * 1.57079632679489655800e+00) - kq * 6.12323399573676603587e-17;
    const double r2 = r * r;
    const double s = r * (1.0 + r2 * (-1.0 / 6 + r2 * (1.0 / 120 + r2 * (-1.0 / 5040 + r2 * (1.0 / 362880 + r2 * (-1.0 / 39916800 + r2 * (1.0 / 6227020800.0)))))));
    const double c = 1.0 + r2 * (-0.5 + r2 * (1.0 / 24 + r2 * (-1.0 / 720 + r2 * (1.0 / 40320 + r2 * (-1.0 / 3628800 + r2 * (1.0 / 479001600 + r2 * (-1.0 / 87178291200.0)))))));
    const int q = (int)((long long)kq & 3);
    const double ss = (q == 0) ? s : (q == 1) ? c : (q == 2) ? -s : -c;
    const double cc = (q == 0) ? c : (q == 1) ? -s : (q == 2) ? -c : s;
    sn = (float)ss; cs = (float)cc;
}

constexpr int MAIN_ROWS = 16384;
template <bool FINAL, int RES, int SPU> __device__ __forceinline__ void ln_rows(const Args& a, const float* Z, const float* g, const float* b, bf16* outB, const float* slabs, const bf16* resb, float scale, int gw, int NGW, int lane) {
    f32x4 gv[4], bv[4];
#pragma unroll
    for (int j = 0; j < 4; ++j) { gv[j] = *(const f32x4*)(g + 4 * lane + 256 * j); bv[j] = *(const f32x4*)(b + 4 * lane + 256 * j); }
    for (int r = gw; r < (FINAL ? R_VALID : MTOT); r += NGW) {
        if (FINAL && r < R_PROMPT) continue;
        f32x4 v[4]; float s = 0.f;
        if (r < MAIN_ROWS) {
            const f32x4* zr = (const f32x4*)(Z + (size_t)r * DM) + lane;
#pragma unroll
            for (int j = 0; j < 4; ++j) v[j] = zr[64 * j];
        } else {
            const int pm = r >> 8, rl = r & 255; const float* xr = RES == 0 ? x_row(a, r) : nullptr;
#pragma unroll
            for (int j = 0; j < 4; ++j) {
                f32x4 acc = {0.f, 0.f, 0.f, 0.f};
                const float* sp = slabs + (size_t)(((pm - MAIN_ROWS / 256) * 4 + j) * SPU) * 65536 + (size_t)rl * 256 + 4 * lane;
                f32x4 t[SPU];
#pragma unroll
                for (int q = 0; q < SPU; ++q) t[q] = *(const f32x4*)(sp + (size_t)q * 65536);
#pragma unroll
                for (int q = 0; q < SPU; ++q) acc += t[q];
                f32x4 rv;
                if (RES == 0) rv = xr ? *((const f32x4*)xr + lane + 64 * j) : (f32x4){0.f, 0.f, 0.f, 0.f};
                else { const v2u w = *((const v2u*)(resb + (size_t)r * DM) + lane + 64 * j); rv = (f32x4){bflo(w.x), bfhi(w.x), bflo(w.y), bfhi(w.y)}; }
                v[j] = rv * DN_ALPHA + acc * scale;
            }
        }
#pragma unroll
        for (int j = 0; j < 4; ++j) s += (v[j].x + v[j].y) + (v[j].z + v[j].w);
        const float mean = wave_sum(s) * (1.f / DM); float s2 = 0.f;
#pragma unroll
        for (int j = 0; j < 4; ++j) { v[j] = v[j] - mean; s2 += (v[j].x * v[j].x + v[j].y * v[j].y) + (v[j].z * v[j].z + v[j].w * v[j].w); }
        const float rstd = 1.0f / sqrtf(wave_sum(s2) * (1.f / DM) + LN_EPS);
        if (FINAL) {
            float* o = a.out + (r < R_SAMPLE ? O_YP + (size_t)(r - R_PROMPT) * DM : O_YS + (size_t)(r - R_SAMPLE) * DM);
#pragma unroll
            for (int j = 0; j < 4; ++j) *((f32x4*)o + lane + 64 * j) = v[j] * rstd * gv[j] + bv[j];
        } else {
            v2u* o = (v2u*)(outB + (size_t)r * DM) + lane;
#pragma unroll
            for (int j = 0; j < 4; ++j) { const f32x4 y = v[j] * rstd * gv[j] + bv[j]; v2u w; w.x = pk2(y.x, y.y); w.y = pk2(y.z, y.w); o[64 * j] = w; }
        }
    }
}

__device__ __forceinline__ void post_rows(const Args& a, int gw, int NGW, int lane) {
    unsigned char* ws = a.ws;
    const float* P2 = (const float*)(ws + WS_P2RAW); bf16* CQB = (bf16*)(ws + WS_CQB); bf16* KVB = (bf16*)(ws + WS_KVB);
    const f32x2* R64 = (const f32x2*)(ws + WS_R64);
    const f32x4 gq = *(const f32x4*)(a.in[12] + 4 * lane);
    const float gk0 = a.in[14][lane], gk1 = a.in[14][64 + lane];
    for (int r0 = gw; r0 < MTOT; r0 += 4 * NGW) {
        f32x4 cq[4]; float c0[4], c1[4], k1[4], k2[4]; f32x2 cs[4];
#pragma unroll
        for (int u = 0; u < 4; ++u) { const int row = r0 + u * NGW; if (row < MTOT) { const float* p = P2 + (size_t)row * 512;
            cq[u] = *(const f32x4*)(p + 4 * lane); c0[u] = p[256 + lane]; c1[u] = p[320 + lane]; k1[u] = p[384 + (lane & 31)]; k2[u] = p[416 + (lane & 31)]; cs[u] = R64[(size_t)row_pos(row) * 32 + (lane & 31)]; } }
#pragma unroll
        for (int u = 0; u < 4; ++u) { const int row = r0 + u * NGW; if (row < MTOT) {
            const float ssq = wave_sum((cq[u].x * cq[u].x + cq[u].y * cq[u].y) + (cq[u].z * cq[u].z + cq[u].w * cq[u].w));
            const float ssk = wave_sum(c0[u] * c0[u] + c1[u] * c1[u]);
            const float rq = 1.0f / sqrtf(ssq * (1.f / 256) + RMS_EPS), rk = 1.0f / sqrtf(ssk * (1.f / 128) + RMS_EPS);
            v2u w; w.x = pk2(cq[u].x * rq * gq.x, cq[u].y * rq * gq.y); w.y = pk2(cq[u].z * rq * gq.z, cq[u].w * rq * gq.w);
            *((v2u*)(CQB + (size_t)row * 256) + lane) = w;
            const float v0 = c0[u] * rk * gk0, v1 = c1[u] * rk * gk1;
            const float kp = lane < 32 ? k1[u] * cs[u].x - k2[u] * cs[u].y : k1[u] * cs[u].y + k2[u] * cs[u].x;
            KVB[(size_t)row * KVW + lane] = (bf16)f2bf(v0); KVB[(size_t)row * KVW + 64 + lane] = (bf16)f2bf(v1); KVB[(size_t)row * KVW + 128 + lane] = (bf16)f2bf(kp);
            if (row < R_PROMPT) {
#pragma unroll
                for (int b = 0; b < NB; ++b) { float* oc = a.out + O_PCKV + ((size_t)b * LP + row) * 128; oc[lane] = v0; oc[64 + lane] = v1; a.out[O_PKPE + ((size_t)b * LP + row) * 64 + lane] = kp; }
            } else if (row < R_SAMPLE) {
                const int b = (row - R_PROMPT) >> 12, sq = (row - R_PROMPT) & (SEQ - 1);
                float* oc = a.out + O_PCKV + ((size_t)b * LP + NMETA + sq) * 128; oc[lane] = v0; oc[64 + lane] = v1; a.out[O_PKPE + ((size_t)b * LP + NMETA + sq) * 64 + lane] = kp;
            } else if (row < R_VALID) {
                float* oc = a.out + O_SCKV + (size_t)(row - R_SAMPLE) * 128; oc[lane] = v0; oc[64 + lane] = v1; a.out[O_SKPE + (size_t)(row - R_SAMPLE) * 64 + lane] = kp;
            } } }
    }
    bf16* KVC = (bf16*)(ws + WS_KVC);
#pragma unroll 4
    for (int r = gw; r < DBS * PAST; r += NGW) {
        const float v0 = a.in[2][(size_t)r * 128 + lane], v1 = a.in[2][(size_t)r * 128 + 64 + lane], kp = a.in[3][(size_t)r * 64 + lane];
        KVC[(size_t)r * KVW + lane] = (bf16)f2bf(v0); KVC[(size_t)r * KVW + 64 + lane] = (bf16)f2bf(v1); KVC[(size_t)r * KVW + 128 + lane] = (bf16)f2bf(kp);
    }
}

__device__ __forceinline__ int crow(int r, int hi) { return (r & 3) + 8 * (r >> 2) + 4 * hi; }
#define PK4(P, BASE, OUT) do { unsigned a0_ = pk2(P[BASE + 0], P[BASE + 1]), a1_ = pk2(P[BASE + 2], P[BASE + 3]);   \
    unsigned b0_ = pk2(P[BASE + 4], P[BASE + 5]), b1_ = pk2(P[BASE + 6], P[BASE + 7]);                              \
    auto r0_ = __builtin_amdgcn_permlane32_swap(a0_, b0_, false, false); auto r1_ = __builtin_amdgcn_permlane32_swap(a1_, b1_, false, false); \
    v4u w_ = {r0_[0], r1_[0], r0_[1], r1_[1]}; OUT = __builtin_bit_cast(bf16x8, w_); } while (0)
__device__ __forceinline__ float half_swap_max(float x) { auto rr = __builtin_amdgcn_permlane32_swap(__float_as_uint(x), __float_as_uint(x), false, false); return fmaxf(__uint_as_float(rr[0]), __uint_as_float(rr[1])); }
__device__ __forceinline__ float half_swap_sum(float x) { auto rr = __builtin_amdgcn_permlane32_swap(__float_as_uint(x), __float_as_uint(x), false, false); return __uint_as_float(rr[0]) + __uint_as_float(rr[1]); }


typedef short v4i16_t __attribute__((ext_vector_type(4)));
__device__ __forceinline__ unsigned offb(unsigned row, unsigned ch) { return 256u * row + 16u * (ch ^ (((row & 3) << 2) | ((row >> 2) & 3))); }
__device__ __forceinline__ unsigned offk(unsigned row, unsigned ch) { return 128u * row + 16u * (ch ^ ((row >> 1) & 7)); }
__device__ __forceinline__ bf16x8 rowfrag(LAS unsigned char* T, unsigned rb, unsigned lane, unsigned s) { return *(LAS bf16x8*)(T + offb(rb + (lane & 31), 2 * s + (lane >> 5))); }
__device__ __forceinline__ bf16x8 rowfrag64(LAS unsigned char* T, unsigned rb, unsigned lane, unsigned s) { return *(LAS bf16x8*)(T + offk(rb + (lane & 31), 2 * s + (lane >> 5))); }
__device__ __forceinline__ bf16x8 trfrag(LAS unsigned char* T, unsigned lane, unsigned c, unsigned ks) {
    const unsigned h = lane >> 5, blk = (lane >> 4) & 1, q = (lane & 15) >> 2, p = lane & 3, row = 16 * ks + 8 * h + q, ch = 4 * c + 2 * blk + (p >> 1);
    const v4i16_t lo = __builtin_amdgcn_ds_read_tr16_b64_v4i16((LAS v4i16_t*)(T + offb(row, ch) + 8 * (p & 1)));
    const v4i16_t hi = __builtin_amdgcn_ds_read_tr16_b64_v4i16((LAS v4i16_t*)(T + offb(row + 4, ch) + 8 * (p & 1)));
    return (bf16x8){lo[0], lo[1], lo[2], lo[3], hi[0], hi[1], hi[2], hi[3]};
}

constexpr int AT_TILE = 24576;
__device__ __forceinline__ const bf16* attn_tile_src(unsigned char* ws, int type, int bi, int t, int& nvalid) {
    const bf16* KVB = (const bf16*)(ws + WS_KVB); const bf16* KVC = (const bf16*)(ws + WS_KVC);
    if (t == 0) { nvalid = NMETA; return KVB; }
    if (type == 0) { nvalid = 64; return KVB + (size_t)(R_PROMPT + bi * SEQ + 64 * (t - 1)) * KVW; }
    if (t <= 16) { nvalid = 64; return KVC + ((size_t)bi * PAST + 64 * (t - 1)) * KVW; }
    nvalid = TS; return KVB + (size_t)(R_SAMPLE + TS * bi) * KVW;
}
__device__ __forceinline__ void attn_unit(const Args& a, LAS unsigned char* L, int type, int bi, int c, int qh, int tid) {
    asm volatile("" : "+v"(tid));
    unsigned char* ws = a.ws;
    const bf16* QA = (const bf16*)(ws + WS_QA); bf16* MIXA = (bf16*)(ws + WS_A16A);
    const int lane = tid & 63, wave = __builtin_amdgcn_readfirstlane(tid >> 6), g = wave >> 2, h = wave & 3, r32 = lane & 31, hi = lane >> 5;
    int qrow0, nq, nt;
    if (type == 0) { qrow0 = R_PROMPT + bi * SEQ + 64 * c + 32 * qh; nq = 32; nt = c + 2; }
    else if (type == 1) { qrow0 = R_SAMPLE + TS * bi; nq = 32; nt = 18; }
    else { qrow0 = 0; nq = 16; nt = 1; }
    const int nsteps = (nt + 1) >> 1;
    bf16x8 qr[12];
    { const bf16* qp = QA + (size_t)(qrow0 + r32) * NQA + h * KVW + hi * 8;
#pragma unroll
      for (int d0 = 0; d0 < 12; ++d0) qr[d0] = *(const bf16x8*)(qp + d0 * 16); }
    f32x16 o[4];
#pragma unroll
    for (int d = 0; d < 4; ++d)
#pragma unroll
        for (int r = 0; r < 16; ++r) o[d][r] = 0.f;
    float m_reg = -1e30f, l_reg = 0.f;
    unsigned rb_[8], kb_[4], tb_[8];
    { const unsigned X = ((r32 & 3) << 2) | ((r32 >> 2) & 3);
#pragma unroll
      for (int s = 0; s < 8; ++s) rb_[s] = 256u * r32 + 32u * (s ^ (X >> 1)) + 16u * (hi ^ (X & 1));
#pragma unroll
      for (int s = 0; s < 4; ++s) kb_[s] = 16384u + offk(r32, 2 * s + hi);
      const unsigned blk = (lane >> 4) & 1, q = (lane & 15) >> 2, p = lane & 3;
#pragma unroll
      for (int cb = 0; cb < 4; ++cb)
#pragma unroll
          for (int t = 0; t < 2; ++t) tb_[2 * cb + t] = 256u * (8 * hi + 4 * t + q) + 64u * (cb ^ q) + 16u * ((2 * blk + (p >> 1)) ^ ((2 * hi + t) & 3)) + 8u * (p & 1); }
#define AT_STAGE(step) do { int ln_ = lane; asm volatile("" : "+v"(ln_)); _Pragma("unroll") for (int i_ = 0; i_ < 6; ++i_) { const int pid_ = wave * 6 + i_, tt_ = pid_ >= 24 ? 1 : 0, pp_ = pid_ - 24 * tt_, t_ = 2 * (step) + tt_; \
        if (t_ < nt) { int nv_; const bf16* src_ = attn_tile_src(ws, type, bi, t_, nv_); LAS unsigned char* T_ = L + (((step) % 3) * 2 + tt_) * AT_TILE + (pp_ < 16 ? pp_ * 1024 : 16384 + (pp_ - 16) * 1024); unsigned so_; \
            if (pp_ < 16) { const unsigned row_ = 4 * pp_ + (ln_ >> 4), slot_ = ln_ & 15; so_ = row_ * KVW + 8 * (slot_ ^ (((row_ & 3) << 2) | ((row_ >> 2) & 3))); } \
            else { const unsigned row_ = 8 * (pp_ - 16) + (ln_ >> 3), slot_ = ln_ & 7; so_ = row_ * KVW + 128 + 8 * (slot_ ^ ((row_ >> 1) & 7)); } \
            __builtin_amdgcn_global_load_lds((const unsigned*)(src_ + so_), (LAS unsigned*)T_, 16, 0, 0); } } } while (0)
    AT_STAGE(0);
    __syncthreads();
    bf16x8 pa0, pa1, pa2, pa3; int pend = -1;
#define AT_TR(T_, cb, ks) ({ const v4i16_t lo_ = __builtin_amdgcn_ds_read_tr16_b64_v4i16((LAS v4i16_t*)((T_) + tb_[2 * (cb)] + 4096 * (ks))), hi_ = __builtin_amdgcn_ds_read_tr16_b64_v4i16((LAS v4i16_t*)((T_) + tb_[2 * (cb) + 1] + 4096 * (ks))); \
                (bf16x8){lo_[0], lo_[1], lo_[2], lo_[3], hi_[0], hi_[1], hi_[2], hi_[3]}; })
#define AT_PV(T_) do { _Pragma("unroll") for (int d0 = 0; d0 < 4; ++d0) { const bf16x8 va_ = AT_TR(T_, d0, 0), vb_ = AT_TR(T_, d0, 1), vc_ = AT_TR(T_, d0, 2), vd_ = AT_TR(T_, d0, 3); \
            o[d0] = __builtin_amdgcn_mfma_f32_32x32x16_bf16(pa0, va_, o[d0], 0, 0, 0); o[d0] = __builtin_amdgcn_mfma_f32_32x32x16_bf16(pa1, vb_, o[d0], 0, 0, 0); \
            o[d0] = __builtin_amdgcn_mfma_f32_32x32x16_bf16(pa2, vc_, o[d0], 0, 0, 0); o[d0] = __builtin_amdgcn_mfma_f32_32x32x16_bf16(pa3, vd_, o[d0], 0, 0, 0); } } while (0)
    for (int s = 0; s < nsteps; ++s) {
        if (s + 1 < nsteps) AT_STAGE(s + 1);
        const int t = 2 * s + g; const bool act = t < nt;
        f32x16 p0, p1;
        if (act) {
            LAS unsigned char* T = L + ((s % 3) * 2 + g) * AT_TILE;
#pragma unroll
            for (int r = 0; r < 16; ++r) { p0[r] = 0.f; p1[r] = 0.f; }
            bf16x8 k0 = *(LAS bf16x8*)(T + rb_[0]), k1 = *(LAS bf16x8*)(T + rb_[0] + 8192);
#pragma unroll
            for (int d0 = 0; d0 < 12; ++d0) {
                bf16x8 n0 = k0, n1 = k1;
                if (d0 < 7) { n0 = *(LAS bf16x8*)(T + rb_[d0 + 1]); n1 = *(LAS bf16x8*)(T + rb_[d0 + 1] + 8192); }
                else if (d0 < 11) { n0 = *(LAS bf16x8*)(T + kb_[d0 - 7]); n1 = *(LAS bf16x8*)(T + kb_[d0 - 7] + 4096); }
                p0 = __builtin_amdgcn_mfma_f32_32x32x16_bf16(k0, qr[d0], p0, 0, 0, 0);
                p1 = __builtin_amdgcn_mfma_f32_32x32x16_bf16(k1, qr[d0], p1, 0, 0, 0);
                k0 = n0; k1 = n1;
            }
        }
        if (pend >= 0) { LAS unsigned char* Tp = L + (pend * 2 + g) * AT_TILE; AT_PV(Tp); }
        if (g == 1) __syncthreads();
        if (act) {
            int nvalid; (void)attn_tile_src(ws, type, bi, t, nvalid);
            if (nvalid < 64) {
#pragma unroll
                for (int r = 0; r < 16; ++r) { const int key = crow(r, hi); if (key >= nvalid) p0[r] = -1e30f; if (key + 32 >= nvalid) p1[r] = -1e30f; }
            }
            float pmax = p0[0];
#pragma unroll
            for (int r = 1; r < 16; ++r) pmax = fmaxf(pmax, p0[r]);
#pragma unroll
            for (int r = 0; r < 16; ++r) pmax = fmaxf(pmax, p1[r]);
            pmax = half_swap_max(pmax);
            float alpha = 1.f;
            if (!__all(pmax - m_reg <= 8.0f)) { const float mn = fmaxf(m_reg, pmax); alpha = __builtin_amdgcn_exp2f((m_reg - mn) * LOG2E); m_reg = mn; }
            const float mnC = -m_reg * LOG2E; float ps = 0.f;
#pragma unroll
            for (int r = 0; r < 16; ++r) { p0[r] = __builtin_amdgcn_exp2f(fmaf(p0[r], LOG2E, mnC)); p1[r] = __builtin_amdgcn_exp2f(fmaf(p1[r], LOG2E, mnC)); ps += p0[r] + p1[r]; }
            ps = half_swap_sum(ps);
            l_reg = l_reg * alpha + ps;
            if (__any(alpha < 1.f)) {
#pragma unroll
                for (int r = 0; r < 16; ++r) { const float ar = __shfl(alpha, crow(r, hi));
#pragma unroll
                    for (int d = 0; d < 4; ++d) o[d][r] *= ar; }
            }
            PK4(p0, 0, pa0); PK4(p0, 8, pa1); PK4(p1, 0, pa2); PK4(p1, 8, pa3);
            pend = s % 3;
        } else pend = -1;
        if (g == 0) __syncthreads();
    }
    if (pend >= 0) { LAS unsigned char* Tp = L + (pend * 2 + g) * AT_TILE; AT_PV(Tp); }
    __syncthreads();
#undef AT_PV
#undef AT_TR
#undef AT_STAGE
    LAS float* M = (LAS float*)(L + h * 17408);
    if (g == 1) {
#pragma unroll
        for (int d = 0; d < 4; ++d)
#pragma unroll
            for (int r = 0; r < 16; ++r) M[(d * 16 + r) * 64 + lane] = o[d][r];
        M[4096 + lane] = m_reg; M[4160 + lane] = l_reg;
    }
    __syncthreads();
    if (g == 0) {
        const float m1 = M[4096 + lane], l1 = M[4160 + lane];
        const float mm = fmaxf(m_reg, m1), f0 = __builtin_amdgcn_exp2f((m_reg - mm) * LOG2E), f1 = __builtin_amdgcn_exp2f((m1 - mm) * LOG2E);
        const float rl = __builtin_amdgcn_rcpf(l_reg * f0 + l1 * f1), s0 = f0 * rl, s1 = f1 * rl;
#pragma unroll
        for (int r = 0; r < 16; ++r) { const int qi = crow(r, hi); const float a0 = __shfl(s0, qi), a1 = __shfl(s1, qi);
            bf16* op = MIXA + (size_t)(qrow0 + qi) * DM + 512 + h * 128 + r32;
#pragma unroll
            for (int d0 = 0; d0 < 4; ++d0) { const float v = o[d0][r] * a0 + M[(d0 * 16 + r) * 64 + lane] * a1; if (qi < nq) op[32 * d0] = (bf16)f2bf(v); } }
    }
    __syncthreads();
}

struct RetItem { int kind, bh, n; };
__device__ __forceinline__ void ret_geom(const RetItem& it, int& h, int& rowbase, int& tlo, int& thi, int& T) {
    if (it.kind == 0) { h = it.bh; rowbase = -48; tlo = 48; thi = 64; T = 64; }
    else if (it.kind == 1) { h = it.bh & 3; rowbase = R_PROMPT + (it.bh >> 2) * SEQ + 64 * (it.n - 1); tlo = 0; thi = 64; T = 64; }
    else { h = it.bh & 3; rowbase = R_SAMPLE + TS * (it.bh >> 2); tlo = 0; thi = TS; T = TS; }
}
__device__ __forceinline__ int kvn_index(const RetItem& it) { return it.kind == 0 ? it.bh : 4 + it.bh * 64 + (it.n - 1); }
__device__ __forceinline__ RetItem ret_item(int i) {
    if (i < 4) return RetItem{0, i, 0};
    if (i < 1028) { const int j = i - 4; return RetItem{1, j >> 6, (j & 63) + 1}; }
    return RetItem{2, i - 1028, 0};
}
constexpr int NRET = 4 + NB * 4 * 64 + DBS * 4;
template <bool DEC> __device__ __forceinline__ void ret_stage(LAS unsigned char* T_, const bf16* X, int rowbase, int h, int tlo, int thi, float lg2, int T, int tid) {
    const int ch = tid & 15;
#pragma unroll
    for (int i = 0; i < 2; ++i) {
        const int t = (tid >> 4) + 32 * i; v4u v = {0u, 0u, 0u, 0u};
        if (t >= tlo && t < thi) {
            v = *(const v4u*)(X + (size_t)(rowbase + t) * 512 + h * 128 + ch * 8);
            if (DEC) { const float d = __builtin_amdgcn_exp2f(lg2 * (float)(T - 1 - t));
                v.x = pk2(bflo(v.x) * d, bfhi(v.x) * d); v.y = pk2(bflo(v.y) * d, bfhi(v.y) * d); v.z = pk2(bflo(v.z) * d, bfhi(v.z) * d); v.w = pk2(bflo(v.w) * d, bfhi(v.w) * d); }
        }
        *(LAS v4u*)(T_ + offb(t, ch)) = v;
    }
}
__device__ __forceinline__ void ret_kv_item(const Args& a, LAS unsigned char* L, const RetItem& it, int tid) {
    asm volatile("" : "+v"(tid));
    unsigned char* ws = a.ws;
    const bf16* KR = (const bf16*)(ws + WS_KR); const bf16* VR = (const bf16*)(ws + WS_VR); bf16* KVN = (bf16*)(ws + WS_KVN);
    int h, rowbase, tlo, thi, T; ret_geom(it, h, rowbase, tlo, thi, T);
    const float lg2 = lg2gamma(h); const int lane = tid & 63, w = __builtin_amdgcn_readfirstlane(tid >> 6), r32 = lane & 31, hi = lane >> 5, ib = w >> 1, jb0 = 2 * (w & 1);
    LAS unsigned char* TK = L; LAS unsigned char* TV = L + 16384;
    ret_stage<false>(TK, KR, rowbase, h, tlo, thi, lg2, T, tid);
    ret_stage<true>(TV, VR, rowbase, h, tlo, thi, lg2, T, tid);
    __syncthreads();
    f32x16 c0, c1;
#pragma unroll
    for (int r = 0; r < 16; ++r) { c0[r] = 0.f; c1[r] = 0.f; }
#pragma unroll
    for (int ks = 0; ks < 4; ++ks) {
        const bf16x8 af = trfrag(TK, lane, ib, ks), b0 = trfrag(TV, lane, jb0, ks), b1 = trfrag(TV, lane, jb0 + 1, ks);
        c0 = __builtin_amdgcn_mfma_f32_32x32x16_bf16(af, b0, c0, 0, 0, 0);
        c1 = __builtin_amdgcn_mfma_f32_32x32x16_bf16(af, b1, c1, 0, 0, 0);
    }
    if (it.kind != 2) {
        bf16* dst = KVN + (size_t)kvn_index(it) * 16384;
#pragma unroll
        for (int rg = 0; rg < 4; ++rg) { const int dk0 = 32 * ib + 8 * rg + 4 * hi;
            v2u w0; w0.x = pk2(c0[4 * rg], c0[4 * rg + 1]); w0.y = pk2(c0[4 * rg + 2], c0[4 * rg + 3]);
            v2u w1; w1.x = pk2(c1[4 * rg], c1[4 * rg + 1]); w1.y = pk2(c1[4 * rg + 2], c1[4 * rg + 3]);
            *(v2u*)(dst + (size_t)(32 * jb0 + r32) * 128 + dk0) = w0; *(v2u*)(dst + (size_t)(32 * (jb0 + 1) + r32) * 128 + dk0) = w1; }
    } else {
        const float dec = __builtin_amdgcn_exp2f(lg2 * (float)T);
        const float* s0 = a.in[4] + (size_t)it.bh * 16384; float* so = a.out + O_SST + (size_t)it.bh * 16384;
#pragma unroll
        for (int r = 0; r < 16; ++r) { const size_t e = (size_t)(32 * ib + crow(r, hi)) * 128 + 32 * jb0 + r32;
            so[e] = dec * s0[e] + c0[r]; so[e + 32] = dec * s0[e + 32] + c1[r]; }
    }
    __syncthreads();
}
__device__ __forceinline__ void ret_out_item(const Args& a, LAS unsigned char* L, const RetItem& it, int tid) {
    asm volatile("" : "+v"(tid));
    unsigned char* ws = a.ws;
    const bf16* QR = (const bf16*)(ws + WS_QR); const bf16* KR = (const bf16*)(ws + WS_KR); const bf16* VR = (const bf16*)(ws + WS_VR); const bf16* GS = (const bf16*)(ws + WS_GS);
    const bf16* KVN = (const bf16*)(ws + WS_KVN); bf16* MIXA = (bf16*)(ws + WS_A16A);
    int h, rowbase, tlo, thi, T; ret_geom(it, h, rowbase, tlo, thi, T);
    const float lg2 = lg2gamma(h); const int lane = tid & 63, w = __builtin_amdgcn_readfirstlane(tid >> 6), r32 = lane & 31, hi = lane >> 5, qhalf = w & 1, cb = w >> 1;
    LAS unsigned char* TQ = L; LAS unsigned char* TK = L + 16384; LAS unsigned char* TV = L + 32768; LAS unsigned char* TS_ = L + 49152;
    LAS float* ST = (LAS float*)(L + 81920);
    ret_stage<false>(TQ, QR, rowbase, h, tlo, thi, lg2, T, tid);
    ret_stage<false>(TK, KR, rowbase, h, tlo, thi, lg2, T, tid);
    ret_stage<false>(TV, VR, rowbase, h, tlo, thi, lg2, T, tid);
    if (it.kind == 1) {
        const bf16* st = KVN + (size_t)kvn_index(it) * 16384;
#pragma unroll
        for (int i = 0; i < 4; ++i) { const int dv = (tid >> 4) + 32 * i, ch = tid & 15; *(LAS v4u*)(TS_ + offb(dv, ch)) = *(const v4u*)(st + (size_t)dv * 128 + ch * 8); }
    } else if (it.kind == 2) {
        const float* s0 = a.in[4] + (size_t)it.bh * 16384;
        for (int e = tid; e < 16384; e += 512) { const int dk = e >> 7, dv = e & 127; *(LAS unsigned short*)(TS_ + offb(dv, dk >> 3) + 2 * (dk & 7)) = (unsigned short)f2bf(s0[e]); }
    }
    __syncthreads();
    f32x16 o;
#pragma unroll
    for (int r = 0; r < 16; ++r) o[r] = 0.f;
    bf16x8 qr[8];
#pragma unroll
    for (int d0 = 0; d0 < 8; ++d0) qr[d0] = rowfrag(TQ, 32 * qhalf, lane, d0);
    if (it.kind != 0) {
#pragma unroll
        for (int kd = 0; kd < 8; ++kd) o = __builtin_amdgcn_mfma_f32_32x32x16_bf16(qr[kd], rowfrag(TS_, 32 * cb, lane, kd), o, 0, 0, 0);
#pragma unroll
        for (int r = 0; r < 16; ++r) o[r] *= __builtin_amdgcn_exp2f(lg2 * (float)(32 * qhalf + crow(r, hi) + 1));
    }
    f32x16 p0, p1;
#pragma unroll
    for (int r = 0; r < 16; ++r) { p0[r] = 0.f; p1[r] = 0.f; }
#pragma unroll
    for (int d0 = 0; d0 < 8; ++d0) {
        p0 = __builtin_amdgcn_mfma_f32_32x32x16_bf16(rowfrag(TK, 0, lane, d0), qr[d0], p0, 0, 0, 0);
        p1 = __builtin_amdgcn_mfma_f32_32x32x16_bf16(rowfrag(TK, 32, lane, d0), qr[d0], p1, 0, 0, 0);
    }
    const int tq = 32 * qhalf + r32;
#pragma unroll
    for (int r = 0; r < 16; ++r) { const int k0 = crow(r, hi), k1 = k0 + 32;
        p0[r] = tq >= k0 ? p0[r] * __builtin_amdgcn_exp2f(lg2 * (float)(tq - k0)) : 0.f;
        p1[r] = tq >= k1 ? p1[r] * __builtin_amdgcn_exp2f(lg2 * (float)(tq - k1)) : 0.f; }
    bf16x8 pa0, pa1, pa2, pa3;
    PK4(p0, 0, pa0); PK4(p0, 8, pa1); PK4(p1, 0, pa2); PK4(p1, 8, pa3);
    o = __builtin_amdgcn_mfma_f32_32x32x16_bf16(pa0, trfrag(TV, lane, cb, 0), o, 0, 0, 0);
    o = __builtin_amdgcn_mfma_f32_32x32x16_bf16(pa1, trfrag(TV, lane, cb, 1), o, 0, 0, 0);
    o = __builtin_amdgcn_mfma_f32_32x32x16_bf16(pa2, trfrag(TV, lane, cb, 2), o, 0, 0, 0);
    o = __builtin_amdgcn_mfma_f32_32x32x16_bf16(pa3, trfrag(TV, lane, cb, 3), o, 0, 0, 0);
#pragma unroll
    for (int r = 0; r < 16; ++r) {
        float s = o[r], q = o[r] * o[r];
#pragma unroll
        for (int off = 1; off < 32; off <<= 1) { s += __shfl_xor(s, off); q += __shfl_xor(q, off); }
        if (r32 == 0) { const int row = 32 * qhalf + crow(r, hi); ST[(row * 4 + cb) * 2] = s; ST[(row * 4 + cb) * 2 + 1] = q; }
    }
    __syncthreads();
    const float gain = a.in[11][h * 128 + 32 * cb + r32];
#pragma unroll
    for (int r = 0; r < 16; ++r) {
        const int t = 32 * qhalf + crow(r, hi);
        const LAS f32x4* sp = (const LAS f32x4*)(ST + t * 8);
        const f32x4 u0 = sp[0], u1 = sp[1];
        const float mean = ((u0.x + u0.z) + (u1.x + u1.z)) * (1.f / 128), var = fmaxf(((u0.y + u0.w) + (u1.y + u1.w)) * (1.f / 128) - mean * mean, 0.f);
        const float rstd = 1.0f / sqrtf(var + LN_EPS);
        if (t >= tlo && t < thi) { const size_t rb = (size_t)(rowbase + t); const int col = h * 128 + 32 * cb + r32;
            MIXA[rb * DM + col] = (bf16)f2bf((o[r] - mean) * rstd * gain * bf2f(GS[rb * 512 + col])); }
    }
    __syncthreads();
}


__device__ __forceinline__ void ret_scan(const Args& a, int gtid, int gthreads) {
    unsigned* KVN = (unsigned*)(a.ws + WS_KVN);
    for (int g = gtid; g < NB * 4 * 8192; g += gthreads) {
        const int bh = g >> 13, e2 = g & 8191, h = bh & 3;
        const float dec = __builtin_amdgcn_exp2f(lg2gamma(h) * 64.f);
        const unsigned w0 = KVN[(size_t)h * 8192 + e2];
        float s0 = bflo(w0), s1 = bfhi(w0);
        unsigned* p = KVN + (size_t)(4 + bh * 64) * 8192 + e2;
#pragma unroll 16
        for (int n = 0; n < 64; ++n) { const unsigned kv = p[(size_t)n * 8192]; p[(size_t)n * 8192] = pk2(s0, s1); s0 = dec * s0 + bflo(kv); s1 = dec * s1 + bfhi(kv); }
        const int dv = e2 >> 6, dk = (e2 & 63) * 2;
        float* so = a.out + O_PST + (size_t)bh * 16384;
        so[(size_t)dk * 128 + dv] = s0; so[(size_t)(dk + 1) * 128 + dv] = s1;
    }
}


#ifndef PROBE_DUP
#define PROBE_DUP -1
#endif
#define REPS(k) for (int rep_ = 0; rep_ < ((PROBE_DUP == (k)) ? 2 : 1); ++rep_)
constexpr int NWAVES = 8, RING_BYTES = 147456  , LDS_BYTES = RING_BYTES + 1024, MISC_OFF = RING_BYTES + 320;

__global__ void __launch_bounds__(NWAVES * 64, 2) fwd_mega(Args a) {
    extern __shared__ __attribute__((aligned(16))) unsigned char lds[];
    LAS unsigned char* L = (LAS unsigned char*)lds;
    volatile LAS unsigned* MISC = (volatile LAS unsigned*)(L + MISC_OFF);
    int tid = threadIdx.x, lane = tid & 63, wave = __builtin_amdgcn_readfirstlane(tid >> 6);
    const int G = gridDim.x, bx = blockIdx.x;
    const int vcu = (G % 8 == 0) ? (bx % 8) * (G / 8) + bx / 8 : bx;
    int gw = vcu * NWAVES + wave, gtid = vcu * (NWAVES * 64) + tid; const int NGW = G * NWAVES, gthreads = G * NWAVES * 64;
#define PHASE_BEGIN() do { tid = threadIdx.x; asm volatile("" : "+v"(tid)); lane = tid & 63; wave = __builtin_amdgcn_readfirstlane(tid >> 6); gw = vcu * NWAVES + wave; gtid = vcu * (NWAVES * 64) + tid; } while (0)
    unsigned char* ws = a.ws;
    for (int u = tid; u < (LDS_BYTES - RING_BYTES) / 4; u += NWAVES * 64) ((LAS unsigned*)(L + RING_BYTES))[u] = 0u;
    __syncthreads();
    XcdBarrier bar = xcd_barrier_post((unsigned*)(ws + WS_CTL) + CW_BAR, MISC + 8);
#define GRID_BAR() do { xcd_barrier(bar); PHASE_BEGIN(); } while (0)
#define SCR ((LAS float*)(L + wave * 16384))

    bf16* WFI = (bf16*)(ws + WS_WFI); bf16* WFO = (bf16*)(ws + WS_WFO); bf16* WMI = (bf16*)(ws + WS_WMI); bf16* WMO = (bf16*)(ws + WS_WMO); bf16* WUQ = (bf16*)(ws + WS_WUQ);
    f32x2* R128 = (f32x2*)(ws + WS_R128); f32x2* R64 = (f32x2*)(ws + WS_R64);
    bf16* A16A = (bf16*)(ws + WS_A16A); bf16* A16B = (bf16*)(ws + WS_A16B); float* Z = (float*)(ws + WS_Z); bf16* HID = (bf16*)(ws + WS_HID);

    REPS(0) {
        REPS(100) {
        transpose_matrix(a.in[6], DM, 2 * FF, WFI, 2 * FF, DM, 0, 0, SCR, gw, NGW, lane);
        transpose_matrix(a.in[7], FF, DM, WFO, DM, FF, 0, 1, SCR, gw, NGW, lane);
        transpose_matrix(a.in[10], DM, DIN, WMI, DINP, DM, 0, 2, SCR, gw, NGW, lane);
        transpose_matrix(a.in[16], 512, DM, WMO, DM, DM, 0, 1, SCR, gw, NGW, lane);
        transpose_matrix(a.in[13], 256, NQA, WUQ, 256, 256, 512, 3, SCR, gw, NGW, lane);
        }
        REPS(101) {
        const float* wuq = a.in[13]; const float* wukv = a.in[15]; const float* wmo = a.in[16];
        for (int idx = gtid; idx < 512 * 256; idx += gthreads) {
            const int k = idx & 255, np = idx >> 8, head = np >> 7, c = np & 127;
            const f32x4* x = (const f32x4*)(wuq + (size_t)k * NQA + head * KVW); const f32x4* y = (const f32x4*)(wukv + (size_t)c * 1024 + head * 256);
            float s = 0.f;
#pragma unroll 8
            for (int n = 0; n < 32; ++n) { const f32x4 xv = x[n], yv = y[n]; s += (xv.x * yv.x + xv.y * yv.y) + (xv.z * yv.z + xv.w * yv.w); }
            WUQ[(size_t)np * 256 + k] = (bf16)f2bf(s);
        }
        for (int idx = gtid; idx < 1024 * 64; idx += gthreads) {
            const int n = idx & 1023, hc = idx >> 10, head = hc >> 4, c8 = hc & 15;
            float s[8];
#pragma unroll
            for (int j = 0; j < 8; ++j) s[j] = 0.f;
            const float* wm = wmo + (size_t)(512 + head * 128) * DM + n; const float* uk = wukv + (size_t)(c8 * 8) * 1024 + head * 256 + 128;
#pragma unroll 2
            for (int v = 0; v < 128; v += 4) {
                float m[4];
#pragma unroll
                for (int q = 0; q < 4; ++q) m[q] = wm[(size_t)(v + q) * DM];
#pragma unroll
                for (int j = 0; j < 8; ++j) { const f32x4 u = *(const f32x4*)(uk + (size_t)j * 1024 + v); s[j] += (u.x * m[0] + u.y * m[1]) + (u.z * m[2] + u.w * m[3]); } }
            v4u w; w.x = pk2(s[0], s[1]); w.y = pk2(s[2], s[3]); w.z = pk2(s[4], s[5]); w.w = pk2(s[6], s[7]);
            *(v4u*)(WMO + (size_t)n * DM + 512 + head * 128 + c8 * 8) = w;
        }
        }
        REPS(102) {
        for (int idx = gtid; idx < LP * 64; idx += gthreads) {
            const int pos = idx >> 6, i = idx & 63;
            const float inv = (float)exp2(-(double)(2 * i) * (13.287712379549449 / 128.0));
            float sn, cs; sincos_acc((float)pos * inv, sn, cs);
            R128[idx] = (f32x2){cs, sn};
            if ((i & 1) == 0) R64[(size_t)pos * 32 + (i >> 1)] = (f32x2){cs, sn};
        }
        }
        REPS(103) {
        for (int r = gw; r < MTOT; r += NGW) {
            const float* xr = x_row(a, r); v2u* o = (v2u*)(A16A + (size_t)r * DM) + lane;
#pragma unroll
            for (int j = 0; j < 4; ++j) { v2u w = {0u, 0u}; if (xr) { const f32x4 v = *((const f32x4*)xr + lane + 64 * j); w.x = pk2(v.x, v.y); w.y = pk2(v.z, v.w); } o[64 * j] = w; }
        }
        }
    }
    GRID_BAR();
#ifndef NO_P1
    REPS(1) { pg8::Gemm g{A16A, WFI, MTOT, 2 * FF, DM}; pg8::StaticOrder S; S.init(MTOT, 2 * FF, G, bx, DM); EpiSwiglu E{HID};
      pg8::gemm_phase<EpiSwiglu, pg8::StaticOrder, true, true>(L, g, S, E); }
#endif
    GRID_BAR();
#ifndef NO_P2
    REPS(2) { pg8::Gemm g{HID, WFO, MTOT, DM, FF}; pg8::SplitOrder S; S.init(MAIN_ROWS, MTOT, DM, G, bx, FF, 11); EpiResZ<0> E{Z, nullptr, a, 0.5f};
      pg8::gemm_phase<EpiResZ<0>, pg8::SplitOrder, true, true>(L, g, S, E, (float*)A16A); }
#endif
    GRID_BAR();
    REPS(3) ln_rows<false, 0, 11>(a, Z, a.in[8], a.in[9], A16B, (const float*)A16A, nullptr, 0.5f, gw, NGW, lane);
    GRID_BAR();
#ifndef NO_P4
    REPS(4) { pg8::Gemm g{A16B, WMI, MTOT, DINP, DM}; pg8::StaticOrder S; S.init(MTOT, DINP, G, bx, DM);
      EpiMixIn E{(bf16*)(ws + WS_QR), (bf16*)(ws + WS_KR), (bf16*)(ws + WS_VR), (bf16*)(ws + WS_GS), (float*)(ws + WS_P2RAW), R128};
      pg8::gemm_phase<EpiMixIn, pg8::StaticOrder, true, true>(L, g, S, E); }
#endif
    GRID_BAR();
    REPS(5) { post_rows(a, gw, NGW, lane);
    transpose_matrix(a.in[19], DM, 2 * FF, WFI, 2 * FF, DM, 0, 0, SCR, gw, NGW, lane);
    transpose_matrix(a.in[20], FF, DM, WFO, DM, FF, 0, 1, SCR, gw, NGW, lane); }
    GRID_BAR();
#ifndef NO_P6
    REPS(6) { int kq = 256; asm volatile("" : "+s"(kq));
      pg8::Gemm g{(const bf16*)(ws + WS_CQB), WUQ, MTOT, NQA, kq}; pg8::StaticOrder S; S.init(MTOT, NQA, G, bx, kq); EpiUq E{(bf16*)(ws + WS_QA), R64};
      pg8::gemm_phase<EpiUq, pg8::StaticOrder, true, true>(L, g, S, E); }
#endif
    GRID_BAR();
    {
        REPS(70) for (int i = vcu; i < NRET; i += G) ret_kv_item(a, L, ret_item(i), tid);
        {
            unsigned* qctr = (unsigned*)(ws + WS_CTL) + CW_ATTQ;
            for (;;) {
                if (tid == 0) MISC[16] = __hip_atomic_fetch_add(qctr, 1u, __ATOMIC_RELAXED, __HIP_MEMORY_SCOPE_AGENT);
                __syncthreads();
                const int idx = (int)MISC[16];
                if (idx >= 529) break;
                int type, bi, cc, qh;
                if (idx < 392) { type = 0; cc = 63 - (idx >> 3); bi = idx & 3; qh = (idx >> 2) & 1; }
                else if (idx < 408) { type = 1; bi = idx - 392; cc = 0; qh = 0; }
                else if (idx < 528) { const int j = idx - 408; type = 0; cc = 14 - (j >> 3); bi = j & 3; qh = (j >> 2) & 1; }
                else { type = 2; bi = 0; cc = 0; qh = 0; }
                attn_unit(a, L, type, bi, cc, qh, tid);
            }
        }
    }
    GRID_BAR();
    ret_scan(a, gtid, gthreads);
    GRID_BAR();
    REPS(9) for (int i = vcu; i < NRET; i += G) ret_out_item(a, L, ret_item(i), tid);
    GRID_BAR();
#ifndef NO_P10
    REPS(10) { pg8::Gemm g{A16A, WMO, MTOT, DM, DM}; pg8::SplitOrder S; S.init(MAIN_ROWS, MTOT, DM, G, bx, DM, 4); EpiResZ<1> E{Z, A16B, a, 1.0f};
      pg8::gemm_phase<EpiResZ<1>, pg8::SplitOrder, true, true>(L, g, S, E, (float*)HID); }
#endif
    GRID_BAR();
    ln_rows<false, 1, 4>(a, Z, a.in[17], a.in[18], A16B, (const float*)HID, A16B, 1.0f, gw, NGW, lane);
    GRID_BAR();
#ifndef NO_P12
    REPS(12) { pg8::Gemm g{A16B, WFI, MTOT, 2 * FF, DM}; pg8::StaticOrder S; S.init(MTOT, 2 * FF, G, bx, DM); EpiSwiglu E{HID};
      pg8::gemm_phase<EpiSwiglu, pg8::StaticOrder, true, true>(L, g, S, E); }
#endif
    GRID_BAR();
#ifndef NO_P13
    REPS(13) { pg8::Gemm g{HID, WFO, MTOT, DM, FF}; pg8::SplitOrder S; S.init(MAIN_ROWS, MTOT, DM, G, bx, FF, 11); EpiResZ<1> E{Z, A16B, a, 0.5f};
      pg8::gemm_phase<EpiResZ<1>, pg8::SplitOrder, true, true>(L, g, S, E, (float*)A16A); }
#endif
    GRID_BAR();
    ln_rows<true, 1, 11>(a, Z, a.in[21], a.in[22], nullptr, (const float*)A16A, A16B, 0.5f, gw, NGW, lane);
#undef GRID_BAR
}

extern "C" void kernel_launch(void* const* d_in, const int* in_sizes, int n_in, void* d_out, int out_size, void* d_ws, size_t ws_size, hipStream_t stream) {
    static int grid = 0;
    if (grid == 0) {
        if (n_in != 23 || out_size != (int)O_END || ws_size < WS_END) { fprintf(stderr, "kernel_launch: unexpected shapes (n_in %d, out %d, ws %zu; need 23, %zu, >= %zu)\n", n_in, out_size, ws_size, (size_t)O_END, (size_t)WS_END); grid = -1; return; }
        int dev = 0, cus = 0, per_cu = 0;
        if (hipGetDevice(&dev) != hipSuccess || hipDeviceGetAttribute(&cus, hipDeviceAttributeMultiprocessorCount, dev) != hipSuccess) { grid = -1; return; }
        if (hipFuncSetAttribute((const void*)fwd_mega, hipFuncAttributeMaxDynamicSharedMemorySize, LDS_BYTES) != hipSuccess) { fprintf(stderr, "kernel_launch: hipFuncSetAttribute failed\n"); grid = -1; return; }
        if (hipOccupancyMaxActiveBlocksPerMultiprocessor(&per_cu, (const void*)fwd_mega, NWAVES * 64, LDS_BYTES) != hipSuccess || per_cu < 1) { fprintf(stderr, "kernel_launch: occupancy query says %d blocks per CU\n", per_cu); per_cu = 1; }
        (void)hipGetLastError();
        grid = cus;
    }
    if (grid < 0) return;
    (void)hipMemsetAsync((char*)d_ws + WS_CTL, 0, CTL_BYTES, stream);
    Args a{};
    for (int i = 0; i < 23; ++i) a.in[i] = (const float*)d_in[i];
    a.out = (float*)d_out; a.ws = (unsigned char*)d_ws;
    void* args[] = {&a};
    hipError_t e = hipLaunchCooperativeKernel((const void*)fwd_mega, dim3(grid), dim3(NWAVES * 64), args, LDS_BYTES, stream);
    if (e != hipSuccess) fprintf(stderr, "kernel_launch: cooperative launch failed: %s (grid %d)\n", hipGetErrorString(e), grid);
}
```

```cpp
#include <hip/hip_runtime.h>
#include <hip/hip_cooperative_groups.h>
#include <cstdio>
#include <cstdint>

namespace pg8 {
#define PG8_LAS __attribute__((address_space(3)))
typedef unsigned short bf16_t;
typedef short bf16x8 __attribute__((ext_vector_type(8)));
typedef float f32x4 __attribute__((ext_vector_type(4)));
typedef unsigned u32x4 __attribute__((ext_vector_type(4)));
constexpr int BM = 256, BK = 64, HALF = 128, HTB = HALF * BK * 2  , STAGE_BYTES = 8 * HTB, NXCD = 8, WGM = 8;

__host__ __device__ __forceinline__ int lds_byte(int r, int c) { const int st = (r >> 4) * 2 + (c >> 5), rr = r & 15, cc = c & 31, ob = rr * 64 + cc * 2; return st * 1024 + (ob ^ (((ob >> 9) & 1) << 5)); }
__host__ __device__ __forceinline__ void stage_rc(int b, int& R, int& C) { const int st = b / 1024, sb = b % 1024, swz = sb ^ (((sb >> 9) & 1) << 5); R = (st >> 1) * 16 + swz / 64; C = (st & 1) * 32 + (swz % 64) / 2; }
__host__ __device__ __forceinline__ int perm32(int rho) { const int n = rho >> 4, i = rho & 15; return 8 * (i >> 2) + 4 * n + (i & 3); }

struct Unit { int pm, pn, kt0, nkt, slab; };
struct SplitOrder;
struct Gemm { const bf16_t* A; const bf16_t* Bt; int M, N, K; };

struct StaticOrder {
    int nM, nN, nwg, G, c, nkt;
    __host__ __device__ void init(int M, int N, int G_, int c_, int K_) { nM = M / BM; nN = N / BM; nwg = nM * nN; G = G_; c = c_; nkt = K_ / BK; }
    __host__ __device__ bool next(int i, Unit& u) const {
        const long L = (long)i * G + c; if (L >= nwg) return false;
        int wgid = (int)L; { const int q = nwg / NXCD, r = nwg % NXCD, xcd = wgid % NXCD, off = wgid / NXCD; wgid = (xcd < r ? xcd * (q + 1) : r * (q + 1) + (xcd - r) * q) + off; }
        const int nig = WGM * nN, gid = wgid / nig, fm = gid * WGM, gsz = (nM - fm) < WGM ? (nM - fm) : WGM;
        u.pm = fm + ((wgid % nig) % gsz); u.pn = (wgid % nig) / gsz; u.kt0 = 0; u.nkt = nkt; u.slab = -1; return true;
    }
    __device__ __forceinline__ void a_ready(const Unit&) const {}
    __device__ __forceinline__ void done(const Unit&) const {}
};
struct SplitOrder {
    StaticOrder main; int nMain, nN, spu, kts, nslice, c;
    __host__ __device__ void init(int Mmain, int Mtot, int N, int G_, int c_, int K_, int spu_) { main.init(Mmain, N, G_, c_, K_); nMain = Mmain / BM; nN = N / BM; spu = spu_; kts = (K_ / BK) / spu_; nslice = (Mtot / BM - nMain) * nN * spu_; c = c_; }
    __host__ __device__ bool next(int i, Unit& u) const {
        if (i == 0) return main.next(0, u);
        if (i > 1 || c >= nslice) return false;
        const int e = c / spu, s = c % spu; u.pm = nMain + e / nN; u.pn = e % nN; u.kt0 = s * kts; u.nkt = kts; u.slab = c; return true;
    }
    __device__ __forceinline__ void a_ready(const Unit&) const {}
    __device__ __forceinline__ void done(const Unit&) const {}
};


__device__ __forceinline__ unsigned cvt_pk_bf16(float lo, float hi) { unsigned r; asm volatile("v_cvt_pk_bf16_f32 %0, %1, %2" : "=v"(r) : "v"(lo), "v"(hi)); return r; }
typedef float f32x2 __attribute__((ext_vector_type(2)));

template <class Epi, class Sched, bool ALIGN_EPI = false, bool SP2 = false>
__device__ __forceinline__ void gemm_phase(PG8_LAS unsigned char* lds, const Gemm g, const Sched& S, const Epi& E, float* slabs = nullptr) {
    int tid_ = threadIdx.x; asm volatile("" : "+v"(tid_));
    const int tid = tid_, wid = __builtin_amdgcn_readfirstlane(tid >> 6), lane = tid & 63, wr = wid >> 2, wc = wid & 3, fr = lane & 15, fq = lane >> 4;
    const int K = g.K;
    unsigned voffA[2], voffB[2];
#pragma unroll
    for (int i = 0; i < 2; ++i) { int R, C; stage_rc(tid * 16 + i * 8192, R, C); const int Rb = Epi::PERM ? ((R & ~31) + perm32(R & 31)) : R;
        voffA[i] = (unsigned)(R * K + C) * 2u; voffB[i] = (unsigned)(Rb * K + C) * 2u; }
    const size_t kstep = (size_t)(BK * 2);
    const size_t hstep = (size_t)HALF * K * 2;
    const size_t tstep = 2 * hstep;
    const unsigned ldsw = (unsigned)wid * 1024u;
    const int aoff = lds_byte(wr * 64 + fr, fq * 8), boff = lds_byte(wc * 32 + fr, fq * 8);
#define PG8_SA(b, h) (((b) * 2 + (h)) * HTB)
#define PG8_SB(b, h) ((4 + (b) * 2 + (h)) * HTB)
#define PG8_STAGE(bufoff, gbase, voff) do { _Pragma("unroll") for (int _i = 0; _i < 2; ++_i) \
        __builtin_amdgcn_global_load_lds((const unsigned*)((const char*)(gbase) + (voff)[_i]), (PG8_LAS unsigned*)(lds + (bufoff) + ldsw + _i * 8192), 16, 0, 0); } while (0)
#define PG8_LDA(dst, b, h) do { _Pragma("unroll") for (int m = 0; m < 4; ++m) _Pragma("unroll") for (int k = 0; k < 2; ++k) dst[m][k] = *(const PG8_LAS bf16x8*)(lds + PG8_SA(b, h) + aoff + m * 2048 + k * 1024); } while (0)
#define PG8_LDB(dst, b, h) do { _Pragma("unroll") for (int n = 0; n < 2; ++n) _Pragma("unroll") for (int k = 0; k < 2; ++k) dst[n][k] = *(const PG8_LAS bf16x8*)(lds + PG8_SB(b, h) + boff + n * 2048 + k * 1024); } while (0)
#define PG8_MMA(ai, bj, At, Bt) do { __builtin_amdgcn_s_setprio(1); _Pragma("unroll") for (int m = 0; m < 4; ++m) _Pragma("unroll") for (int n = 0; n < 2; ++n) _Pragma("unroll") for (int k = 0; k < 2; ++k) \
        acc[ai][bj][m][n] = __builtin_amdgcn_mfma_f32_16x16x32_bf16(Bt[n][k], At[m][k], acc[ai][bj][m][n], 0, 0, 0); __builtin_amdgcn_s_setprio(0); } while (0)
#define PG8_WAIT_V(n) asm volatile("s_waitcnt vmcnt(" #n ")" ::: "memory")
#define PG8_WAIT_L(n) asm volatile("s_waitcnt lgkmcnt(" #n ")" ::: "memory")
#define PG8_BAR __builtin_amdgcn_s_barrier()
#define PG8_SCHED __builtin_amdgcn_sched_barrier(0)
    Unit cur, nxt; int ui = 0;
    if (!S.next(0, cur)) return;
    f32x4 acc[2][2][4][2];
#pragma unroll
    for (int a = 0; a < 2; ++a)
#pragma unroll
        for (int b = 0; b < 2; ++b)
#pragma unroll
            for (int m = 0; m < 4; ++m)
#pragma unroll
                for (int n = 0; n < 2; ++n) acc[a][b][m][n] = (f32x4){0.f, 0.f, 0.f, 0.f};
    bf16x8 At[4][2], B0[2][2], B1[2][2];
    const char* cA = (const char*)g.A + (size_t)cur.pm * tstep + (size_t)cur.kt0 * kstep; const char* cB = (const char*)g.Bt + (size_t)cur.pn * tstep + (size_t)cur.kt0 * kstep;
    S.a_ready(cur);
    if constexpr (SP2) {
        PG8_STAGE(PG8_SB(0, 0), cB, voffB); PG8_STAGE(PG8_SB(0, 1), cB + hstep, voffB); PG8_STAGE(PG8_SA(0, 0), cA, voffA); PG8_STAGE(PG8_SA(0, 1), cA + hstep, voffA);
        if (wr == 1) PG8_BAR;
        PG8_WAIT_V(2); PG8_BAR;
        PG8_STAGE(PG8_SB(1, 0), cB + kstep, voffB); PG8_STAGE(PG8_SA(1, 0), cA + kstep, voffA); PG8_STAGE(PG8_SB(1, 1), cB + hstep + kstep, voffB);
        PG8_WAIT_V(6); PG8_BAR;
    } else {
        PG8_STAGE(PG8_SB(0, 0), cB, voffB); PG8_STAGE(PG8_SA(0, 0), cA, voffA); PG8_STAGE(PG8_SB(0, 1), cB + hstep, voffB); PG8_STAGE(PG8_SA(0, 1), cA + hstep, voffA);
        if (wr == 1) PG8_BAR;
        PG8_WAIT_V(4); PG8_BAR;
        PG8_STAGE(PG8_SB(1, 0), cB + kstep, voffB); PG8_STAGE(PG8_SA(1, 0), cA + kstep, voffA); PG8_STAGE(PG8_SB(1, 1), cB + hstep + kstep, voffB);
        PG8_WAIT_V(6); PG8_BAR;
    }
    for (;;) {
        const bool has_next = S.next(ui + 1, nxt);
        const char* nA = has_next ? (const char*)g.A + (size_t)nxt.pm * tstep + (size_t)nxt.kt0 * kstep : cA; const char* nB = has_next ? (const char*)g.Bt + (size_t)nxt.pn * tstep + (size_t)nxt.kt0 * kstep : cB;
        const int nt = cur.nkt;
        for (int t = 0; t < nt; t += 2) {
            const bool last = (t == nt - 2);
            const char* a1 = cA + (size_t)(t + 1) * kstep;
            const char* a2 = last ? nA : cA + (size_t)(t + 2) * kstep; const char* b2 = last ? nB : cB + (size_t)(t + 2) * kstep;
            const char* a3 = a2 + kstep; const char* b3 = b2 + kstep;
            if (last && has_next) S.a_ready(nxt);
            if constexpr (SP2) {
            PG8_LDB(B0, 0, 0); PG8_LDB(B1, 0, 1); PG8_SCHED; PG8_LDA(At, 0, 0); PG8_STAGE(PG8_SA(1, 1), a1 + hstep, voffA);
            PG8_WAIT_V(8); PG8_WAIT_L(0); PG8_BAR; PG8_MMA(0, 0, At, B0); PG8_MMA(0, 1, At, B1); PG8_BAR; PG8_SCHED;
            PG8_LDA(At, 0, 1); PG8_STAGE(PG8_SB(0, 0), b2, voffB); PG8_STAGE(PG8_SB(0, 1), b2 + hstep, voffB); PG8_STAGE(PG8_SA(0, 0), a2, voffA);
            PG8_WAIT_V(8); PG8_WAIT_L(0); PG8_BAR; PG8_MMA(1, 0, At, B0); PG8_MMA(1, 1, At, B1); PG8_BAR; PG8_SCHED;
            PG8_LDB(B0, 1, 0); PG8_LDB(B1, 1, 1); PG8_SCHED; PG8_LDA(At, 1, 0); PG8_STAGE(PG8_SA(0, 1), a2 + hstep, voffA);
            PG8_WAIT_V(8); PG8_WAIT_L(0); PG8_BAR; PG8_MMA(0, 0, At, B0); PG8_MMA(0, 1, At, B1); PG8_BAR; PG8_SCHED;
            PG8_LDA(At, 1, 1); PG8_STAGE(PG8_SB(1, 0), b3, voffB); PG8_STAGE(PG8_SB(1, 1), b3 + hstep, voffB); PG8_STAGE(PG8_SA(1, 0), a3, voffA);
            PG8_WAIT_V(8); PG8_WAIT_L(0); PG8_BAR; PG8_MMA(1, 0, At, B0); PG8_MMA(1, 1, At, B1); PG8_BAR; PG8_SCHED;
            } else {
            PG8_LDB(B0, 0, 0); PG8_SCHED; PG8_LDA(At, 0, 0); PG8_STAGE(PG8_SA(1, 1), a1 + hstep, voffA);
            PG8_WAIT_L(8); PG8_BAR; PG8_WAIT_L(0); PG8_MMA(0, 0, At, B0); PG8_BAR; PG8_SCHED;
            PG8_LDB(B1, 0, 1); PG8_STAGE(PG8_SB(0, 0), b2, voffB);
            PG8_BAR; PG8_WAIT_L(0); PG8_MMA(0, 1, At, B1); PG8_BAR;
            PG8_LDA(At, 0, 1); PG8_STAGE(PG8_SA(0, 0), a2, voffA);
            PG8_BAR; PG8_WAIT_L(0); PG8_MMA(1, 0, At, B0); PG8_BAR; PG8_SCHED;
            PG8_STAGE(PG8_SB(0, 1), b2 + hstep, voffB);
            PG8_WAIT_V(6); PG8_BAR; PG8_MMA(1, 1, At, B1); PG8_BAR;
            PG8_LDB(B0, 1, 0); PG8_SCHED; PG8_LDA(At, 1, 0); PG8_STAGE(PG8_SA(0, 1), a2 + hstep, voffA);
            PG8_WAIT_L(8); PG8_BAR; PG8_WAIT_L(0); PG8_MMA(0, 0, At, B0); PG8_BAR; PG8_SCHED;
            PG8_LDB(B1, 1, 1); PG8_STAGE(PG8_SB(1, 0), b3, voffB);
            PG8_BAR; PG8_WAIT_L(0); PG8_MMA(0, 1, At, B1); PG8_BAR;
            PG8_LDA(At, 1, 1); PG8_STAGE(PG8_SA(1, 0), a3, voffA);
            PG8_BAR; PG8_WAIT_L(0); PG8_MMA(1, 0, At, B0); PG8_BAR; PG8_SCHED;
            PG8_STAGE(PG8_SB(1, 1), b3 + hstep, voffB);
            PG8_WAIT_V(6); PG8_BAR; PG8_MMA(1, 1, At, B1); PG8_BAR;
            }
        }
        if constexpr (ALIGN_EPI) { if (wr == 0) PG8_BAR; }
        if constexpr (!Epi::AFTER_DRAIN) {
            if (cur.slab >= 0) {
                float* sb = slabs + (size_t)cur.slab * 65536 + (size_t)(wr * 64 + fr) * 256 + wc * 32 + 4 * fq;
#pragma unroll
                for (int ai = 0; ai < 2; ++ai)
#pragma unroll
                    for (int m = 0; m < 4; ++m)
#pragma unroll
                        for (int bj = 0; bj < 2; ++bj)
#pragma unroll
                            for (int n = 0; n < 2; ++n) *(f32x4*)(sb + (size_t)(ai * 128 + m * 16) * 256 + bj * 128 + n * 16) = acc[ai][bj][m][n];
            } else E(acc, cur, wr, wc, fr, fq);
            S.done(cur); }
        if (!has_next) break;
#pragma unroll
        for (int a = 0; a < 2; ++a)
#pragma unroll
            for (int b = 0; b < 2; ++b)
#pragma unroll
                for (int m = 0; m < 4; ++m)
#pragma unroll
                    for (int n = 0; n < 2; ++n) acc[a][b][m][n] = (f32x4){0.f, 0.f, 0.f, 0.f};
        cur = nxt; cA = nA; cB = nB; ++ui;
        if constexpr (ALIGN_EPI) { if (wr == 1) PG8_BAR; }
    }
    PG8_WAIT_V(0);
    if constexpr (!ALIGN_EPI) { if (wr == 0) PG8_BAR; }
    PG8_BAR;
    if constexpr (Epi::AFTER_DRAIN) { E.fused(acc, cur, wr, wc, fr, fq, lds, wid, lane); S.done(cur); }
#undef PG8_SA
#undef PG8_SB
#undef PG8_STAGE
#undef PG8_LDA
#undef PG8_LDB
#undef PG8_MMA
#undef PG8_WAIT_V
#undef PG8_WAIT_L
#undef PG8_BAR
#undef PG8_SCHED
}
}

#define LAS __attribute__((address_space(3)))

#define XB_TMO      128
#define XB_XCNT(j)  (256  + 64 * (j))
#define XB_XSUB(j)  (1280 + 64 * (j))
#define XB_XGEN(j)  (2304 + 64 * (j))
#define XB_TOP      3328
#define XB_TOPGEN   3392
#define XCD_BAR_WORDS 3456
#define XB_SPIN_CAP (1u << 18)

__device__ __forceinline__ unsigned xb_ld(unsigned* p)              { return __hip_atomic_load(p, __ATOMIC_RELAXED, __HIP_MEMORY_SCOPE_AGENT); }
__device__ __forceinline__ unsigned xb_add(unsigned* p, unsigned v) { return __hip_atomic_fetch_add(p, v, __ATOMIC_RELAXED, __HIP_MEMORY_SCOPE_AGENT); }
__device__ __forceinline__ unsigned xb_xcc_id() { return (unsigned)__builtin_amdgcn_s_getreg((3 << 11) | 20) & 0xFu; }
#define XB_SPIN(cond, bar) do { unsigned _sp = 0; while (cond) { __builtin_amdgcn_s_sleep(1); \
    if ((++_sp & 255u) == 0u) { if (xb_ld(&(bar)[XB_TMO])) break; if (_sp > XB_SPIN_CAP) { atomicAdd(&(bar)[XB_TMO], 1u); break; } } } } while (0)

struct XcdBarrier {
    unsigned* bar; unsigned x;
    volatile LAS unsigned* st;
};

__device__ __forceinline__ XcdBarrier xcd_barrier_post(unsigned* bar, volatile LAS unsigned* st) {
    XcdBarrier b; b.bar = bar; b.x = xb_xcc_id(); b.st = st;
    if (threadIdx.x == 0) (void)xb_add(&bar[XB_XCNT(b.x)], 1u);
    return b;
}
__device__ __forceinline__ void xcd_barrier_complete(unsigned* bar, unsigned x, unsigned& nloc, unsigned& nx) {
    const unsigned G = gridDim.x * gridDim.y * gridDim.z;
    unsigned sum, cnt, mine, sp = 0u;
    for (;;) {
        sum = 0u; cnt = 0u; mine = 0u;
#pragma unroll
        for (unsigned j = 0; j < 16; ++j) { const unsigned c = xb_ld(&bar[XB_XCNT(j)]); sum += c; cnt += (c > 0u) ? 1u : 0u; mine = (j == x) ? c : mine; }
        if (sum == G) break;
        __builtin_amdgcn_s_sleep(1);
        if ((++sp & 255u) == 0u) { if (xb_ld(&bar[XB_TMO])) break; if (sp > XB_SPIN_CAP) { atomicAdd(&bar[XB_TMO], 1u); break; } }
    }
    nloc = mine > 0u ? mine : 1u; nx = cnt > 0u ? cnt : 1u;
}

__device__ __forceinline__ void xcd_barrier(const XcdBarrier& b) {
    asm volatile("s_waitcnt vmcnt(0)" ::: "memory");
    __syncthreads();
    if (threadIdx.x == 0) {
        unsigned* bar = b.bar;
        __builtin_amdgcn_s_waitcnt(0);
        unsigned nloc = b.st[0], nx = b.st[1];
        if (nloc == 0u) { xcd_barrier_complete(bar, b.x, nloc, nx); b.st[0] = nloc; b.st[1] = nx; }
        const unsigned old = xb_add(&bar[XB_XSUB(b.x)], 1u);
        const unsigned gen = old / nloc;
        if (old + 1u == (gen + 1u) * nloc) {
            __builtin_amdgcn_fence(__ATOMIC_RELEASE, "agent");
            asm volatile("s_waitcnt vmcnt(0)" ::: "memory");
            const unsigned og = xb_add(&bar[XB_TOP], 1u);
            const unsigned tg = og / nx;
            if (og + 1u == (tg + 1u) * nx) xb_add(&bar[XB_TOPGEN], 1u);
            else XB_SPIN(xb_ld(&bar[XB_TOPGEN]) == tg, bar);
            __builtin_amdgcn_fence(__ATOMIC_ACQUIRE, "agent");
            xb_add(&bar[XB_XGEN(b.x)], 1u);
            asm volatile("s_waitcnt vmcnt(0)" ::: "memory");
        } else {
            XB_SPIN(xb_ld(&bar[XB_XGEN(b.x)]) == gen, bar);
            __builtin_amdgcn_fence(__ATOMIC_ACQUIRE, "agent");
            asm volatile("s_waitcnt vmcnt(0)" ::: "memory");
        }
    }
    __syncthreads();
}


#define GAS __attribute__((address_space(1)))

typedef unsigned short bf16;
typedef unsigned v4u __attribute__((ext_vector_type(4)));
typedef unsigned v2u __attribute__((ext_vector_type(2)));
typedef float f32x4 __attribute__((ext_vector_type(4)));
typedef float f32x2 __attribute__((ext_vector_type(2)));
typedef float f32x16 __attribute__((ext_vector_type(16)));
typedef short bf16x8 __attribute__((ext_vector_type(8)));
#define LDS_WAIT() asm volatile("s_waitcnt lgkmcnt(0)" ::: "memory")
#define VM_WAIT() asm volatile("s_waitcnt vmcnt(0)" ::: "memory")

constexpr int DM = 1024, NMETA = 16, SEQ = 4096, NB = 4, DBS = 16, TS = 32, PAST = 1024, FF = 2816, LP = NMETA + SEQ;
constexpr int R_PROMPT = 16, R_SAMPLE = R_PROMPT + NB * SEQ, R_VALID = R_SAMPLE + DBS * TS, MTOT = 17152;
static_assert(R_SAMPLE == 16400 && R_VALID == 16912 && MTOT % 256 == 0 && MTOT >= R_VALID + 64, "row space");
constexpr int DIN = 2496, DINP = 2560, NQA = 768, KVW = 192;
constexpr float DN_ALPHA = 1.189207115002721f, LN_EPS = 1e-5f, RMS_EPS = 1e-6f, LOG2E = 1.4426950408889634f;
constexpr float SM_SCALE = 0.07216878364870322f;
constexpr float KR_SCALE = 0.08838834764831845f;
constexpr size_t O_YP = 0, O_YS = O_YP + (size_t)NB * SEQ * DM, O_PCKV = O_YS + (size_t)DBS * TS * DM, O_PKPE = O_PCKV + (size_t)NB * LP * 128, O_PST = O_PKPE + (size_t)NB * LP * 64,
                 O_SCKV = O_PST + (size_t)NB * 4 * 128 * 128, O_SKPE = O_SCKV + (size_t)DBS * TS * 128, O_SST = O_SKPE + (size_t)DBS * TS * 64, O_END = O_SST + (size_t)DBS * 4 * 128 * 128;
static_assert(O_END == 21868544, "d_out size");

constexpr size_t al256(size_t x) { return (x + 255) & ~(size_t)255; }
constexpr size_t WS_CTL = 0, CTL_BYTES = 1u << 20;
constexpr size_t WS_WFI = WS_CTL + CTL_BYTES;
constexpr size_t WS_WFO = WS_WFI + (size_t)5632 * 1024 * 2;
constexpr size_t WS_WMI = WS_WFO + (size_t)1024 * 2816 * 2;
constexpr size_t WS_WMO = WS_WMI + (size_t)2560 * 1024 * 2;
constexpr size_t WS_WUQ = WS_WMO + (size_t)1024 * 1024 * 2;
constexpr size_t WS_R128 = WS_WUQ + (size_t)768 * 256 * 2;
constexpr size_t WS_R64 = WS_R128 + (size_t)LP * 64 * 8;
constexpr size_t WS_A16A = al256(WS_R64 + (size_t)LP * 32 * 8);
constexpr size_t A16_BYTES = (size_t)MTOT * 1024 * 2;
constexpr size_t WS_A16B = WS_A16A + A16_BYTES;
constexpr size_t WS_Z = WS_A16B + A16_BYTES;
constexpr size_t Z_BYTES = (size_t)MTOT * 1024 * 4;
constexpr size_t WS_HID = WS_Z + Z_BYTES;
constexpr size_t HID_BYTES = (size_t)MTOT * 2816 * 2;
constexpr size_t WS_END = WS_HID + HID_BYTES;
static_assert(WS_END <= 268435456, "workspace map exceeds 256 MiB");
constexpr size_t WS_P2RAW = WS_Z;
constexpr size_t WS_QA = WS_Z;
constexpr size_t WS_KVN = WS_QA + (size_t)MTOT * 768 * 2;
constexpr int KVN_ITEMS = 4 + NB * 4 * 64;
constexpr size_t WS_KVCT = WS_KVN + (size_t)KVN_ITEMS * 32768;
constexpr size_t WS_CKVT = WS_KVCT + (size_t)DBS * 128 * PAST * 2;
static_assert(WS_CKVT + (size_t)128 * MTOT * 2 <= WS_Z + Z_BYTES && WS_KVCT >= WS_P2RAW + (size_t)MTOT * 512 * 4, "Z overlays");
constexpr size_t RB_BYTES = (size_t)MTOT * 512 * 2;
constexpr size_t WS_QR = WS_HID, WS_KR = WS_QR + RB_BYTES, WS_VR = WS_KR + RB_BYTES, WS_GS = WS_VR + RB_BYTES;
constexpr size_t WS_KVB = WS_GS + RB_BYTES;
constexpr size_t WS_KVC = WS_KVB + (size_t)MTOT * KVW * 2;
constexpr size_t WS_CQB = WS_KVC + (size_t)DBS * PAST * KVW * 2;
static_assert(WS_CQB + (size_t)MTOT * 256 * 2 <= WS_HID + HID_BYTES, "HID overlays");
constexpr int CW_BAR = 4096;
constexpr int CW_ATTQ = 16384;

__device__ __forceinline__ float lg2gamma(int h) { return h == 0 ? -0.04580368961312479f : h == 1 ? -0.02272007650008353f : h == 2 ? -0.011315313227834146f : -0.005646563141142063f; }

__device__ __forceinline__ int row_pos(int r) { return r < R_PROMPT ? r : (r < R_SAMPLE ? NMETA + ((r - R_PROMPT) & (SEQ - 1)) : (r < R_VALID ? NMETA + PAST + ((r - R_SAMPLE) & (TS - 1)) : 0)); }
__device__ __forceinline__ unsigned f2bf(float f) { unsigned u = __builtin_bit_cast(unsigned, f); return (u + 0x7fffu + ((u >> 16) & 1u)) >> 16; }
__device__ __forceinline__ unsigned pk2(float lo, float hi) { return pg8::cvt_pk_bf16(lo, hi); }
__device__ __forceinline__ float bf2f(unsigned short b) { return __builtin_bit_cast(float, (unsigned)b << 16); }
__device__ __forceinline__ float bflo(unsigned w) { return __builtin_bit_cast(float, w << 16); }
__device__ __forceinline__ float bfhi(unsigned w) { return __builtin_bit_cast(float, w & 0xffff0000u); }
__device__ __forceinline__ float siluf(float x) { return x * __builtin_amdgcn_rcpf(1.0f + __builtin_amdgcn_exp2f(-x * LOG2E)); }
__device__ __forceinline__ float wave_sum(float v) {
#pragma unroll
    for (int o = 1; o < 64; o <<= 1) v += __shfl_xor(v, o);
    return v;
}

struct Args { const float* in[23]; float* out; unsigned char* ws; };

__device__ __forceinline__ const float* x_row(const Args& a, int r) {
    if (r < R_PROMPT) return a.in[5] + (size_t)r * DM;
    if (r < R_SAMPLE) return a.in[0] + (size_t)(r - R_PROMPT) * DM;
    if (r < R_VALID) return a.in[1] + (size_t)(r - R_SAMPLE) * DM;
    return nullptr;
}

struct EpiSwiglu {
    static constexpr bool PERM = true, AFTER_DRAIN = false;
    bf16* H;
    __device__ __forceinline__ void operator()(const pg8::f32x4 (&acc)[2][2][4][2], const pg8::Unit& u, int wr, int wc, int fr, int fq) const {
        asm volatile("" : "+v"(fr), "+v"(fq));
        const int row0 = u.pm * 256 + wr * 64 + fr, col0 = u.pn * 128 + wc * 32 + 8 * fq;
#pragma unroll
        for (int ai = 0; ai < 2; ++ai)
#pragma unroll
            for (int m = 0; m < 4; ++m) {
                const int row = row0 + ai * 128 + m * 16;
                const pg8::f32x4 g0 = acc[ai][0][m][0], g1 = acc[ai][0][m][1], u0 = acc[ai][1][m][0], u1 = acc[ai][1][m][1];
                v4u w;
                w.x = pk2(siluf(g0[0]) * u0[0], siluf(g0[1]) * u0[1]); w.y = pk2(siluf(g0[2]) * u0[2], siluf(g0[3]) * u0[3]);
                w.z = pk2(siluf(g1[0]) * u1[0], siluf(g1[1]) * u1[1]); w.w = pk2(siluf(g1[2]) * u1[2], siluf(g1[3]) * u1[3]);
                *(v4u*)(H + (size_t)row * FF + col0) = w;
            }
    }
};
template <int SRC> struct EpiResZ {
    static constexpr bool PERM = false, AFTER_DRAIN = false;
    float* Z; const bf16* resb; Args a; float scale;
    __device__ __forceinline__ void operator()(const pg8::f32x4 (&acc)[2][2][4][2], const pg8::Unit& u, int wr, int wc, int fr, int fq) const {
        asm volatile("" : "+v"(fr), "+v"(fq));
        const int row0 = u.pm * 256 + wr * 64 + fr, col0 = u.pn * 256 + wc * 32 + 4 * fq;
#pragma unroll
        for (int ai = 0; ai < 2; ++ai)
#pragma unroll
            for (int m = 0; m < 4; ++m) {
                const int row = row0 + ai * 128 + m * 16;
                const float* xr = SRC == 0 ? x_row(a, row) : nullptr;
#pragma unroll
                for (int bj = 0; bj < 2; ++bj)
#pragma unroll
                    for (int n = 0; n < 2; ++n) {
                        const int c = col0 + bj * 128 + n * 16;
                        f32x4 rv;
                        if (SRC == 0) rv = xr ? *(const f32x4*)(xr + c) : (f32x4){0.f, 0.f, 0.f, 0.f};
                        else { const v2u w = *(const v2u*)(resb + (size_t)row * DM + c); rv = (f32x4){bflo(w.x), bfhi(w.x), bflo(w.y), bfhi(w.y)}; }
                        const pg8::f32x4 av = acc[ai][bj][m][n];
                        f32x4 o; o.x = DN_ALPHA * rv.x + scale * av[0]; o.y = DN_ALPHA * rv.y + scale * av[1]; o.z = DN_ALPHA * rv.z + scale * av[2]; o.w = DN_ALPHA * rv.w + scale * av[3];
                        *(f32x4*)(Z + (size_t)row * DM + c) = o;
                    }
                asm volatile("" ::: "memory");
            }
    }
};
struct EpiMixIn {
    static constexpr bool PERM = true, AFTER_DRAIN = false;
    bf16 *QR, *KR, *VR, *GS; float* P2; const f32x2* R128;
    __device__ __forceinline__ void operator()(const pg8::f32x4 (&acc)[2][2][4][2], const pg8::Unit& u, int wr, int wc, int fr, int fq) const {
        asm volatile("" : "+v"(fr), "+v"(fq));
        const int row0 = u.pm * 256 + wr * 64 + fr, pn = u.pn;
        if (pn < 4) {
            bf16* dst = pn < 2 ? QR : KR; const float sc = pn < 2 ? 1.0f : KR_SCALE;
            const int head = 2 * (pn & 1) + (wc >> 1), i0 = (wc & 1) * 32 + 8 * fq;
#pragma unroll
            for (int ai = 0; ai < 2; ++ai)
#pragma unroll
                for (int m = 0; m < 4; ++m) {
                    const int row = row0 + ai * 128 + m * 16;
                    const f32x2* cs = R128 + (size_t)row_pos(row) * 64 + i0;
                    float o1[8], o2[8];
#pragma unroll
                    for (int n = 0; n < 2; ++n)
#pragma unroll
                        for (int j = 0; j < 4; ++j) { const f32x2 t = cs[4 * n + j]; const float x1 = acc[ai][0][m][n][j], x2 = acc[ai][1][m][n][j];
                            o1[4 * n + j] = (x1 * t.x - x2 * t.y) * sc; o2[4 * n + j] = (x1 * t.y + x2 * t.x) * sc; }
                    v4u w1, w2;
                    w1.x = pk2(o1[0], o1[1]); w1.y = pk2(o1[2], o1[3]); w1.z = pk2(o1[4], o1[5]); w1.w = pk2(o1[6], o1[7]);
                    w2.x = pk2(o2[0], o2[1]); w2.y = pk2(o2[2], o2[3]); w2.z = pk2(o2[4], o2[5]); w2.w = pk2(o2[6], o2[7]);
                    bf16* p = dst + (size_t)row * 512 + head * 128 + i0;
                    *(v4u*)p = w1; *(v4u*)(p + 64) = w2;
                    asm volatile("" ::: "memory");
                }
        } else if (pn < 8) {
            bf16* dst = pn < 6 ? VR : GS; const bool act = pn >= 6;
            const int cb = (pn & 1) * 256 + wc * 32 + 8 * fq;
#pragma unroll
            for (int ai = 0; ai < 2; ++ai)
#pragma unroll
                for (int m = 0; m < 4; ++m) {
                    const int row = row0 + ai * 128 + m * 16;
#pragma unroll
                    for (int bj = 0; bj < 2; ++bj) {
                        pg8::f32x4 v0 = acc[ai][bj][m][0], v1 = acc[ai][bj][m][1];
                        if (act) {
#pragma unroll
                            for (int j = 0; j < 4; ++j) { v0[j] = siluf(v0[j]); v1[j] = siluf(v1[j]); } }
                        v4u w; w.x = pk2(v0[0], v0[1]); w.y = pk2(v0[2], v0[3]); w.z = pk2(v1[0], v1[1]); w.w = pk2(v1[2], v1[3]);
                        *(v4u*)(dst + (size_t)row * 512 + cb + bj * 128) = w;
                    }
                }
        } else {
            const int cb = (pn - 8) * 256 + wc * 32 + 8 * fq;
#pragma unroll
            for (int ai = 0; ai < 2; ++ai)
#pragma unroll
                for (int m = 0; m < 4; ++m) {
                    const int row = row0 + ai * 128 + m * 16;
#pragma unroll
                    for (int bj = 0; bj < 2; ++bj) {
                        float* p = P2 + (size_t)row * 512 + cb + bj * 128;
                        const pg8::f32x4 v0 = acc[ai][bj][m][0], v1 = acc[ai][bj][m][1];
                        *(f32x4*)p = (f32x4){v0[0], v0[1], v0[2], v0[3]}; *(f32x4*)(p + 4) = (f32x4){v1[0], v1[1], v1[2], v1[3]};
                    }
                }
        }
    }
};
struct EpiUq {
    static constexpr bool PERM = true, AFTER_DRAIN = false;
    bf16* QA; const f32x2* R64;
    __device__ __forceinline__ void operator()(const pg8::f32x4 (&acc)[2][2][4][2], const pg8::Unit& u, int wr, int wc, int fr, int fq) const {
        asm volatile("" : "+v"(fr), "+v"(fq));
        const int row0 = u.pm * 256 + wr * 64 + fr, pn = u.pn;
        if (pn < 2) {
#pragma unroll
            for (int ai = 0; ai < 2; ++ai)
#pragma unroll
                for (int m = 0; m < 4; ++m) {
                    const int row = row0 + ai * 128 + m * 16;
#pragma unroll
                    for (int bj = 0; bj < 2; ++bj) {
                        const pg8::f32x4 v0 = acc[ai][bj][m][0] * SM_SCALE, v1 = acc[ai][bj][m][1] * SM_SCALE;
                        v4u w; w.x = pk2(v0[0], v0[1]); w.y = pk2(v0[2], v0[3]); w.z = pk2(v1[0], v1[1]); w.w = pk2(v1[2], v1[3]);
                        *(v4u*)(QA + (size_t)row * NQA + (2 * pn + bj) * KVW + wc * 32 + 8 * fq) = w;
                    }
                }
        } else {
            const int head = wc, i0 = 8 * fq;
#pragma unroll
            for (int ai = 0; ai < 2; ++ai)
#pragma unroll
                for (int m = 0; m < 4; ++m) {
                    const int row = row0 + ai * 128 + m * 16;
                    const f32x2* cs = R64 + (size_t)row_pos(row) * 32 + i0;
                    float o1[8], o2[8];
#pragma unroll
                    for (int n = 0; n < 2; ++n)
#pragma unroll
                        for (int j = 0; j < 4; ++j) { const f32x2 t = cs[4 * n + j]; const float x1 = acc[ai][0][m][n][j], x2 = acc[ai][1][m][n][j];
                            o1[4 * n + j] = (x1 * t.x - x2 * t.y) * SM_SCALE; o2[4 * n + j] = (x1 * t.y + x2 * t.x) * SM_SCALE; }
                    v4u w1, w2;
                    w1.x = pk2(o1[0], o1[1]); w1.y = pk2(o1[2], o1[3]); w1.z = pk2(o1[4], o1[5]); w1.w = pk2(o1[6], o1[7]);
                    w2.x = pk2(o2[0], o2[1]); w2.y = pk2(o2[2], o2[3]); w2.z = pk2(o2[4], o2[5]); w2.w = pk2(o2[6], o2[7]);
                    bf16* p = QA + (size_t)row * NQA + head * KVW + 128 + i0;
                    *(v4u*)p = w1; *(v4u*)(p + 32) = w2;
                    asm volatile("" ::: "memory");
                }
        }
    }
};

__device__ __forceinline__ int src_col(int mat, int n) {
    if (mat == 0) { const int pn = n >> 8, bj = (n >> 7) & 1, i = n & 127; return bj * FF + 128 * pn + i; }
    if (mat == 2) {
        if (n < 1024) { const int pn = n >> 8, bj = (n >> 7) & 1, ip = n & 127, hh = ip >> 6, i = ip & 63; return (pn >> 1) * 512 + (2 * (pn & 1) + hh) * 128 + 64 * bj + i; }
        return n < DIN ? n : -1; }
    if (mat == 3) { const int bj = n >> 7, ip = n & 127, head = ip >> 5, i = ip & 31; return head * KVW + 128 + 32 * bj + i; }
    return n;
}
__device__ __forceinline__ void transpose_item(const float* __restrict__ W, int srcN, bf16* WT, int dstPitch, int dstRowOff, int mat, int k0, int n0, LAS float* scr, int lane) {
    const int sc = src_col(mat, n0 + (lane & 31));
    float v[32];
    const float* wp = W + (size_t)(k0 + (lane >> 5)) * srcN + (sc >= 0 ? sc : 0);
#pragma unroll
    for (int i = 0; i < 32; ++i) v[i] = wp[(size_t)(2 * i) * srcN];
#pragma unroll
    for (int i = 0; i < 32; ++i) scr[(2 * i + (lane >> 5)) * 33 + (lane & 31)] = sc >= 0 ? v[i] : 0.f;
    LDS_WAIT();
    const int c = lane & 7;
#pragma unroll
    for (int j = 0; j < 4; ++j) { const int n = (lane >> 3) + 8 * j; const LAS float* s = scr + (8 * c) * 33 + n;
        v4u o; o.x = pk2(s[0 * 33], s[1 * 33]); o.y = pk2(s[2 * 33], s[3 * 33]); o.z = pk2(s[4 * 33], s[5 * 33]); o.w = pk2(s[6 * 33], s[7 * 33]);
        *(v4u*)(WT + (size_t)(dstRowOff + n0 + n) * dstPitch + k0 + 8 * c) = o; }
    LDS_WAIT();
}
__device__ __forceinline__ void transpose_matrix(const float* W, int Kdim, int srcN, bf16* WT, int Ndst, int dstPitch, int dstRowOff, int mat, LAS float* scr, int gw, int NGW, int lane) {
    const int nblk = Ndst / 32, nitems = (Kdim / 64) * nblk;
    for (int it = gw; it < nitems; it += NGW) transpose_item(W, srcN, WT, dstPitch, dstRowOff, mat, 64 * (it / nblk), 32 * (it % nblk), scr, lane);
}
__device__ __forceinline__ void sincos_acc(float ang, float& sn, float& cs) {
    const double x = (double)ang; const double kq = __builtin_rint(x * 0.63661977236758134308);
    const double r = (x - kq * 1.57079632679489655800e+00) - kq * 6.12323399573676603587e-17;
    const double r2 = r * r;
    const double s = r * (1.0 + r2 * (-1.0 / 6 + r2 * (1.0 / 120 + r2 * (-1.0 / 5040 + r2 * (1.0 / 362880 + r2 * (-1.0 / 39916800 + r2 * (1.0 / 6227020800.0)))))));
    const double c = 1.0 + r2 * (-0.5 + r2 * (1.0 / 24 + r2 * (-1.0 / 720 + r2 * (1.0 / 40320 + r2 * (-1.0 / 3628800 + r2 * (1.0 / 479001600 + r2 * (-1.0 / 87178291200.0)))))));
    const int q = (int)((long long)kq & 3);
    const double ss = (q == 0) ? s : (q == 1) ? c : (q == 2) ? -s : -c;
    const double cc = (q == 0) ? c : (q == 1) ? -s : (q == 2) ? -c : s;
    sn = (float)ss; cs = (float)cc;
}

constexpr int MAIN_ROWS = 16384;
template <bool FINAL, int RES, int SPU> __device__ __forceinline__ void ln_rows(const Args& a, const float* Z, const float* g, const float* b, bf16* outB, const float* slabs, const bf16* resb, float scale, int gw, int NGW, int lane) {
    f32x4 gv[4], bv[4];
#pragma unroll
    for (int j = 0; j < 4; ++j) { gv[j] = *(const f32x4*)(g + 4 * lane + 256 * j); bv[j] = *(const f32x4*)(b + 4 * lane + 256 * j); }
    for (int r = gw; r < (FINAL ? R_VALID : MTOT); r += NGW) {
        if (FINAL && r < R_PROMPT) continue;
        f32x4 v[4]; float s = 0.f;
        if (r < MAIN_ROWS) {
            const f32x4* zr = (const f32x4*)(Z + (size_t)r * DM) + lane;
#pragma unroll
            for (int j = 0; j < 4; ++j) v[j] = zr[64 * j];
        } else {
            const int pm = r >> 8, rl = r & 255; const float* xr = RES == 0 ? x_row(a, r) : nullptr;
#pragma unroll
            for (int j = 0; j < 4; ++j) {
                f32x4 acc = {0.f, 0.f, 0.f, 0.f};
                const float* sp = slabs + (size_t)(((pm - MAIN_ROWS / 256) * 4 + j) * SPU) * 65536 + (size_t)rl * 256 + 4 * lane;
                f32x4 t[SPU];
#pragma unroll
                for (int q = 0; q < SPU; ++q) t[q] = *(const f32x4*)(sp + (size_t)q * 65536);
#pragma unroll
                for (int q = 0; q < SPU; ++q) acc += t[q];
                f32x4 rv;
                if (RES == 0) rv = xr ? *((const f32x4*)xr + lane + 64 * j) : (f32x4){0.f, 0.f, 0.f, 0.f};
                else { const v2u w = *((const v2u*)(resb + (size_t)r * DM) + lane + 64 * j); rv = (f32x4){bflo(w.x), bfhi(w.x), bflo(w.y), bfhi(w.y)}; }
                v[j] = rv * DN_ALPHA + acc * scale;
            }
        }
#pragma unroll
        for (int j = 0; j < 4; ++j) s += (v[j].x + v[j].y) + (v[j].z + v[j].w);
        const float mean = wave_sum(s) * (1.f / DM); float s2 = 0.f;
#pragma unroll
        for (int j = 0; j < 4; ++j) { v[j] = v[j] - mean; s2 += (v[j].x * v[j].x + v[j].y * v[j].y) + (v[j].z * v[j].z + v[j].w * v[j].w); }
        const float rstd = 1.0f / sqrtf(wave_sum(s2) * (1.f / DM) + LN_EPS);
        if (FINAL) {
            float* o = a.out + (r < R_SAMPLE ? O_YP + (size_t)(r - R_PROMPT) * DM : O_YS + (size_t)(r - R_SAMPLE) * DM);
#pragma unroll
            for (int j = 0; j < 4; ++j) *((f32x4*)o + lane + 64 * j) = v[j] * rstd * gv[j] + bv[j];
        } else {
            v2u* o = (v2u*)(outB + (size_t)r * DM) + lane;
#pragma unroll
            for (int j = 0; j < 4; ++j) { const f32x4 y = v[j] * rstd * gv[j] + bv[j]; v2u w; w.x = pk2(y.x, y.y); w.y = pk2(y.z, y.w); o[64 * j] = w; }
        }
    }
}

__device__ __forceinline__ void post_rows(const Args& a, int gw, int NGW, int lane) {
    unsigned char* ws = a.ws;
    const float* P2 = (const float*)(ws + WS_P2RAW); bf16* CQB = (bf16*)(ws + WS_CQB); bf16* KVB = (bf16*)(ws + WS_KVB);
    const f32x2* R64 = (const f32x2*)(ws + WS_R64);
    const f32x4 gq = *(const f32x4*)(a.in[12] + 4 * lane);
    const float gk0 = a.in[14][lane], gk1 = a.in[14][64 + lane];
    for (int r0 = gw; r0 < MTOT; r0 += 4 * NGW) {
        f32x4 cq[4]; float c0[4], c1[4], k1[4], k2[4]; f32x2 cs[4];
#pragma unroll
        for (int u = 0; u < 4; ++u) { const int row = r0 + u * NGW; if (row < MTOT) { const float* p = P2 + (size_t)row * 512;
            cq[u] = *(const f32x4*)(p + 4 * lane); c0[u] = p[256 + lane]; c1[u] = p[320 + lane]; k1[u] = p[384 + (lane & 31)]; k2[u] = p[416 + (lane & 31)]; cs[u] = R64[(size_t)row_pos(row) * 32 + (lane & 31)]; } }
#pragma unroll
        for (int u = 0; u < 4; ++u) { const int row = r0 + u * NGW; if (row < MTOT) {
            const float ssq = wave_sum((cq[u].x * cq[u].x + cq[u].y * cq[u].y) + (cq[u].z * cq[u].z + cq[u].w * cq[u].w));
            const float ssk = wave_sum(c0[u] * c0[u] + c1[u] * c1[u]);
            const float rq = 1.0f / sqrtf(ssq * (1.f / 256) + RMS_EPS), rk = 1.0f / sqrtf(ssk * (1.f / 128) + RMS_EPS);
            v2u w; w.x = pk2(cq[u].x * rq * gq.x, cq[u].y * rq * gq.y); w.y = pk2(cq[u].z * rq * gq.z, cq[u].w * rq * gq.w);
            *((v2u*)(CQB + (size_t)row * 256) + lane) = w;
            const float v0 = c0[u] * rk * gk0, v1 = c1[u] * rk * gk1;
            const float kp = lane < 32 ? k1[u] * cs[u].x - k2[u] * cs[u].y : k1[u] * cs[u].y + k2[u] * cs[u].x;
            KVB[(size_t)row * KVW + lane] = (bf16)f2bf(v0); KVB[(size_t)row * KVW + 64 + lane] = (bf16)f2bf(v1); KVB[(size_t)row * KVW + 128 + lane] = (bf16)f2bf(kp);
            if (row < R_PROMPT) {
#pragma unroll
                for (int b = 0; b < NB; ++b) { float* oc = a.out + O_PCKV + ((size_t)b * LP + row) * 128; oc[lane] = v0; oc[64 + lane] = v1; a.out[O_PKPE + ((size_t)b * LP + row) * 64 + lane] = kp; }
            } else if (row < R_SAMPLE) {
                const int b = (row - R_PROMPT) >> 12, sq = (row - R_PROMPT) & (SEQ - 1);
                float* oc = a.out + O_PCKV + ((size_t)b * LP + NMETA + sq) * 128; oc[lane] = v0; oc[64 + lane] = v1; a.out[O_PKPE + ((size_t)b * LP + NMETA + sq) * 64 + lane] = kp;
            } else if (row < R_VALID) {
                float* oc = a.out + O_SCKV + (size_t)(row - R_SAMPLE) * 128; oc[lane] = v0; oc[64 + lane] = v1; a.out[O_SKPE + (size_t)(row - R_SAMPLE) * 64 + lane] = kp;
            } } }
    }
    bf16* KVC = (bf16*)(ws + WS_KVC);
#pragma unroll 4
    for (int r = gw; r < DBS * PAST; r += NGW) {
        const float v0 = a.in[2][(size_t)r * 128 + lane], v1 = a.in[2][(size_t)r * 128 + 64 + lane], kp = a.in[3][(size_t)r * 64 + lane];
        KVC[(size_t)r * KVW + lane] = (bf16)f2bf(v0); KVC[(size_t)r * KVW + 64 + lane] = (bf16)f2bf(v1); KVC[(size_t)r * KVW + 128 + lane] = (bf16)f2bf(kp);
    }
}

__device__ __forceinline__ int crow(int r, int hi) { return (r & 3) + 8 * (r >> 2) + 4 * hi; }
#define PK4(P, BASE, OUT) do { unsigned a0_ = pk2(P[BASE + 0], P[BASE + 1]), a1_ = pk2(P[BASE + 2], P[BASE + 3]);   \
    unsigned b0_ = pk2(P[BASE + 4], P[BASE + 5]), b1_ = pk2(P[BASE + 6], P[BASE + 7]);                              \
    auto r0_ = __builtin_amdgcn_permlane32_swap(a0_, b0_, false, false); auto r1_ = __builtin_amdgcn_permlane32_swap(a1_, b1_, false, false); \
    v4u w_ = {r0_[0], r1_[0], r0_[1], r1_[1]}; OUT = __builtin_bit_cast(bf16x8, w_); } while (0)
__device__ __forceinline__ float half_swap_max(float x) { auto rr = __builtin_amdgcn_permlane32_swap(__float_as_uint(x), __float_as_uint(x), false, false); return fmaxf(__uint_as_float(rr[0]), __uint_as_float(rr[1])); }
__device__ __forceinline__ float half_swap_sum(float x) { auto rr = __builtin_amdgcn_permlane32_swap(__float_as_uint(x), __float_as_uint(x), false, false); return __uint_as_float(rr[0]) + __uint_as_float(rr[1]); }


typedef short v4i16_t __attribute__((ext_vector_type(4)));
__device__ __forceinline__ unsigned offb(unsigned row, unsigned ch) { return 256u * row + 16u * (ch ^ (((row & 3) << 2) | ((row >> 2) & 3))); }
__device__ __forceinline__ unsigned offk(unsigned row, unsigned ch) { return 128u * row + 16u * (ch ^ ((row >> 1) & 7)); }
__device__ __forceinline__ bf16x8 rowfrag(LAS unsigned char* T, unsigned rb, unsigned lane, unsigned s) { return *(LAS bf16x8*)(T + offb(rb + (lane & 31), 2 * s + (lane >> 5))); }
__device__ __forceinline__ bf16x8 rowfrag64(LAS unsigned char* T, unsigned rb, unsigned lane, unsigned s) { return *(LAS bf16x8*)(T + offk(rb + (lane & 31), 2 * s + (lane >> 5))); }
__device__ __forceinline__ bf16x8 trfrag(LAS unsigned char* T, unsigned lane, unsigned c, unsigned ks) {
    const unsigned h = lane >> 5, blk = (lane >> 4) & 1, q = (lane & 15) >> 2, p = lane & 3, row = 16 * ks + 8 * h + q, ch = 4 * c + 2 * blk + (p >> 1);
    const v4i16_t lo = __builtin_amdgcn_ds_read_tr16_b64_v4i16((LAS v4i16_t*)(T + offb(row, ch) + 8 * (p & 1)));
    const v4i16_t hi = __builtin_amdgcn_ds_read_tr16_b64_v4i16((LAS v4i16_t*)(T + offb(row + 4, ch) + 8 * (p & 1)));
    return (bf16x8){lo[0], lo[1], lo[2], lo[3], hi[0], hi[1], hi[2], hi[3]};
}

constexpr int AT_TILE = 24576;
__device__ __forceinline__ const bf16* attn_tile_src(unsigned char* ws, int type, int bi, int t, int& nvalid) {
    const bf16* KVB = (const bf16*)(ws + WS_KVB); const bf16* KVC = (const bf16*)(ws + WS_KVC);
    if (t == 0) { nvalid = NMETA; return KVB; }
    if (type == 0) { nvalid = 64; return KVB + (size_t)(R_PROMPT + bi * SEQ + 64 * (t - 1)) * KVW; }
    if (t <= 16) { nvalid = 64; return KVC + ((size_t)bi * PAST + 64 * (t - 1)) * KVW; }
    nvalid = TS; return KVB + (size_t)(R_SAMPLE + TS * bi) * KVW;
}
__device__ __forceinline__ void attn_unit(const Args& a, LAS unsigned char* L, int type, int bi, int c, int qh, int tid) {
    asm volatile("" : "+v"(tid));
    unsigned char* ws = a.ws;
    const bf16* QA = (const bf16*)(ws + WS_QA); bf16* MIXA = (bf16*)(ws + WS_A16A);
    const int lane = tid & 63, wave = __builtin_amdgcn_readfirstlane(tid >> 6), g = wave >> 2, h = wave & 3, r32 = lane & 31, hi = lane >> 5;
    int qrow0, nq, nt;
    if (type == 0) { qrow0 = R_PROMPT + bi * SEQ + 64 * c + 32 * qh; nq = 32; nt = c + 2; }
    else if (type == 1) { qrow0 = R_SAMPLE + TS * bi; nq = 32; nt = 18; }
    else { qrow0 = 0; nq = 16; nt = 1; }
    const int nsteps = (nt + 1) >> 1;
    bf16x8 qr[12];
    { const bf16* qp = QA + (size_t)(qrow0 + r32) * NQA + h * KVW + hi * 8;
#pragma unroll
      for (int d0 = 0; d0 < 12; ++d0) qr[d0] = *(const bf16x8*)(qp + d0 * 16); }
    f32x16 o[4];
#pragma unroll
    for (int d = 0; d < 4; ++d)
#pragma unroll
        for (int r = 0; r < 16; ++r) o[d][r] = 0.f;
    float m_reg = -1e30f, l_reg = 0.f;
    unsigned rb_[8], kb_[4], tb_[8];
    { const unsigned X = ((r32 & 3) << 2) | ((r32 >> 2) & 3);
#pragma unroll
      for (int s = 0; s < 8; ++s) rb_[s] = 256u * r32 + 32u * (s ^ (X >> 1)) + 16u * (hi ^ (X & 1));
#pragma unroll
      for (int s = 0; s < 4; ++s) kb_[s] = 16384u + offk(r32, 2 * s + hi);
      const unsigned blk = (lane >> 4) & 1, q = (lane & 15) >> 2, p = lane & 3;
#pragma unroll
      for (int cb = 0; cb < 4; ++cb)
#pragma unroll
          for (int t = 0; t < 2; ++t) tb_[2 * cb + t] = 256u * (8 * hi + 4 * t + q) + 64u * (cb ^ q) + 16u * ((2 * blk + (p >> 1)) ^ ((2 * hi + t) & 3)) + 8u * (p & 1); }
#define AT_STAGE(step) do { int ln_ = lane; asm volatile("" : "+v"(ln_)); _Pragma("unroll") for (int i_ = 0; i_ < 6; ++i_) { const int pid_ = wave * 6 + i_, tt_ = pid_ >= 24 ? 1 : 0, pp_ = pid_ - 24 * tt_, t_ = 2 * (step) + tt_; \
        if (t_ < nt) { int nv_; const bf16* src_ = attn_tile_src(ws, type, bi, t_, nv_); LAS unsigned char* T_ = L + (((step) % 3) * 2 + tt_) * AT_TILE + (pp_ < 16 ? pp_ * 1024 : 16384 + (pp_ - 16) * 1024); unsigned so_; \
            if (pp_ < 16) { const unsigned row_ = 4 * pp_ + (ln_ >> 4), slot_ = ln_ & 15; so_ = row_ * KVW + 8 * (slot_ ^ (((row_ & 3) << 2) | ((row_ >> 2) & 3))); } \
            else { const unsigned row_ = 8 * (pp_ - 16) + (ln_ >> 3), slot_ = ln_ & 7; so_ = row_ * KVW + 128 + 8 * (slot_ ^ ((row_ >> 1) & 7)); } \
            __builtin_amdgcn_global_load_lds((const unsigned*)(src_ + so_), (LAS unsigned*)T_, 16, 0, 0); } } } while (0)
    AT_STAGE(0);
    __syncthreads();
    bf16x8 pa0, pa1, pa2, pa3; int pend = -1;
#define AT_TR(T_, cb, ks) ({ const v4i16_t lo_ = __builtin_amdgcn_ds_read_tr16_b64_v4i16((LAS v4i16_t*)((T_) + tb_[2 * (cb)] + 4096 * (ks))), hi_ = __builtin_amdgcn_ds_read_tr16_b64_v4i16((LAS v4i16_t*)((T_) + tb_[2 * (cb) + 1] + 4096 * (ks))); \
                (bf16x8){lo_[0], lo_[1], lo_[2], lo_[3], hi_[0], hi_[1], hi_[2], hi_[3]}; })
#define AT_PV(T_) do { _Pragma("unroll") for (int d0 = 0; d0 < 4; ++d0) { const bf16x8 va_ = AT_TR(T_, d0, 0), vb_ = AT_TR(T_, d0, 1), vc_ = AT_TR(T_, d0, 2), vd_ = AT_TR(T_, d0, 3); \
            o[d0] = __builtin_amdgcn_mfma_f32_32x32x16_bf16(pa0, va_, o[d0], 0, 0, 0); o[d0] = __builtin_amdgcn_mfma_f32_32x32x16_bf16(pa1, vb_, o[d0], 0, 0, 0); \
            o[d0] = __builtin_amdgcn_mfma_f32_32x32x16_bf16(pa2, vc_, o[d0], 0, 0, 0); o[d0] = __builtin_amdgcn_mfma_f32_32x32x16_bf16(pa3, vd_, o[d0], 0, 0, 0); } } while (0)
    for (int s = 0; s < nsteps; ++s) {
        if (s + 1 < nsteps) AT_STAGE(s + 1);
        const int t = 2 * s + g; const bool act = t < nt;
        f32x16 p0, p1;
        if (act) {
            LAS unsigned char* T = L + ((s % 3) * 2 + g) * AT_TILE;
#pragma unroll
            for (int r = 0; r < 16; ++r) { p0[r] = 0.f; p1[r] = 0.f; }
            bf16x8 k0 = *(LAS bf16x8*)(T + rb_[0]), k1 = *(LAS bf16x8*)(T + rb_[0] + 8192);
#pragma unroll
            for (int d0 = 0; d0 < 12; ++d0) {
                bf16x8 n0 = k0, n1 = k1;
                if (d0 < 7) { n0 = *(LAS bf16x8*)(T + rb_[d0 + 1]); n1 = *(LAS bf16x8*)(T + rb_[d0 + 1] + 8192); }
                else if (d0 < 11) { n0 = *(LAS bf16x8*)(T + kb_[d0 - 7]); n1 = *(LAS bf16x8*)(T + kb_[d0 - 7] + 4096); }
                p0 = __builtin_amdgcn_mfma_f32_32x32x16_bf16(k0, qr[d0], p0, 0, 0, 0);
                p1 = __builtin_amdgcn_mfma_f32_32x32x16_bf16(k1, qr[d0], p1, 0, 0, 0);
                k0 = n0; k1 = n1;
            }
        }
        if (pend >= 0) { LAS unsigned char* Tp = L + (pend * 2 + g) * AT_TILE; AT_PV(Tp); }
        if (g == 1) __syncthreads();
        if (act) {
            int nvalid; (void)attn_tile_src(ws, type, bi, t, nvalid);
            if (nvalid < 64) {
#pragma unroll
                for (int r = 0; r < 16; ++r) { const int key = crow(r, hi); if (key >= nvalid) p0[r] = -1e30f; if (key + 32 >= nvalid) p1[r] = -1e30f; }
            }
            float pmax = p0[0];
#pragma unroll
            for (int r = 1; r < 16; ++r) pmax = fmaxf(pmax, p0[r]);
#pragma unroll
            for (int r = 0; r < 16; ++r) pmax = fmaxf(pmax, p1[r]);
            pmax = half_swap_max(pmax);
            float alpha = 1.f;
            if (!__all(pmax - m_reg <= 8.0f)) { const float mn = fmaxf(m_reg, pmax); alpha = __builtin_amdgcn_exp2f((m_reg - mn) * LOG2E); m_reg = mn; }
            const float mnC = -m_reg * LOG2E; float ps = 0.f;
#pragma unroll
            for (int r = 0; r < 16; ++r) { p0[r] = __builtin_amdgcn_exp2f(fmaf(p0[r], LOG2E, mnC)); p1[r] = __builtin_amdgcn_exp2f(fmaf(p1[r], LOG2E, mnC)); ps += p0[r] + p1[r]; }
            ps = half_swap_sum(ps);
            l_reg = l_reg * alpha + ps;
            if (__any(alpha < 1.f)) {
#pragma unroll
                for (int r = 0; r < 16; ++r) { const float ar = __shfl(alpha, crow(r, hi));
#pragma unroll
                    for (int d = 0; d < 4; ++d) o[d][r] *= ar; }
            }
            PK4(p0, 0, pa0); PK4(p0, 8, pa1); PK4(p1, 0, pa2); PK4(p1, 8, pa3);
            pend = s % 3;
        } else pend = -1;
        if (g == 0) __syncthreads();
    }
    if (pend >= 0) { LAS unsigned char* Tp = L + (pend * 2 + g) * AT_TILE; AT_PV(Tp); }
    __syncthreads();
#undef AT_PV
#undef AT_TR
#undef AT_STAGE
    LAS float* M = (LAS float*)(L + h * 17408);
    if (g == 1) {
#pragma unroll
        for (int d = 0; d < 4; ++d)
#pragma unroll
            for (int r = 0; r < 16; ++r) M[(d * 16 + r) * 64 + lane] = o[d][r];
        M[4096 + lane] = m_reg; M[4160 + lane] = l_reg;
    }
    __syncthreads();
    if (g == 0) {
        const float m1 = M[4096 + lane], l1 = M[4160 + lane];
        const float mm = fmaxf(m_reg, m1), f0 = __builtin_amdgcn_exp2f((m_reg - mm) * LOG2E), f1 = __builtin_amdgcn_exp2f((m1 - mm) * LOG2E);
        const float rl = __builtin_amdgcn_rcpf(l_reg * f0 + l1 * f1), s0 = f0 * rl, s1 = f1 * rl;
#pragma unroll
        for (int r = 0; r < 16; ++r) { const int qi = crow(r, hi); const float a0 = __shfl(s0, qi), a1 = __shfl(s1, qi);
            bf16* op = MIXA + (size_t)(qrow0 + qi) * DM + 512 + h * 128 + r32;
#pragma unroll
            for (int d0 = 0; d0 < 4; ++d0) { const float v = o[d0][r] * a0 + M[(d0 * 16 + r) * 64 + lane] * a1; if (qi < nq) op[32 * d0] = (bf16)f2bf(v); } }
    }
    __syncthreads();
}

struct RetItem { int kind, bh, n; };
__device__ __forceinline__ void ret_geom(const RetItem& it, int& h, int& rowbase, int& tlo, int& thi, int& T) {
    if (it.kind == 0) { h = it.bh; rowbase = -48; tlo = 48; thi = 64; T = 64; }
    else if (it.kind == 1) { h = it.bh & 3; rowbase = R_PROMPT + (it.bh >> 2) * SEQ + 64 * (it.n - 1); tlo = 0; thi = 64; T = 64; }
    else { h = it.bh & 3; rowbase = R_SAMPLE + TS * (it.bh >> 2); tlo = 0; thi = TS; T = TS; }
}
__device__ __forceinline__ int kvn_index(const RetItem& it) { return it.kind == 0 ? it.bh : 4 + it.bh * 64 + (it.n - 1); }
__device__ __forceinline__ RetItem ret_item(int i) {
    if (i < 4) return RetItem{0, i, 0};
    if (i < 1028) { const int j = i - 4; return RetItem{1, j >> 6, (j & 63) + 1}; }
    return RetItem{2, i - 1028, 0};
}
constexpr int NRET = 4 + NB * 4 * 64 + DBS * 4;
template <bool DEC> __device__ __forceinline__ void ret_stage(LAS unsigned char* T_, const bf16* X, int rowbase, int h, int tlo, int thi, float lg2, int T, int tid) {
    const int ch = tid & 15;
#pragma unroll
    for (int i = 0; i < 2; ++i) {
        const int t = (tid >> 4) + 32 * i; v4u v = {0u, 0u, 0u, 0u};
        if (t >= tlo && t < thi) {
            v = *(const v4u*)(X + (size_t)(rowbase + t) * 512 + h * 128 + ch * 8);
            if (DEC) { const float d = __builtin_amdgcn_exp2f(lg2 * (float)(T - 1 - t));
                v.x = pk2(bflo(v.x) * d, bfhi(v.x) * d); v.y = pk2(bflo(v.y) * d, bfhi(v.y) * d); v.z = pk2(bflo(v.z) * d, bfhi(v.z) * d); v.w = pk2(bflo(v.w) * d, bfhi(v.w) * d); }
        }
        *(LAS v4u*)(T_ + offb(t, ch)) = v;
    }
}
__device__ __forceinline__ void ret_kv_item(const Args& a, LAS unsigned char* L, const RetItem& it, int tid) {
    asm volatile("" : "+v"(tid));
    unsigned char* ws = a.ws;
    const bf16* KR = (const bf16*)(ws + WS_KR); const bf16* VR = (const bf16*)(ws + WS_VR); bf16* KVN = (bf16*)(ws + WS_KVN);
    int h, rowbase, tlo, thi, T; ret_geom(it, h, rowbase, tlo, thi, T);
    const float lg2 = lg2gamma(h); const int lane = tid & 63, w = __builtin_amdgcn_readfirstlane(tid >> 6), r32 = lane & 31, hi = lane >> 5, ib = w >> 1, jb0 = 2 * (w & 1);
    LAS unsigned char* TK = L; LAS unsigned char* TV = L + 16384;
    ret_stage<false>(TK, KR, rowbase, h, tlo, thi, lg2, T, tid);
    ret_stage<true>(TV, VR, rowbase, h, tlo, thi, lg2, T, tid);
    __syncthreads();
    f32x16 c0, c1;
#pragma unroll
    for (int r = 0; r < 16; ++r) { c0[r] = 0.f; c1[r] = 0.f; }
#pragma unroll
    for (int ks = 0; ks < 4; ++ks) {
        const bf16x8 af = trfrag(TK, lane, ib, ks), b0 = trfrag(TV, lane, jb0, ks), b1 = trfrag(TV, lane, jb0 + 1, ks);
        c0 = __builtin_amdgcn_mfma_f32_32x32x16_bf16(af, b0, c0, 0, 0, 0);
        c1 = __builtin_amdgcn_mfma_f32_32x32x16_bf16(af, b1, c1, 0, 0, 0);
    }
    if (it.kind != 2) {
        bf16* dst = KVN + (size_t)kvn_index(it) * 16384;
#pragma unroll
        for (int rg = 0; rg < 4; ++rg) { const int dk0 = 32 * ib + 8 * rg + 4 * hi;
            v2u w0; w0.x = pk2(c0[4 * rg], c0[4 * rg + 1]); w0.y = pk2(c0[4 * rg + 2], c0[4 * rg + 3]);
            v2u w1; w1.x = pk2(c1[4 * rg], c1[4 * rg + 1]); w1.y = pk2(c1[4 * rg + 2], c1[4 * rg + 3]);
            *(v2u*)(dst + (size_t)(32 * jb0 + r32) * 128 + dk0) = w0; *(v2u*)(dst + (size_t)(32 * (jb0 + 1) + r32) * 128 + dk0) = w1; }
    } else {
        const float dec = __builtin_amdgcn_exp2f(lg2 * (float)T);
        const float* s0 = a.in[4] + (size_t)it.bh * 16384; float* so = a.out + O_SST + (size_t)it.bh * 16384;
#pragma unroll
        for (int r = 0; r < 16; ++r) { const size_t e = (size_t)(32 * ib + crow(r, hi)) * 128 + 32 * jb0 + r32;
            so[e] = dec * s0[e] + c0[r]; so[e + 32] = dec * s0[e + 32] + c1[r]; }
    }
    __syncthreads();
}
__device__ __forceinline__ void ret_out_item(const Args& a, LAS unsigned char* L, const RetItem& it, int tid) {
    asm volatile("" : "+v"(tid));
    unsigned char* ws = a.ws;
    const bf16* QR = (const bf16*)(ws + WS_QR); const bf16* KR = (const bf16*)(ws + WS_KR); const bf16* VR = (const bf16*)(ws + WS_VR); const bf16* GS = (const bf16*)(ws + WS_GS);
    const bf16* KVN = (const bf16*)(ws + WS_KVN); bf16* MIXA = (bf16*)(ws + WS_A16A);
    int h, rowbase, tlo, thi, T; ret_geom(it, h, rowbase, tlo, thi, T);
    const float lg2 = lg2gamma(h); const int lane = tid & 63, w = __builtin_amdgcn_readfirstlane(tid >> 6), r32 = lane & 31, hi = lane >> 5, qhalf = w & 1, cb = w >> 1;
    LAS unsigned char* TQ = L; LAS unsigned char* TK = L + 16384; LAS unsigned char* TV = L + 32768; LAS unsigned char* TS_ = L + 49152;
    LAS float* ST = (LAS float*)(L + 81920);
    ret_stage<false>(TQ, QR, rowbase, h, tlo, thi, lg2, T, tid);
    ret_stage<false>(TK, KR, rowbase, h, tlo, thi, lg2, T, tid);
    ret_stage<false>(TV, VR, rowbase, h, tlo, thi, lg2, T, tid);
    if (it.kind == 1) {
        const bf16* st = KVN + (size_t)kvn_index(it) * 16384;
#pragma unroll
        for (int i = 0; i < 4; ++i) { const int dv = (tid >> 4) + 32 * i, ch = tid & 15; *(LAS v4u*)(TS_ + offb(dv, ch)) = *(const v4u*)(st + (size_t)dv * 128 + ch * 8); }
    } else if (it.kind == 2) {
        const float* s0 = a.in[4] + (size_t)it.bh * 16384;
        for (int e = tid; e < 16384; e += 512) { const int dk = e >> 7, dv = e & 127; *(LAS unsigned short*)(TS_ + offb(dv, dk >> 3) + 2 * (dk & 7)) = (unsigned short)f2bf(s0[e]); }
    }
    __syncthreads();
    f32x16 o;
#pragma unroll
    for (int r = 0; r < 16; ++r) o[r] = 0.f;
    bf16x8 qr[8];
#pragma unroll
    for (int d0 = 0; d0 < 8; ++d0) qr[d0] = rowfrag(TQ, 32 * qhalf, lane, d0);
    if (it.kind != 0) {
#pragma unroll
        for (int kd = 0; kd < 8; ++kd) o = __builtin_amdgcn_mfma_f32_32x32x16_bf16(qr[kd], rowfrag(TS_, 32 * cb, lane, kd), o, 0, 0, 0);
#pragma unroll
        for (int r = 0; r < 16; ++r) o[r] *= __builtin_amdgcn_exp2f(lg2 * (float)(32 * qhalf + crow(r, hi) + 1));
    }
    f32x16 p0, p1;
#pragma unroll
    for (int r = 0; r < 16; ++r) { p0[r] = 0.f; p1[r] = 0.f; }
#pragma unroll
    for (int d0 = 0; d0 < 8; ++d0) {
        p0 = __builtin_amdgcn_mfma_f32_32x32x16_bf16(rowfrag(TK, 0, lane, d0), qr[d0], p0, 0, 0, 0);
        p1 = __builtin_amdgcn_mfma_f32_32x32x16_bf16(rowfrag(TK, 32, lane, d0), qr[d0], p1, 0, 0, 0);
    }
    const int tq = 32 * qhalf + r32;
#pragma unroll
    for (int r = 0; r < 16; ++r) { const int k0 = crow(r, hi), k1 = k0 + 32;
        p0[r] = tq >= k0 ? p0[r] * __builtin_amdgcn_exp2f(lg2 * (float)(tq - k0)) : 0.f;
        p1[r] = tq >= k1 ? p1[r] * __builtin_amdgcn_exp2f(lg2 * (float)(tq - k1)) : 0.f; }
    bf16x8 pa0, pa1, pa2, pa3;
    PK4(p0, 0, pa0); PK4(p0, 8, pa1); PK4(p1, 0, pa2); PK4(p1, 8, pa3);
    o = __builtin_amdgcn_mfma_f32_32x32x16_bf16(pa0, trfrag(TV, lane, cb, 0), o, 0, 0, 0);
    o = __builtin_amdgcn_mfma_f32_32x32x16_bf16(pa1, trfrag(TV, lane, cb, 1), o, 0, 0, 0);
    o = __builtin_amdgcn_mfma_f32_32x32x16_bf16(pa2, trfrag(TV, lane, cb, 2), o, 0, 0, 0);
    o = __builtin_amdgcn_mfma_f32_32x32x16_bf16(pa3, trfrag(TV, lane, cb, 3), o, 0, 0, 0);
#pragma unroll
    for (int r = 0; r < 16; ++r) {
        float s = o[r], q = o[r] * o[r];
#pragma unroll
        for (int off = 1; off < 32; off <<= 1) { s += __shfl_xor(s, off); q += __shfl_xor(q, off); }
        if (r32 == 0) { const int row = 32 * qhalf + crow(r, hi); ST[(row * 4 + cb) * 2] = s; ST[(row * 4 + cb) * 2 + 1] = q; }
    }
    __syncthreads();
    const float gain = a.in[11][h * 128 + 32 * cb + r32];
#pragma unroll
    for (int r = 0; r < 16; ++r) {
        const int t = 32 * qhalf + crow(r, hi);
        const LAS f32x4* sp = (const LAS f32x4*)(ST + t * 8);
        const f32x4 u0 = sp[0], u1 = sp[1];
        const float mean = ((u0.x + u0.z) + (u1.x + u1.z)) * (1.f / 128), var = fmaxf(((u0.y + u0.w) + (u1.y + u1.w)) * (1.f / 128) - mean * mean, 0.f);
        const float rstd = 1.0f / sqrtf(var + LN_EPS);
        if (t >= tlo && t < thi) { const size_t rb = (size_t)(rowbase + t); const int col = h * 128 + 32 * cb + r32;
            MIXA[rb * DM + col] = (bf16)f2bf((o[r] - mean) * rstd * gain * bf2f(GS[rb * 512 + col])); }
    }
    __syncthreads();
}


__device__ __forceinline__ void ret_scan(const Args& a, int gtid, int gthreads) {
    unsigned* KVN = (unsigned*)(a.ws + WS_KVN);
    for (int g = gtid; g < NB * 4 * 8192; g += gthreads) {
        const int bh = g >> 13, e2 = g & 8191, h = bh & 3;
        const float dec = __builtin_amdgcn_exp2f(lg2gamma(h) * 64.f);
        const unsigned w0 = KVN[(size_t)h * 8192 + e2];
        float s0 = bflo(w0), s1 = bfhi(w0);
        unsigned* p = KVN + (size_t)(4 + bh * 64) * 8192 + e2;
#pragma unroll 16
        for (int n = 0; n < 64; ++n) { const unsigned kv = p[(size_t)n * 8192]; p[(size_t)n * 8192] = pk2(s0, s1); s0 = dec * s0 + bflo(kv); s1 = dec * s1 + bfhi(kv); }
        const int dv = e2 >> 6, dk = (e2 & 63) * 2;
        float* so = a.out + O_PST + (size_t)bh * 16384;
        so[(size_t)dk * 128 + dv] = s0; so[(size_t)(dk + 1) * 128 + dv] = s1;
    }
}


#ifndef PROBE_DUP
#define PROBE_DUP -1
#endif
#define REPS(k) for (int rep_ = 0; rep_ < ((PROBE_DUP == (k)) ? 2 : 1); ++rep_)
constexpr int NWAVES = 8, RING_BYTES = 147456  , LDS_BYTES = RING_BYTES + 1024, MISC_OFF = RING_BYTES + 320;

__global__ void __launch_bounds__(NWAVES * 64, 2) fwd_mega(Args a) {
    extern __shared__ __attribute__((aligned(16))) unsigned char lds[];
    LAS unsigned char* L = (LAS unsigned char*)lds;
    volatile LAS unsigned* MISC = (volatile LAS unsigned*)(L + MISC_OFF);
    int tid = threadIdx.x, lane = tid & 63, wave = __builtin_amdgcn_readfirstlane(tid >> 6);
    const int G = gridDim.x, bx = blockIdx.x;
    const int vcu = (G % 8 == 0) ? (bx % 8) * (G / 8) + bx / 8 : bx;
    int gw = vcu * NWAVES + wave, gtid = vcu * (NWAVES * 64) + tid; const int NGW = G * NWAVES, gthreads = G * NWAVES * 64;
#define PHASE_BEGIN() do { tid = threadIdx.x; asm volatile("" : "+v"(tid)); lane = tid & 63; wave = __builtin_amdgcn_readfirstlane(tid >> 6); gw = vcu * NWAVES + wave; gtid = vcu * (NWAVES * 64) + tid; } while (0)
    unsigned char* ws = a.ws;
    for (int u = tid; u < (LDS_BYTES - RING_BYTES) / 4; u += NWAVES * 64) ((LAS unsigned*)(L + RING_BYTES))[u] = 0u;
    __syncthreads();
    XcdBarrier bar = xcd_barrier_post((unsigned*)(ws + WS_CTL) + CW_BAR, MISC + 8);
#define GRID_BAR() do { xcd_barrier(bar); PHASE_BEGIN(); } while (0)
#define SCR ((LAS float*)(L + wave * 16384))

    bf16* WFI = (bf16*)(ws + WS_WFI); bf16* WFO = (bf16*)(ws + WS_WFO); bf16* WMI = (bf16*)(ws + WS_WMI); bf16* WMO = (bf16*)(ws + WS_WMO); bf16* WUQ = (bf16*)(ws + WS_WUQ);
    f32x2* R128 = (f32x2*)(ws + WS_R128); f32x2* R64 = (f32x2*)(ws + WS_R64);
    bf16* A16A = (bf16*)(ws + WS_A16A); bf16* A16B = (bf16*)(ws + WS_A16B); float* Z = (float*)(ws + WS_Z); bf16* HID = (bf16*)(ws + WS_HID);

    REPS(0) {
        REPS(100) {
        transpose_matrix(a.in[6], DM, 2 * FF, WFI, 2 * FF, DM, 0, 0, SCR, gw, NGW, lane);
        transpose_matrix(a.in[7], FF, DM, WFO, DM, FF, 0, 1, SCR, gw, NGW, lane);
        transpose_matrix(a.in[10], DM, DIN, WMI, DINP, DM, 0, 2, SCR, gw, NGW, lane);
        transpose_matrix(a.in[16], 512, DM, WMO, DM, DM, 0, 1, SCR, gw, NGW, lane);
        transpose_matrix(a.in[13], 256, NQA, WUQ, 256, 256, 512, 3, SCR, gw, NGW, lane);
        }
        REPS(101) {
        const float* wuq = a.in[13]; const float* wukv = a.in[15]; const float* wmo = a.in[16];
        for (int idx = gtid; idx < 512 * 256; idx += gthreads) {
            const int k = idx & 255, np = idx >> 8, head = np >> 7, c = np & 127;
            const f32x4* x = (const f32x4*)(wuq + (size_t)k * NQA + head * KVW); const f32x4* y = (const f32x4*)(wukv + (size_t)c * 1024 + head * 256);
            float s = 0.f;
#pragma unroll 8
            for (int n = 0; n < 32; ++n) { const f32x4 xv = x[n], yv = y[n]; s += (xv.x * yv.x + xv.y * yv.y) + (xv.z * yv.z + xv.w * yv.w); }
            WUQ[(size_t)np * 256 + k] = (bf16)f2bf(s);
        }
        for (int idx = gtid; idx < 1024 * 64; idx += gthreads) {
            const int n = idx & 1023, hc = idx >> 10, head = hc >> 4, c8 = hc & 15;
            float s[8];
#pragma unroll
            for (int j = 0; j < 8; ++j) s[j] = 0.f;
            const float* wm = wmo + (size_t)(512 + head * 128) * DM + n; const float* uk = wukv + (size_t)(c8 * 8) * 1024 + head * 256 + 128;
#pragma unroll 2
            for (int v = 0; v < 128; v += 4) {
                float m[4];
#pragma unroll
                for (int q = 0; q < 4; ++q) m[q] = wm[(size_t)(v + q) * DM];
#pragma unroll
                for (int j = 0; j < 8; ++j) { const f32x4 u = *(const f32x4*)(uk + (size_t)j * 1024 + v); s[j] += (u.x * m[0] + u.y * m[1]) + (u.z * m[2] + u.w * m[3]); } }
            v4u w; w.x = pk2(s[0], s[1]); w.y = pk2(s[2], s[3]); w.z = pk2(s[4], s[5]); w.w = pk2(s[6], s[7]);
            *(v4u*)(WMO + (size_t)n * DM + 512 + head * 128 + c8 * 8) = w;
        }
        }
        REPS(102) {
        for (int idx = gtid; idx < LP * 64; idx += gthreads) {
            const int pos = idx >> 6, i = idx & 63;
            const float inv = (float)exp2(-(double)(2 * i) * (13.287712379549449 / 128.0));
            float sn, cs; sincos_acc((float)pos * inv, sn, cs);
            R128[idx] = (f32x2){cs, sn};
            if ((i & 1) == 0) R64[(size_t)pos * 32 + (i >> 1)] = (f32x2){cs, sn};
        }
        }
        REPS(103) {
        for (int r = gw; r < MTOT; r += NGW) {
            const float* xr = x_row(a, r); v2u* o = (v2u*)(A16A + (size_t)r * DM) + lane;
#pragma unroll
            for (int j = 0; j < 4; ++j) { v2u w = {0u, 0u}; if (xr) { const f32x4 v = *((const f32x4*)xr + lane + 64 * j); w.x = pk2(v.x, v.y); w.y = pk2(v.z, v.w); } o[64 * j] = w; }
        }
        }
    }
    GRID_BAR();
#ifndef NO_P1
    REPS(1) { pg8::Gemm g{A16A, WFI, MTOT, 2 * FF, DM}; pg8::StaticOrder S; S.init(MTOT, 2 * FF, G, bx, DM); EpiSwiglu E{HID};
      pg8::gemm_phase<EpiSwiglu, pg8::StaticOrder, true, true>(L, g, S, E); }
#endif
    GRID_BAR();
#ifndef NO_P2
    REPS(2) { pg8::Gemm g{HID, WFO, MTOT, DM, FF}; pg8::SplitOrder S; S.init(MAIN_ROWS, MTOT, DM, G, bx, FF, 11); EpiResZ<0> E{Z, nullptr, a, 0.5f};
      pg8::gemm_phase<EpiResZ<0>, pg8::SplitOrder, true, true>(L, g, S, E, (float*)A16A); }
#endif
    GRID_BAR();
    REPS(3) ln_rows<false, 0, 11>(a, Z, a.in[8], a.in[9], A16B, (const float*)A16A, nullptr, 0.5f, gw, NGW, lane);
    GRID_BAR();
#ifndef NO_P4
    REPS(4) { pg8::Gemm g{A16B, WMI, MTOT, DINP, DM}; pg8::StaticOrder S; S.init(MTOT, DINP, G, bx, DM);
      EpiMixIn E{(bf16*)(ws + WS_QR), (bf16*)(ws + WS_KR), (bf16*)(ws + WS_VR), (bf16*)(ws + WS_GS), (float*)(ws + WS_P2RAW), R128};
      pg8::gemm_phase<EpiMixIn, pg8::StaticOrder, true, true>(L, g, S, E); }
#endif
    GRID_BAR();
    REPS(5) { post_rows(a, gw, NGW, lane);
    transpose_matrix(a.in[19], DM, 2 * FF, WFI, 2 * FF, DM, 0, 0, SCR, gw, NGW, lane);
    transpose_matrix(a.in[20], FF, DM, WFO, DM, FF, 0, 1, SCR, gw, NGW, lane); }
    GRID_BAR();
#ifndef NO_P6
    REPS(6) { int kq = 256; asm volatile("" : "+s"(kq));
      pg8::Gemm g{(const bf16*)(ws + WS_CQB), WUQ, MTOT, NQA, kq}; pg8::StaticOrder S; S.init(MTOT, NQA, G, bx, kq); EpiUq E{(bf16*)(ws + WS_QA), R64};
      pg8::gemm_phase<EpiUq, pg8::StaticOrder, true, true>(L, g, S, E); }
#endif
    GRID_BAR();
    {
        REPS(70) for (int i = vcu; i < NRET; i += G) ret_kv_item(a, L, ret_item(i), tid);
        {
            unsigned* qctr = (unsigned*)(ws + WS_CTL) + CW_ATTQ;
            for (;;) {
                if (tid == 0) MISC[16] = __hip_atomic_fetch_add(qctr, 1u, __ATOMIC_RELAXED, __HIP_MEMORY_SCOPE_AGENT);
                __syncthreads();
                const int idx = (int)MISC[16];
                if (idx >= 529) break;
                int type, bi, cc, qh;
                if (idx < 392) { type = 0; cc = 63 - (idx >> 3); bi = idx & 3; qh = (idx >> 2) & 1; }
                else if (idx < 408) { type = 1; bi = idx - 392; cc = 0; qh = 0; }
                else if (idx < 528) { const int j = idx - 408; type = 0; cc = 14 - (j >> 3); bi = j & 3; qh = (j >> 2) & 1; }
                else { type = 2; bi = 0; cc = 0; qh = 0; }
                attn_unit(a, L, type, bi, cc, qh, tid);
            }
        }
    }
    GRID_BAR();
    ret_scan(a, gtid, gthreads);
    GRID_BAR();
    REPS(9) for (int i = vcu; i < NRET; i += G) ret_out_item(a, L, ret_item(i), tid);
    GRID_BAR();
#ifndef NO_P10
    REPS(10) { pg8::Gemm g{A16A, WMO, MTOT, DM, DM}; pg8::SplitOrder S; S.init(MAIN_ROWS, MTOT, DM, G, bx, DM, 4); EpiResZ<1> E{Z, A16B, a, 1.0f};
      pg8::gemm_phase<EpiResZ<1>, pg8::SplitOrder, true, true>(L, g, S, E, (float*)HID); }
#endif
    GRID_BAR();
    ln_rows<false, 1, 4>(a, Z, a.in[17], a.in[18], A16B, (const float*)HID, A16B, 1.0f, gw, NGW, lane);
    GRID_BAR();
#ifndef NO_P12
    REPS(12) { pg8::Gemm g{A16B, WFI, MTOT, 2 * FF, DM}; pg8::StaticOrder S; S.init(MTOT, 2 * FF, G, bx, DM); EpiSwiglu E{HID};
      pg8::gemm_phase<EpiSwiglu, pg8::StaticOrder, true, true>(L, g, S, E); }
#endif
    GRID_BAR();
#ifndef NO_P13
    REPS(13) { pg8::Gemm g{HID, WFO, MTOT, DM, FF}; pg8::SplitOrder S; S.init(MAIN_ROWS, MTOT, DM, G, bx, FF, 11); EpiResZ<1> E{Z, A16B, a, 0.5f};
      pg8::gemm_phase<EpiResZ<1>, pg8::SplitOrder, true, true>(L, g, S, E, (float*)A16A); }
#endif
    GRID_BAR();
    ln_rows<true, 1, 11>(a, Z, a.in[21], a.in[22], nullptr, (const float*)A16A, A16B, 0.5f, gw, NGW, lane);
#undef GRID_BAR
}

extern "C" void kernel_launch(void* const* d_in, const int* in_sizes, int n_in, void* d_out, int out_size, void* d_ws, size_t ws_size, hipStream_t stream) {
    static int grid = 0;
    if (grid == 0) {
        if (n_in != 23 || out_size != (int)O_END || ws_size < WS_END) { fprintf(stderr, "kernel_launch: unexpected shapes (n_in %d, out %d, ws %zu; need 23, %zu, >= %zu)\n", n_in, out_size, ws_size, (size_t)O_END, (size_t)WS_END); grid = -1; return; }
        int dev = 0, cus = 0, per_cu = 0;
        if (hipGetDevice(&dev) != hipSuccess || hipDeviceGetAttribute(&cus, hipDeviceAttributeMultiprocessorCount, dev) != hipSuccess) { grid = -1; return; }
        if (hipFuncSetAttribute((const void*)fwd_mega, hipFuncAttributeMaxDynamicSharedMemorySize, LDS_BYTES) != hipSuccess) { fprintf(stderr, "kernel_launch: hipFuncSetAttribute failed\n"); grid = -1; return; }
        if (hipOccupancyMaxActiveBlocksPerMultiprocessor(&per_cu, (const void*)fwd_mega, NWAVES * 64, LDS_BYTES) != hipSuccess || per_cu < 1) { fprintf(stderr, "kernel_launch: occupancy query says %d blocks per CU\n", per_cu); per_cu = 1; }
        (void)hipGetLastError();
        grid = cus;
    }
    if (grid < 0) return;
    (void)hipMemsetAsync((char*)d_ws + WS_CTL, 0, CTL_BYTES, stream);
    Args a{};
    for (int i = 0; i < 23; ++i) a.in[i] = (const float*)d_in[i];
    a.out = (float*)d_out; a.ws = (unsigned char*)d_ws;
    void* args[] = {&a};
    hipError_t e = hipLaunchCooperativeKernel((const void*)fwd_mega, dim3(grid), dim3(NWAVES * 64), args, LDS_BYTES, stream);
    if (e != hipSuccess) fprintf(stderr, "kernel_launch: cooperative launch failed: %s (grid %d)\n", hipGetErrorString(e), grid);
}
```

```cpp
#include <hip/hip_runtime.h>
#include <hip/hip_cooperative_groups.h>
#include <cstdio>
#include <cstdint>

namespace pg8 {
#define PG8_LAS __attribute__((address_space(3)))
typedef unsigned short bf16_t;
typedef short bf16x8 __attribute__((ext_vector_type(8)));
typedef float f32x4 __attribute__((ext_vector_type(4)));
typedef unsigned u32x4 __attribute__((ext_vector_type(4)));
constexpr int BM = 256, BK = 64, HALF = 128, HTB = HALF * BK * 2  , STAGE_BYTES = 8 * HTB, NXCD = 8, WGM = 8;

__host__ __device__ __forceinline__ int lds_byte(int r, int c) { const int st = (r >> 4) * 2 + (c >> 5), rr = r & 15, cc = c & 31, ob = rr * 64 + cc * 2; return st * 1024 + (ob ^ (((ob >> 9) & 1) << 5)); }
__host__ __device__ __forceinline__ void stage_rc(int b, int& R, int& C) { const int st = b / 1024, sb = b % 1024, swz = sb ^ (((sb >> 9) & 1) << 5); R = (st >> 1) * 16 + swz / 64; C = (st & 1) * 32 + (swz % 64) / 2; }
__host__ __device__ __forceinline__ int perm32(int rho) { const int n = rho >> 4, i = rho & 15; return 8 * (i >> 2) + 4 * n + (i & 3); }

struct Unit { int pm, pn, kt0, nkt, slab; };
struct SplitOrder;
struct Gemm { const bf16_t* A; const bf16_t* Bt; int M, N, K; };

struct StaticOrder {
    int nM, nN, nwg, G, c, nkt;
    __host__ __device__ void init(int M, int N, int G_, int c_, int K_) { nM = M / BM; nN = N / BM; nwg = nM * nN; G = G_; c = c_; nkt = K_ / BK; }
    __host__ __device__ bool next(int i, Unit& u) const {
        const long L = (long)i * G + c; if (L >= nwg) return false;
        int wgid = (int)L; { const int q = nwg / NXCD, r = nwg % NXCD, xcd = wgid % NXCD, off = wgid / NXCD; wgid = (xcd < r ? xcd * (q + 1) : r * (q + 1) + (xcd - r) * q) + off; }
        const int nig = WGM * nN, gid = wgid / nig, fm = gid * WGM, gsz = (nM - fm) < WGM ? (nM - fm) : WGM;
        u.pm = fm + ((wgid % nig) % gsz); u.pn = (wgid % nig) / gsz; u.kt0 = 0; u.nkt = nkt; u.slab = -1; return true;
    }
    __device__ __forceinline__ void a_ready(const Unit&) const {}
    __device__ __forceinline__ void done(const Unit&) const {}
};
struct SplitOrder {
    StaticOrder main; int nMain, nN, spu, kts, nslice, c;
    __host__ __device__ void init(int Mmain, int Mtot, int N, int G_, int c_, int K_, int spu_) { main.init(Mmain, N, G_, c_, K_); nMain = Mmain / BM; nN = N / BM; spu = spu_; kts = (K_ / BK) / spu_; nslice = (Mtot / BM - nMain) * nN * spu_; c = c_; }
    __host__ __device__ bool next(int i, Unit& u) const {
        if (i == 0) return main.next(0, u);
        if (i > 1 || c >= nslice) return false;
        const int e = c / spu, s = c % spu; u.pm = nMain + e / nN; u.pn = e % nN; u.kt0 = s * kts; u.nkt = kts; u.slab = c; return true;
    }
    __device__ __forceinline__ void a_ready(const Unit&) const {}
    __device__ __forceinline__ void done(const Unit&) const {}
};


__device__ __forceinline__ unsigned cvt_pk_bf16(float lo, float hi) { unsigned r; asm volatile("v_cvt_pk_bf16_f32 %0, %1, %2" : "=v"(r) : "v"(lo), "v"(hi)); return r; }
typedef float f32x2 __attribute__((ext_vector_type(2)));

template <class Epi, class Sched, bool ALIGN_EPI = false, bool SP2 = false>
__device__ __forceinline__ void gemm_phase(PG8_LAS unsigned char* lds, const Gemm g, const Sched& S, const Epi& E, float* slabs = nullptr) {
    int tid_ = threadIdx.x; asm volatile("" : "+v"(tid_));
    const int tid = tid_, wid = __builtin_amdgcn_readfirstlane(tid >> 6), lane = tid & 63, wr = wid >> 2, wc = wid & 3, fr = lane & 15, fq = lane >> 4;
    const int K = g.K;
    unsigned voffA[2], voffB[2];
#pragma unroll
    for (int i = 0; i < 2; ++i) { int R, C; stage_rc(tid * 16 + i * 8192, R, C); const int Rb = Epi::PERM ? ((R & ~31) + perm32(R & 31)) : R;
        voffA[i] = (unsigned)(R * K + C) * 2u; voffB[i] = (unsigned)(Rb * K + C) * 2u; }
    const size_t kstep = (size_t)(BK * 2);
    const size_t hstep = (size_t)HALF * K * 2;
    const size_t tstep = 2 * hstep;
    const unsigned ldsw = (unsigned)wid * 1024u;
    const int aoff = lds_byte(wr * 64 + fr, fq * 8), boff = lds_byte(wc * 32 + fr, fq * 8);
#define PG8_SA(b, h) (((b) * 2 + (h)) * HTB)
#define PG8_SB(b, h) ((4 + (b) * 2 + (h)) * HTB)
#define PG8_STAGE(bufoff, gbase, voff) do { _Pragma("unroll") for (int _i = 0; _i < 2; ++_i) \
        __builtin_amdgcn_global_load_lds((const unsigned*)((const char*)(gbase) + (voff)[_i]), (PG8_LAS unsigned*)(lds + (bufoff) + ldsw + _i * 8192), 16, 0, 0); } while (0)
#define PG8_LDA(dst, b, h) do { _Pragma("unroll") for (int m = 0; m < 4; ++m) _Pragma("unroll") for (int k = 0; k < 2; ++k) dst[m][k] = *(const PG8_LAS bf16x8*)(lds + PG8_SA(b, h) + aoff + m * 2048 + k * 1024); } while (0)
#define PG8_LDB(dst, b, h) do { _Pragma("unroll") for (int n = 0; n < 2; ++n) _Pragma("unroll") for (int k = 0; k < 2; ++k) dst[n][k] = *(const PG8_LAS bf16x8*)(lds + PG8_SB(b, h) + boff + n * 2048 + k * 1024); } while (0)
#define PG8_MMA(ai, bj, At, Bt) do { __builtin_amdgcn_s_setprio(1); _Pragma("unroll") for (int m = 0; m < 4; ++m) _Pragma("unroll") for (int n = 0; n < 2; ++n) _Pragma("unroll") for (int k = 0; k < 2; ++k) \
        acc[ai][bj][m][n] = __builtin_amdgcn_mfma_f32_16x16x32_bf16(Bt[n][k], At[m][k], acc[ai][bj][m][n], 0, 0, 0); __builtin_amdgcn_s_setprio(0); } while (0)
#define PG8_WAIT_V(n) asm volatile("s_waitcnt vmcnt(" #n ")" ::: "memory")
#define PG8_WAIT_L(n) asm volatile("s_waitcnt lgkmcnt(" #n ")" ::: "memory")
#define PG8_BAR __builtin_amdgcn_s_barrier()
#define PG8_SCHED __builtin_amdgcn_sched_barrier(0)
    Unit cur, nxt; int ui = 0;
    if (!S.next(0, cur)) return;
    f32x4 acc[2][2][4][2];
#pragma unroll
    for (int a = 0; a < 2; ++a)
#pragma unroll
        for (int b = 0; b < 2; ++b)
#pragma unroll
            for (int m = 0; m < 4; ++m)
#pragma unroll
                for (int n = 0; n < 2; ++n) acc[a][b][m][n] = (f32x4){0.f, 0.f, 0.f, 0.f};
    bf16x8 At[4][2], B0[2][2], B1[2][2];
    const char* cA = (const char*)g.A + (size_t)cur.pm * tstep + (size_t)cur.kt0 * kstep; const char* cB = (const char*)g.Bt + (size_t)cur.pn * tstep + (size_t)cur.kt0 * kstep;
    S.a_ready(cur);
    if constexpr (SP2) {
        PG8_STAGE(PG8_SB(0, 0), cB, voffB); PG8_STAGE(PG8_SB(0, 1), cB + hstep, voffB); PG8_STAGE(PG8_SA(0, 0), cA, voffA); PG8_STAGE(PG8_SA(0, 1), cA + hstep, voffA);
        if (wr == 1) PG8_BAR;
        PG8_WAIT_V(2); PG8_BAR;
        PG8_STAGE(PG8_SB(1, 0), cB + kstep, voffB); PG8_STAGE(PG8_SA(1, 0), cA + kstep, voffA); PG8_STAGE(PG8_SB(1, 1), cB + hstep + kstep, voffB);
        PG8_WAIT_V(6); PG8_BAR;
    } else {
        PG8_STAGE(PG8_SB(0, 0), cB, voffB); PG8_STAGE(PG8_SA(0, 0), cA, voffA); PG8_STAGE(PG8_SB(0, 1), cB + hstep, voffB); PG8_STAGE(PG8_SA(0, 1), cA + hstep, voffA);
        if (wr == 1) PG8_BAR;
        PG8_WAIT_V(4); PG8_BAR;
        PG8_STAGE(PG8_SB(1, 0), cB + kstep, voffB); PG8_STAGE(PG8_SA(1, 0), cA + kstep, voffA); PG8_STAGE(PG8_SB(1, 1), cB + hstep + kstep, voffB);
        PG8_WAIT_V(6); PG8_BAR;
    }
    for (;;) {
        const bool has_next = S.next(ui + 1, nxt);
        const char* nA = has_next ? (const char*)g.A + (size_t)nxt.pm * tstep + (size_t)nxt.kt0 * kstep : cA; const char* nB = has_next ? (const char*)g.Bt + (size_t)nxt.pn * tstep + (size_t)nxt.kt0 * kstep : cB;
        const int nt = cur.nkt;
        for (int t = 0; t < nt; t += 2) {
            const bool last = (t == nt - 2);
            const char* a1 = cA + (size_t)(t + 1) * kstep;
            const char* a2 = last ? nA : cA + (size_t)(t + 2) * kstep; const char* b2 = last ? nB : cB + (size_t)(t + 2) * kstep;
            const char* a3 = a2 + kstep; const char* b3 = b2 + kstep;
            if (last && has_next) S.a_ready(nxt);
            if constexpr (SP2) {
            PG8_LDB(B0, 0, 0); PG8_LDB(B1, 0, 1); PG8_SCHED; PG8_LDA(At, 0, 0); PG8_STAGE(PG8_SA(1, 1), a1 + hstep, voffA);
            PG8_WAIT_V(8); PG8_WAIT_L(0); PG8_BAR; PG8_MMA(0, 0, At, B0); PG8_MMA(0, 1, At, B1); PG8_BAR; PG8_SCHED;
            PG8_LDA(At, 0, 1); PG8_STAGE(PG8_SB(0, 0), b2, voffB); PG8_STAGE(PG8_SB(0, 1), b2 + hstep, voffB); PG8_STAGE(PG8_SA(0, 0), a2, voffA);
            PG8_WAIT_V(8); PG8_WAIT_L(0); PG8_BAR; PG8_MMA(1, 0, At, B0); PG8_MMA(1, 1, At, B1); PG8_BAR; PG8_SCHED;
            PG8_LDB(B0, 1, 0); PG8_LDB(B1, 1, 1); PG8_SCHED; PG8_LDA(At, 1, 0); PG8_STAGE(PG8_SA(0, 1), a2 + hstep, voffA);
            PG8_WAIT_V(8); PG8_WAIT_L(0); PG8_BAR; PG8_MMA(0, 0, At, B0); PG8_MMA(0, 1, At, B1); PG8_BAR; PG8_SCHED;
            PG8_LDA(At, 1, 1); PG8_STAGE(PG8_SB(1, 0), b3, voffB); PG8_STAGE(PG8_SB(1, 1), b3 + hstep, voffB); PG8_STAGE(PG8_SA(1, 0), a3, voffA);
            PG8_WAIT_V(8); PG8_WAIT_L(0); PG8_BAR; PG8_MMA(1, 0, At, B0); PG8_MMA(1, 1, At, B1); PG8_BAR; PG8_SCHED;
            } else {
            PG8_LDB(B0, 0, 0); PG8_SCHED; PG8_LDA(At, 0, 0); PG8_STAGE(PG8_SA(1, 1), a1 + hstep, voffA);
            PG8_WAIT_L(8); PG8_BAR; PG8_WAIT_L(0); PG8_MMA(0, 0, At, B0); PG8_BAR; PG8_SCHED;
            PG8_LDB(B1, 0, 1); PG8_STAGE(PG8_SB(0, 0), b2, voffB);
            PG8_BAR; PG8_WAIT_L(0); PG8_MMA(0, 1, At, B1); PG8_BAR;
            PG8_LDA(At, 0, 1); PG8_STAGE(PG8_SA(0, 0), a2, voffA);
            PG8_BAR; PG8_WAIT_L(0); PG8_MMA(1, 0, At, B0); PG8_BAR; PG8_SCHED;
            PG8_STAGE(PG8_SB(0, 1), b2 + hstep, voffB);
            PG8_WAIT_V(6); PG8_BAR; PG8_MMA(1, 1, At, B1); PG8_BAR;
            PG8_LDB(B0, 1, 0); PG8_SCHED; PG8_LDA(At, 1, 0); PG8_STAGE(PG8_SA(0, 1), a2 + hstep, voffA);
            PG8_WAIT_L(8); PG8_BAR; PG8_WAIT_L(0); PG8_MMA(0, 0, At, B0); PG8_BAR; PG8_SCHED;
            PG8_LDB(B1, 1, 1); PG8_STAGE(PG8_SB(1, 0), b3, voffB);
            PG8_BAR; PG8_WAIT_L(0); PG8_MMA(0, 1, At, B1); PG8_BAR;
            PG8_LDA(At, 1, 1); PG8_STAGE(PG8_SA(1, 0), a3, voffA);
            PG8_BAR; PG8_WAIT_L(0); PG8_MMA(1, 0, At, B0); PG8_BAR; PG8_SCHED;
            PG8_STAGE(PG8_SB(1, 1), b3 + hstep, voffB);
            PG8_WAIT_V(6); PG8_BAR; PG8_MMA(1, 1, At, B1); PG8_BAR;
            }
        }
        if constexpr (ALIGN_EPI) { if (wr == 0) PG8_BAR; }
        if constexpr (!Epi::AFTER_DRAIN) {
            if (cur.slab >= 0) {
                float* sb = slabs + (size_t)cur.slab * 65536 + (size_t)(wr * 64 + fr) * 256 + wc * 32 + 4 * fq;
#pragma unroll
                for (int ai = 0; ai < 2; ++ai)
#pragma unroll
                    for (int m = 0; m < 4; ++m)
#pragma unroll
                        for (int bj = 0; bj < 2; ++bj)
#pragma unroll
                            for (int n = 0; n < 2; ++n) *(f32x4*)(sb + (size_t)(ai * 128 + m * 16) * 256 + bj * 128 + n * 16) = acc[ai][bj][m][n];
            } else E(acc, cur, wr, wc, fr, fq);
            S.done(cur); }
        if (!has_next) break;
#pragma unroll
        for (int a = 0; a < 2; ++a)
#pragma unroll
            for (int b = 0; b < 2; ++b)
#pragma unroll
                for (int m = 0; m < 4; ++m)
#pragma unroll
                    for (int n = 0; n < 2; ++n) acc[a][b][m][n] = (f32x4){0.f, 0.f, 0.f, 0.f};
        cur = nxt; cA = nA; cB = nB; ++ui;
        if constexpr (ALIGN_EPI) { if (wr == 1) PG8_BAR; }
    }
    PG8_WAIT_V(0);
    if constexpr (!ALIGN_EPI) { if (wr == 0) PG8_BAR; }
    PG8_BAR;
    if constexpr (Epi::AFTER_DRAIN) { E.fused(acc, cur, wr, wc, fr, fq, lds, wid, lane); S.done(cur); }
#undef PG8_SA
#undef PG8_SB
#undef PG8_STAGE
#undef PG8_LDA
#undef PG8_LDB
#undef PG8_MMA
#undef PG8_WAIT_V
#undef PG8_WAIT_L
#undef PG8_BAR
#undef PG8_SCHED
}
}

#define LAS __attribute__((address_space(3)))

#define XB_TMO      128
#define XB_XCNT(j)  (256  + 64 * (j))
#define XB_XSUB(j)  (1280 + 64 * (j))
#define XB_XGEN(j)  (2304 + 64 * (j))
#define XB_TOP      3328
#define XB_TOPGEN   3392
#define XCD_BAR_WORDS 3456
#define XB_SPIN_CAP (1u << 18)

__device__ __forceinline__ unsigned xb_ld(unsigned* p)              { return __hip_atomic_load(p, __ATOMIC_RELAXED, __HIP_MEMORY_SCOPE_AGENT); }
__device__ __forceinline__ unsigned xb_add(unsigned* p, unsigned v) { return __hip_atomic_fetch_add(p, v, __ATOMIC_RELAXED, __HIP_MEMORY_SCOPE_AGENT); }
__device__ __forceinline__ unsigned xb_xcc_id() { return (unsigned)__builtin_amdgcn_s_getreg((3 << 11) | 20) & 0xFu; }
#define XB_SPIN(cond, bar) do { unsigned _sp = 0; while (cond) { __builtin_amdgcn_s_sleep(1); \
    if ((++_sp & 255u) == 0u) { if (xb_ld(&(bar)[XB_TMO])) break; if (_sp > XB_SPIN_CAP) { atomicAdd(&(bar)[XB_TMO], 1u); break; } } } } while (0)

struct XcdBarrier {
    unsigned* bar; unsigned x;
    volatile LAS unsigned* st;
};

__device__ __forceinline__ XcdBarrier xcd_barrier_post(unsigned* bar, volatile LAS unsigned* st) {
    XcdBarrier b; b.bar = bar; b.x = xb_xcc_id(); b.st = st;
    if (threadIdx.x == 0) (void)xb_add(&bar[XB_XCNT(b.x)], 1u);
    return b;
}
__device__ __forceinline__ void xcd_barrier_complete(unsigned* bar, unsigned x, unsigned& nloc, unsigned& nx) {
    const unsigned G = gridDim.x * gridDim.y * gridDim.z;
    unsigned sum, cnt, mine, sp = 0u;
    for (;;) {
        sum = 0u; cnt = 0u; mine = 0u;
#pragma unroll
        for (unsigned j = 0; j < 16; ++j) { const unsigned c = xb_ld(&bar[XB_XCNT(j)]); sum += c; cnt += (c > 0u) ? 1u : 0u; mine = (j == x) ? c : mine; }
        if (sum == G) break;
        __builtin_amdgcn_s_sleep(1);
        if ((++sp & 255u) == 0u) { if (xb_ld(&bar[XB_TMO])) break; if (sp > XB_SPIN_CAP) { atomicAdd(&bar[XB_TMO], 1u); break; } }
    }
    nloc = mine > 0u ? mine : 1u; nx = cnt > 0u ? cnt : 1u;
}

__device__ __forceinline__ void xcd_barrier(const XcdBarrier& b) {
    asm volatile("s_waitcnt vmcnt(0)" ::: "memory");
    __syncthreads();
    if (threadIdx.x == 0) {
        unsigned* bar = b.bar;
        __builtin_amdgcn_s_waitcnt(0);
        unsigned nloc = b.st[0], nx = b.st[1];
        if (nloc == 0u) { xcd_barrier_complete(bar, b.x, nloc, nx); b.st[0] = nloc; b.st[1] = nx; }
        const unsigned old = xb_add(&bar[XB_XSUB(b.x)], 1u);
        const unsigned gen = old / nloc;
        if (old + 1u == (gen + 1u) * nloc) {
            __builtin_amdgcn_fence(__ATOMIC_RELEASE, "agent");
            asm volatile("s_waitcnt vmcnt(0)" ::: "memory");
            const unsigned og = xb_add(&bar[XB_TOP], 1u);
            const unsigned tg = og / nx;
            if (og + 1u == (tg + 1u) * nx) xb_add(&bar[XB_TOPGEN], 1u);
            else XB_SPIN(xb_ld(&bar[XB_TOPGEN]) == tg, bar);
            __builtin_amdgcn_fence(__ATOMIC_ACQUIRE, "agent");
            xb_add(&bar[XB_XGEN(b.x)], 1u);
            asm volatile("s_waitcnt vmcnt(0)" ::: "memory");
        } else {
            XB_SPIN(xb_ld(&bar[XB_XGEN(b.x)]) == gen, bar);
            __builtin_amdgcn_fence(__ATOMIC_ACQUIRE, "agent");
            asm volatile("s_waitcnt vmcnt(0)" ::: "memory");
        }
    }
    __syncthreads();
}


#define GAS __attribute__((address_space(1)))

typedef unsigned short bf16;
typedef unsigned v4u __attribute__((ext_vector_type(4)));
typedef unsigned v2u __attribute__((ext_vector_type(2)));
typedef float f32x4 __attribute__((ext_vector_type(4)));
typedef float f32x2 __attribute__((ext_vector_type(2)));
typedef float f32x16 __attribute__((ext_vector_type(16)));
typedef short bf16x8 __attribute__((ext_vector_type(8)));
#define LDS_WAIT() asm volatile("s_waitcnt lgkmcnt(0)" ::: "memory")
#define VM_WAIT() asm volatile("s_waitcnt vmcnt(0)" ::: "memory")

constexpr int DM = 1024, NMETA = 16, SEQ = 4096, NB = 4, DBS = 16, TS = 32, PAST = 1024, FF = 2816, LP = NMETA + SEQ;
constexpr int R_PROMPT = 16, R_SAMPLE = R_PROMPT + NB * SEQ, R_VALID = R_SAMPLE + DBS * TS, MTOT = 17152;
static_assert(R_SAMPLE == 16400 && R_VALID == 16912 && MTOT % 256 == 0 && MTOT >= R_VALID + 64, "row space");
constexpr int DIN = 2496, DINP = 2560, NQA = 768, KVW = 192;
constexpr float DN_ALPHA = 1.189207115002721f, LN_EPS = 1e-5f, RMS_EPS = 1e-6f, LOG2E = 1.4426950408889634f;
constexpr float SM_SCALE = 0.07216878364870322f;
constexpr float KR_SCALE = 0.08838834764831845f;
constexpr size_t O_YP = 0, O_YS = O_YP + (size_t)NB * SEQ * DM, O_PCKV = O_YS + (size_t)DBS * TS * DM, O_PKPE = O_PCKV + (size_t)NB * LP * 128, O_PST = O_PKPE + (size_t)NB * LP * 64,
                 O_SCKV = O_PST + (size_t)NB * 4 * 128 * 128, O_SKPE = O_SCKV + (size_t)DBS * TS * 128, O_SST = O_SKPE + (size_t)DBS * TS * 64, O_END = O_SST + (size_t)DBS * 4 * 128 * 128;
static_assert(O_END == 21868544, "d_out size");

constexpr size_t al256(size_t x) { return (x + 255) & ~(size_t)255; }
constexpr size_t WS_CTL = 0, CTL_BYTES = 1u << 20;
constexpr size_t WS_WFI = WS_CTL + CTL_BYTES;
constexpr size_t WS_WFO = WS_WFI + (size_t)5632 * 1024 * 2;
constexpr size_t WS_WMI = WS_WFO + (size_t)1024 * 2816 * 2;
constexpr size_t WS_WMO = WS_WMI + (size_t)2560 * 1024 * 2;
constexpr size_t WS_WUQ = WS_WMO + (size_t)1024 * 1024 * 2;
constexpr size_t WS_R128 = WS_WUQ + (size_t)768 * 256 * 2;
constexpr size_t WS_R64 = WS_R128 + (size_t)LP * 64 * 8;
constexpr size_t WS_A16A = al256(WS_R64 + (size_t)LP * 32 * 8);
constexpr size_t A16_BYTES = (size_t)MTOT * 1024 * 2;
constexpr size_t WS_A16B = WS_A16A + A16_BYTES;
constexpr size_t WS_Z = WS_A16B + A16_BYTES;
constexpr size_t Z_BYTES = (size_t)MTOT * 1024 * 4;
constexpr size_t WS_HID = WS_Z + Z_BYTES;
constexpr size_t HID_BYTES = (size_t)MTOT * 2816 * 2;
constexpr size_t WS_END = WS_HID + HID_BYTES;
static_assert(WS_END <= 268435456, "workspace map exceeds 256 MiB");
constexpr size_t WS_P2RAW = WS_Z;
constexpr size_t WS_QA = WS_Z;
constexpr size_t WS_KVN = WS_QA + (size_t)MTOT * 768 * 2;
constexpr int KVN_ITEMS = 4 + NB * 4 * 64;
constexpr size_t WS_KVCT = WS_KVN + (size_t)KVN_ITEMS * 32768;
constexpr size_t WS_CKVT = WS_KVCT + (size_t)DBS * 128 * PAST * 2;
static_assert(WS_CKVT + (size_t)128 * MTOT * 2 <= WS_Z + Z_BYTES && WS_KVCT >= WS_P2RAW + (size_t)MTOT * 512 * 4, "Z overlays");
constexpr size_t RB_BYTES = (size_t)MTOT * 512 * 2;
constexpr size_t WS_QR = WS_HID, WS_KR = WS_QR + RB_BYTES, WS_VR = WS_KR + RB_BYTES, WS_GS = WS_VR + RB_BYTES;
constexpr size_t WS_KVB = WS_GS + RB_BYTES;
constexpr size_t WS_KVC = WS_KVB + (size_t)MTOT * KVW * 2;
constexpr size_t WS_CQB = WS_KVC + (size_t)DBS * PAST * KVW * 2;
static_assert(WS_CQB + (size_t)MTOT * 256 * 2 <= WS_HID + HID_BYTES, "HID overlays");
constexpr int CW_BAR = 4096;
constexpr int CW_ATTQ = 16384;

__device__ __forceinline__ float lg2gamma(int h) { return h == 0 ? -0.04580368961312479f : h == 1 ? -0.02272007650008353f : h == 2 ? -0.011315313227834146f : -0.005646563141142063f; }

__device__ __forceinline__ int row_pos(int r) { return r < R_PROMPT ? r : (r < R_SAMPLE ? NMETA + ((r - R_PROMPT) & (SEQ - 1)) : (r < R_VALID ? NMETA + PAST + ((r - R_SAMPLE) & (TS - 1)) : 0)); }
__device__ __forceinline__ unsigned f2bf(float f) { unsigned u = __builtin_bit_cast(unsigned, f); return (u + 0x7fffu + ((u >> 16) & 1u)) >> 16; }
__device__ __forceinline__ unsigned pk2(float lo, float hi) { return pg8::cvt_pk_bf16(lo, hi); }
__device__ __forceinline__ float bf2f(unsigned short b) { return __builtin_bit_cast(float, (unsigned)b << 16); }
__device__ __forceinline__ float bflo(unsigned w) { return __builtin_bit_cast(float, w << 16); }
__device__ __forceinline__ float bfhi(unsigned w) { return __builtin_bit_cast(float, w & 0xffff0000u); }
__device__ __forceinline__ float siluf(float x) { return x * __builtin_amdgcn_rcpf(1.0f + __builtin_amdgcn_exp2f(-x * LOG2E)); }
template <int CTRL> __device__ __forceinline__ float dppf(float v) { return __builtin_bit_cast(float, __builtin_amdgcn_update_dpp(0, __builtin_bit_cast(int, v), CTRL, 0xF, 0xF, true)); }
__device__ __forceinline__ float wave_sum(float v) {
    v += dppf<0xB1>(v); v += dppf<0x4E>(v); v += dppf<0x141>(v); v += dppf<0x140>(v);
    { auto r = __builtin_amdgcn_permlane16_swap(__float_as_uint(v), __float_as_uint(v), false, false); v = __uint_as_float(r[0]) + __uint_as_float(r[1]); }
    { auto r = __builtin_amdgcn_permlane32_swap(__float_as_uint(v), __float_as_uint(v), false, false); v = __uint_as_float(r[0]) + __uint_as_float(r[1]); }
    return v;
}

struct Args { const float* in[23]; float* out; unsigned char* ws; };
#ifndef WT_AUX
#define WT_AUX 0
#endif
typedef __amdgpu_buffer_rsrc_t rsrc_t;
__device__ __forceinline__ rsrc_t ws_rsrc(const Args& a) { return __builtin_amdgcn_make_buffer_rsrc((void*)a.ws, (short)0, (int)WS_END, 0x00020000); }
__device__ __forceinline__ void wt16(rsrc_t r, size_t off, v4u v) { __builtin_amdgcn_raw_buffer_store_b128(v, r, (unsigned)off, 0, WT_AUX); }
__device__ __forceinline__ void wt8(rsrc_t r, size_t off, v2u v) { __builtin_amdgcn_raw_buffer_store_b64(v, r, (unsigned)off, 0, WT_AUX); }
__device__ __forceinline__ void wt2(rsrc_t r, size_t off, unsigned short v) { __builtin_amdgcn_raw_buffer_store_b16(v, r, (unsigned)off, 0, WT_AUX); }

__device__ __forceinline__ const float* x_row(const Args& a, int r) {
    if (r < R_PROMPT) return a.in[5] + (size_t)r * DM;
    if (r < R_SAMPLE) return a.in[0] + (size_t)(r - R_PROMPT) * DM;
    if (r < R_VALID) return a.in[1] + (size_t)(r - R_SAMPLE) * DM;
    return nullptr;
}

struct EpiSwiglu {
    static constexpr bool PERM = true, AFTER_DRAIN = false;
    rsrc_t R; size_t Hoff;
    __device__ __forceinline__ void operator()(const pg8::f32x4 (&acc)[2][2][4][2], const pg8::Unit& u, int wr, int wc, int fr, int fq) const {
        asm volatile("" : "+v"(fr), "+v"(fq));
        const int row0 = u.pm * 256 + wr * 64 + fr, col0 = u.pn * 128 + wc * 32 + 8 * fq;
#pragma unroll
        for (int ai = 0; ai < 2; ++ai)
#pragma unroll
            for (int m = 0; m < 4; ++m) {
                const int row = row0 + ai * 128 + m * 16;
                const pg8::f32x4 g0 = acc[ai][0][m][0], g1 = acc[ai][0][m][1], u0 = acc[ai][1][m][0], u1 = acc[ai][1][m][1];
                v4u w;
                w.x = pk2(siluf(g0[0]) * u0[0], siluf(g0[1]) * u0[1]); w.y = pk2(siluf(g0[2]) * u0[2], siluf(g0[3]) * u0[3]);
                w.z = pk2(siluf(g1[0]) * u1[0], siluf(g1[1]) * u1[1]); w.w = pk2(siluf(g1[2]) * u1[2], siluf(g1[3]) * u1[3]);
                wt16(R, Hoff + ((size_t)row * FF + col0) * 2, w);
            }
    }
};
template <int SRC> struct EpiResZ {
    static constexpr bool PERM = false, AFTER_DRAIN = false;
    rsrc_t R; size_t Zoff; const bf16* resb; Args a; float scale;
    __device__ __forceinline__ void operator()(const pg8::f32x4 (&acc)[2][2][4][2], const pg8::Unit& u, int wr, int wc, int fr, int fq) const {
        asm volatile("" : "+v"(fr), "+v"(fq));
        const int row0 = u.pm * 256 + wr * 64 + fr, col0 = u.pn * 256 + wc * 32 + 4 * fq;
#pragma unroll
        for (int ai = 0; ai < 2; ++ai)
#pragma unroll
            for (int m = 0; m < 4; ++m) {
                const int row = row0 + ai * 128 + m * 16;
                const float* xr = SRC == 0 ? x_row(a, row) : nullptr;
#pragma unroll
                for (int bj = 0; bj < 2; ++bj)
#pragma unroll
                    for (int n = 0; n < 2; ++n) {
                        const int c = col0 + bj * 128 + n * 16;
                        f32x4 rv;
                        if (SRC == 0) rv = xr ? *(const f32x4*)(xr + c) : (f32x4){0.f, 0.f, 0.f, 0.f};
                        else { const v2u w = *(const v2u*)(resb + (size_t)row * DM + c); rv = (f32x4){bflo(w.x), bfhi(w.x), bflo(w.y), bfhi(w.y)}; }
                        const pg8::f32x4 av = acc[ai][bj][m][n];
                        f32x4 o; o.x = DN_ALPHA * rv.x + scale * av[0]; o.y = DN_ALPHA * rv.y + scale * av[1]; o.z = DN_ALPHA * rv.z + scale * av[2]; o.w = DN_ALPHA * rv.w + scale * av[3];
                        wt16(R, Zoff + ((size_t)row * DM + c) * 4, __builtin_bit_cast(v4u, o));
                    }
                asm volatile("" ::: "memory");
            }
    }
};
struct EpiMixIn {
    static constexpr bool PERM = true, AFTER_DRAIN = false;
    rsrc_t R; const f32x2* R128;
    __device__ __forceinline__ void operator()(const pg8::f32x4 (&acc)[2][2][4][2], const pg8::Unit& u, int wr, int wc, int fr, int fq) const {
        asm volatile("" : "+v"(fr), "+v"(fq));
        const int row0 = u.pm * 256 + wr * 64 + fr, pn = u.pn;
        if (pn < 4) {
            const size_t dst = pn < 2 ? WS_QR : WS_KR; const float sc = pn < 2 ? 1.0f : KR_SCALE;
            const int head = 2 * (pn & 1) + (wc >> 1), i0 = (wc & 1) * 32 + 8 * fq;
#pragma unroll
            for (int ai = 0; ai < 2; ++ai)
#pragma unroll
                for (int m = 0; m < 4; ++m) {
                    const int row = row0 + ai * 128 + m * 16;
                    const f32x2* cs = R128 + (size_t)row_pos(row) * 64 + i0;
                    float o1[8], o2[8];
#pragma unroll
                    for (int n = 0; n < 2; ++n)
#pragma unroll
                        for (int j = 0; j < 4; ++j) { const f32x2 t = cs[4 * n + j]; const float x1 = acc[ai][0][m][n][j], x2 = acc[ai][1][m][n][j];
                            o1[4 * n + j] = (x1 * t.x - x2 * t.y) * sc; o2[4 * n + j] = (x1 * t.y + x2 * t.x) * sc; }
                    v4u w1, w2;
                    w1.x = pk2(o1[0], o1[1]); w1.y = pk2(o1[2], o1[3]); w1.z = pk2(o1[4], o1[5]); w1.w = pk2(o1[6], o1[7]);
                    w2.x = pk2(o2[0], o2[1]); w2.y = pk2(o2[2], o2[3]); w2.z = pk2(o2[4], o2[5]); w2.w = pk2(o2[6], o2[7]);
                    const size_t p = dst + ((size_t)row * 512 + head * 128 + i0) * 2;
                    wt16(R, p, w1); wt16(R, p + 128, w2);
                    asm volatile("" ::: "memory");
                }
        } else if (pn < 8) {
            const size_t dst = pn < 6 ? WS_VR : WS_GS; const bool act = pn >= 6;
            const int cb = (pn & 1) * 256 + wc * 32 + 8 * fq;
#pragma unroll
            for (int ai = 0; ai < 2; ++ai)
#pragma unroll
                for (int m = 0; m < 4; ++m) {
                    const int row = row0 + ai * 128 + m * 16;
#pragma unroll
                    for (int bj = 0; bj < 2; ++bj) {
                        pg8::f32x4 v0 = acc[ai][bj][m][0], v1 = acc[ai][bj][m][1];
                        if (act) {
#pragma unroll
                            for (int j = 0; j < 4; ++j) { v0[j] = siluf(v0[j]); v1[j] = siluf(v1[j]); } }
                        v4u w; w.x = pk2(v0[0], v0[1]); w.y = pk2(v0[2], v0[3]); w.z = pk2(v1[0], v1[1]); w.w = pk2(v1[2], v1[3]);
                        wt16(R, dst + ((size_t)row * 512 + cb + bj * 128) * 2, w);
                    }
                }
        } else {
            const int cb = (pn - 8) * 256 + wc * 32 + 8 * fq;
#pragma unroll
            for (int ai = 0; ai < 2; ++ai)
#pragma unroll
                for (int m = 0; m < 4; ++m) {
                    const int row = row0 + ai * 128 + m * 16;
#pragma unroll
                    for (int bj = 0; bj < 2; ++bj) {
                        const size_t p = WS_P2RAW + ((size_t)row * 512 + cb + bj * 128) * 4;
                        const pg8::f32x4 v0 = acc[ai][bj][m][0], v1 = acc[ai][bj][m][1];
                        wt16(R, p, __builtin_bit_cast(v4u, v0)); wt16(R, p + 16, __builtin_bit_cast(v4u, v1));
                    }
                }
        }
    }
};
struct EpiUq {
    static constexpr bool PERM = true, AFTER_DRAIN = false;
    rsrc_t R; const f32x2* R64;
    __device__ __forceinline__ void operator()(const pg8::f32x4 (&acc)[2][2][4][2], const pg8::Unit& u, int wr, int wc, int fr, int fq) const {
        asm volatile("" : "+v"(fr), "+v"(fq));
        const int row0 = u.pm * 256 + wr * 64 + fr, pn = u.pn;
        if (pn < 2) {
#pragma unroll
            for (int ai = 0; ai < 2; ++ai)
#pragma unroll
                for (int m = 0; m < 4; ++m) {
                    const int row = row0 + ai * 128 + m * 16;
#pragma unroll
                    for (int bj = 0; bj < 2; ++bj) {
                        const pg8::f32x4 v0 = acc[ai][bj][m][0] * SM_SCALE, v1 = acc[ai][bj][m][1] * SM_SCALE;
                        v4u w; w.x = pk2(v0[0], v0[1]); w.y = pk2(v0[2], v0[3]); w.z = pk2(v1[0], v1[1]); w.w = pk2(v1[2], v1[3]);
                        wt16(R, WS_QA + ((size_t)row * NQA + (2 * pn + bj) * KVW + wc * 32 + 8 * fq) * 2, w);
                    }
                }
        } else {
            const int head = wc, i0 = 8 * fq;
#pragma unroll
            for (int ai = 0; ai < 2; ++ai)
#pragma unroll
                for (int m = 0; m < 4; ++m) {
                    const int row = row0 + ai * 128 + m * 16;
                    const f32x2* cs = R64 + (size_t)row_pos(row) * 32 + i0;
                    float o1[8], o2[8];
#pragma unroll
                    for (int n = 0; n < 2; ++n)
#pragma unroll
                        for (int j = 0; j < 4; ++j) { const f32x2 t = cs[4 * n + j]; const float x1 = acc[ai][0][m][n][j], x2 = acc[ai][1][m][n][j];
                            o1[4 * n + j] = (x1 * t.x - x2 * t.y) * SM_SCALE; o2[4 * n + j] = (x1 * t.y + x2 * t.x) * SM_SCALE; }
                    v4u w1, w2;
                    w1.x = pk2(o1[0], o1[1]); w1.y = pk2(o1[2], o1[3]); w1.z = pk2(o1[4], o1[5]); w1.w = pk2(o1[6], o1[7]);
                    w2.x = pk2(o2[0], o2[1]); w2.y = pk2(o2[2], o2[3]); w2.z = pk2(o2[4], o2[5]); w2.w = pk2(o2[6], o2[7]);
                    const size_t p = WS_QA + ((size_t)row * NQA + head * KVW + 128 + i0) * 2;
                    wt16(R, p, w1); wt16(R, p + 64, w2);
                    asm volatile("" ::: "memory");
                }
        }
    }
};

__device__ __forceinline__ int src_col(int mat, int n) {
    if (mat == 0) { const int pn = n >> 8, bj = (n >> 7) & 1, i = n & 127; return bj * FF + 128 * pn + i; }
    if (mat == 2) {
        if (n < 1024) { const int pn = n >> 8, bj = (n >> 7) & 1, ip = n & 127, hh = ip >> 6, i = ip & 63; return (pn >> 1) * 512 + (2 * (pn & 1) + hh) * 128 + 64 * bj + i; }
        return n < DIN ? n : -1; }
    if (mat == 3) { const int bj = n >> 7, ip = n & 127, head = ip >> 5, i = ip & 31; return head * KVW + 128 + 32 * bj + i; }
    return n;
}
__device__ __forceinline__ void transpose_item(const float* __restrict__ W, int srcN, bf16* WT, int dstPitch, int dstRowOff, int mat, int k0, int n0, LAS float* scr, int lane) {
    const int sc = src_col(mat, n0 + (lane & 31));
    float v[32];
    const float* wp = W + (size_t)(k0 + (lane >> 5)) * srcN + (sc >= 0 ? sc : 0);
#pragma unroll
    for (int i = 0; i < 32; ++i) v[i] = wp[(size_t)(2 * i) * srcN];
#pragma unroll
    for (int i = 0; i < 32; ++i) scr[(2 * i + (lane >> 5)) * 33 + (lane & 31)] = sc >= 0 ? v[i] : 0.f;
    LDS_WAIT();
    const int c = lane & 7;
#pragma unroll
    for (int j = 0; j < 4; ++j) { const int n = (lane >> 3) + 8 * j; const LAS float* s = scr + (8 * c) * 33 + n;
        v4u o; o.x = pk2(s[0 * 33], s[1 * 33]); o.y = pk2(s[2 * 33], s[3 * 33]); o.z = pk2(s[4 * 33], s[5 * 33]); o.w = pk2(s[6 * 33], s[7 * 33]);
        *(v4u*)(WT + (size_t)(dstRowOff + n0 + n) * dstPitch + k0 + 8 * c) = o; }
    LDS_WAIT();
}
__device__ __forceinline__ void transpose_matrix(const float* W, int Kdim, int srcN, bf16* WT, int Ndst, int dstPitch, int dstRowOff, int mat, LAS float* scr, int gw, int NGW, int lane) {
    const int nblk = Ndst / 32, nitems = (Kdim / 64) * nblk;
    for (int it = gw; it < nitems; it += NGW) transpose_item(W, srcN, WT, dstPitch, dstRowOff, mat, 64 * (it / nblk), 32 * (it % nblk), scr, lane);
}
__device__ __forceinline__ void sincos_acc(float ang, float& sn, float& cs) {
    const double x = (double)ang; const double kq = __builtin_rint(x * 0.63661977236758134308);
    const double r = (x - kq * 1.57079632679489655800e+00) - kq * 6.12323399573676603587e-17;
    const double r2 = r * r;
    const double s = r * (1.0 + r2 * (-1.0 / 6 + r2 * (1.0 / 120 + r2 * (-1.0 / 5040 + r2 * (1.0 / 362880 + r2 * (-1.0 / 39916800 + r2 * (1.0 / 6227020800.0)))))));
    const double c = 1.0 + r2 * (-0.5 + r2 * (1.0 / 24 + r2 * (-1.0 / 720 + r2 * (1.0 / 40320 + r2 * (-1.0 / 3628800 + r2 * (1.0 / 479001600 + r2 * (-1.0 / 87178291200.0)))))));
    const int q = (int)((long long)kq & 3);
    const double ss = (q == 0) ? s : (q == 1) ? c : (q == 2) ? -s : -c;
    const double cc = (q == 0) ? c : (q == 1) ? -s : (q == 2) ? -c : s;
    sn = (float)ss; cs = (float)cc;
}

constexpr int MAIN_ROWS = 16384;
template <bool FINAL, int RES, int SPU> __device__ __forceinline__ void ln_rows(const Args& a, const float* Z, const float* g, const float* b, bf16* outB, const float* slabs, const bf16* resb, float scale, int gw, int NGW, int lane) {
    f32x4 gv[4], bv[4]; const rsrc_t wsr = ws_rsrc(a);
#pragma unroll
    for (int j = 0; j < 4; ++j) { gv[j] = *(const f32x4*)(g + 4 * lane + 256 * j); bv[j] = *(const f32x4*)(b + 4 * lane + 256 * j); }
#define LN_FINISH(v, r) do { float s_ = 0.f; _Pragma("unroll") for (int j = 0; j < 4; ++j) s_ += (v[j].x + v[j].y) + (v[j].z + v[j].w); \
        const float mean_ = wave_sum(s_) * (1.f / DM); float s2_ = 0.f; \
        _Pragma("unroll") for (int j = 0; j < 4; ++j) { v[j] = v[j] - mean_; s2_ += (v[j].x * v[j].x + v[j].y * v[j].y) + (v[j].z * v[j].z + v[j].w * v[j].w); } \
        const float rstd_ = 1.0f / sqrtf(wave_sum(s2_) * (1.f / DM) + LN_EPS); \
        if (FINAL) { float* o_ = a.out + ((r) < R_SAMPLE ? O_YP + (size_t)((r) - R_PROMPT) * DM : O_YS + (size_t)((r) - R_SAMPLE) * DM); \
            _Pragma("unroll") for (int j = 0; j < 4; ++j) *((f32x4*)o_ + lane + 64 * j) = v[j] * rstd_ * gv[j] + bv[j]; } \
        else { const size_t o_ = (size_t)((const unsigned char*)outB - a.ws) + ((size_t)(r) * DM + 4 * lane) * 2; \
            _Pragma("unroll") for (int j = 0; j < 4; ++j) { const f32x4 y_ = v[j] * rstd_ * gv[j] + bv[j]; v2u w_; w_.x = pk2(y_.x, y_.y); w_.y = pk2(y_.z, y_.w); wt8(wsr, o_ + 512 * j, w_); } } } while (0)
    for (int r0 = gw; r0 < MAIN_ROWS; r0 += 2 * NGW) {
        const int r1 = r0 + NGW; const bool h1 = r1 < MAIN_ROWS;
        f32x4 va[4], vb[4];
        { const f32x4* zr = (const f32x4*)(Z + (size_t)r0 * DM) + lane;
#pragma unroll
          for (int j = 0; j < 4; ++j) va[j] = zr[64 * j]; }
        if (h1) { const f32x4* zr = (const f32x4*)(Z + (size_t)r1 * DM) + lane;
#pragma unroll
          for (int j = 0; j < 4; ++j) vb[j] = zr[64 * j]; }
        if (!(FINAL && r0 < R_PROMPT)) LN_FINISH(va, r0);
        if (h1 && !(FINAL && r1 < R_PROMPT)) LN_FINISH(vb, r1);
    }
    for (int r = MAIN_ROWS + gw; r < (FINAL ? R_VALID : MTOT); r += NGW) {
        f32x4 v[4];
        const int pm = r >> 8, rl = r & 255; const float* xr = RES == 0 ? x_row(a, r) : nullptr;
#pragma unroll
        for (int j = 0; j < 4; ++j) {
            f32x4 acc = {0.f, 0.f, 0.f, 0.f};
            const float* sp = slabs + (size_t)(((pm - MAIN_ROWS / 256) * 4 + j) * SPU) * 65536 + (size_t)rl * 256 + 4 * lane;
            f32x4 t[SPU];
#pragma unroll
            for (int q = 0; q < SPU; ++q) t[q] = *(const f32x4*)(sp + (size_t)q * 65536);
#pragma unroll
            for (int q = 0; q < SPU; ++q) acc += t[q];
            f32x4 rv;
            if (RES == 0) rv = xr ? *((const f32x4*)xr + lane + 64 * j) : (f32x4){0.f, 0.f, 0.f, 0.f};
            else { const v2u w = *((const v2u*)(resb + (size_t)r * DM) + lane + 64 * j); rv = (f32x4){bflo(w.x), bfhi(w.x), bflo(w.y), bfhi(w.y)}; }
            v[j] = rv * DN_ALPHA + acc * scale;
        }
        LN_FINISH(v, r);
    }
#undef LN_FINISH
}

__device__ __forceinline__ void post_rows(const Args& a, int gw, int NGW, int lane) {
    unsigned char* ws = a.ws;
    const float* P2 = (const float*)(ws + WS_P2RAW); bf16* CQB = (bf16*)(ws + WS_CQB); bf16* KVB = (bf16*)(ws + WS_KVB);
    const f32x2* R64 = (const f32x2*)(ws + WS_R64);
    const f32x4 gq = *(const f32x4*)(a.in[12] + 4 * lane);
    const float gk0 = a.in[14][lane], gk1 = a.in[14][64 + lane];
    for (int r0 = gw; r0 < MTOT; r0 += 4 * NGW) {
        f32x4 cq[4]; float c0[4], c1[4], k1[4], k2[4]; f32x2 cs[4];
#pragma unroll
        for (int u = 0; u < 4; ++u) { const int row = r0 + u * NGW; if (row < MTOT) { const float* p = P2 + (size_t)row * 512;
            cq[u] = *(const f32x4*)(p + 4 * lane); c0[u] = p[256 + lane]; c1[u] = p[320 + lane]; k1[u] = p[384 + (lane & 31)]; k2[u] = p[416 + (lane & 31)]; cs[u] = R64[(size_t)row_pos(row) * 32 + (lane & 31)]; } }
#pragma unroll
        for (int u = 0; u < 4; ++u) { const int row = r0 + u * NGW; if (row < MTOT) {
            const float ssq = wave_sum((cq[u].x * cq[u].x + cq[u].y * cq[u].y) + (cq[u].z * cq[u].z + cq[u].w * cq[u].w));
            const float ssk = wave_sum(c0[u] * c0[u] + c1[u] * c1[u]);
            const float rq = 1.0f / sqrtf(ssq * (1.f / 256) + RMS_EPS), rk = 1.0f / sqrtf(ssk * (1.f / 128) + RMS_EPS);
            v2u w; w.x = pk2(cq[u].x * rq * gq.x, cq[u].y * rq * gq.y); w.y = pk2(cq[u].z * rq * gq.z, cq[u].w * rq * gq.w);
            *((v2u*)(CQB + (size_t)row * 256) + lane) = w;
            const float v0 = c0[u] * rk * gk0, v1 = c1[u] * rk * gk1;
            const float kp = lane < 32 ? k1[u] * cs[u].x - k2[u] * cs[u].y : k1[u] * cs[u].y + k2[u] * cs[u].x;
            KVB[(size_t)row * KVW + lane] = (bf16)f2bf(v0); KVB[(size_t)row * KVW + 64 + lane] = (bf16)f2bf(v1); KVB[(size_t)row * KVW + 128 + lane] = (bf16)f2bf(kp);
            if (row < R_PROMPT) {
#pragma unroll
                for (int b = 0; b < NB; ++b) { float* oc = a.out + O_PCKV + ((size_t)b * LP + row) * 128; oc[lane] = v0; oc[64 + lane] = v1; a.out[O_PKPE + ((size_t)b * LP + row) * 64 + lane] = kp; }
            } else if (row < R_SAMPLE) {
                const int b = (row - R_PROMPT) >> 12, sq = (row - R_PROMPT) & (SEQ - 1);
                float* oc = a.out + O_PCKV + ((size_t)b * LP + NMETA + sq) * 128; oc[lane] = v0; oc[64 + lane] = v1; a.out[O_PKPE + ((size_t)b * LP + NMETA + sq) * 64 + lane] = kp;
            } else if (row < R_VALID) {
                float* oc = a.out + O_SCKV + (size_t)(row - R_SAMPLE) * 128; oc[lane] = v0; oc[64 + lane] = v1; a.out[O_SKPE + (size_t)(row - R_SAMPLE) * 64 + lane] = kp;
            } } }
    }
    bf16* KVC = (bf16*)(ws + WS_KVC);
#pragma unroll 4
    for (int r = gw; r < DBS * PAST; r += NGW) {
        const float v0 = a.in[2][(size_t)r * 128 + lane], v1 = a.in[2][(size_t)r * 128 + 64 + lane], kp = a.in[3][(size_t)r * 64 + lane];
        KVC[(size_t)r * KVW + lane] = (bf16)f2bf(v0); KVC[(size_t)r * KVW + 64 + lane] = (bf16)f2bf(v1); KVC[(size_t)r * KVW + 128 + lane] = (bf16)f2bf(kp);
    }
}

__device__ __forceinline__ int crow(int r, int hi) { return (r & 3) + 8 * (r >> 2) + 4 * hi; }
#define PK4(P, BASE, OUT) do { unsigned a0_ = pk2(P[BASE + 0], P[BASE + 1]), a1_ = pk2(P[BASE + 2], P[BASE + 3]);   \
    unsigned b0_ = pk2(P[BASE + 4], P[BASE + 5]), b1_ = pk2(P[BASE + 6], P[BASE + 7]);                              \
    auto r0_ = __builtin_amdgcn_permlane32_swap(a0_, b0_, false, false); auto r1_ = __builtin_amdgcn_permlane32_swap(a1_, b1_, false, false); \
    v4u w_ = {r0_[0], r1_[0], r0_[1], r1_[1]}; OUT = __builtin_bit_cast(bf16x8, w_); } while (0)
__device__ __forceinline__ float half_swap_max(float x) { auto rr = __builtin_amdgcn_permlane32_swap(__float_as_uint(x), __float_as_uint(x), false, false); return fmaxf(__uint_as_float(rr[0]), __uint_as_float(rr[1])); }
__device__ __forceinline__ float half_swap_sum(float x) { auto rr = __builtin_amdgcn_permlane32_swap(__float_as_uint(x), __float_as_uint(x), false, false); return __uint_as_float(rr[0]) + __uint_as_float(rr[1]); }


typedef short v4i16_t __attribute__((ext_vector_type(4)));
__device__ __forceinline__ unsigned offb(unsigned row, unsigned ch) { return 256u * row + 16u * (ch ^ (((row & 3) << 2) | ((row >> 2) & 3))); }
__device__ __forceinline__ unsigned offk(unsigned row, unsigned ch) { return 128u * row + 16u * (ch ^ ((row >> 1) & 7)); }
__device__ __forceinline__ bf16x8 rowfrag(LAS unsigned char* T, unsigned rb, unsigned lane, unsigned s) { return *(LAS bf16x8*)(T + offb(rb + (lane & 31), 2 * s + (lane >> 5))); }
__device__ __forceinline__ bf16x8 rowfrag64(LAS unsigned char* T, unsigned rb, unsigned lane, unsigned s) { return *(LAS bf16x8*)(T + offk(rb + (lane & 31), 2 * s + (lane >> 5))); }
__device__ __forceinline__ bf16x8 trfrag(LAS unsigned char* T, unsigned lane, unsigned c, unsigned ks) {
    const unsigned h = lane >> 5, blk = (lane >> 4) & 1, q = (lane & 15) >> 2, p = lane & 3, row = 16 * ks + 8 * h + q, ch = 4 * c + 2 * blk + (p >> 1);
    const v4i16_t lo = __builtin_amdgcn_ds_read_tr16_b64_v4i16((LAS v4i16_t*)(T + offb(row, ch) + 8 * (p & 1)));
    const v4i16_t hi = __builtin_amdgcn_ds_read_tr16_b64_v4i16((LAS v4i16_t*)(T + offb(row + 4, ch) + 8 * (p & 1)));
    return (bf16x8){lo[0], lo[1], lo[2], lo[3], hi[0], hi[1], hi[2], hi[3]};
}

constexpr int AT_TILE = 24576;
__device__ __forceinline__ const bf16* attn_tile_src(unsigned char* ws, int type, int bi, int t, int& nvalid) {
    const bf16* KVB = (const bf16*)(ws + WS_KVB); const bf16* KVC = (const bf16*)(ws + WS_KVC);
    if (t == 0) { nvalid = NMETA; return KVB; }
    if (type == 0) { nvalid = 64; return KVB + (size_t)(R_PROMPT + bi * SEQ + 64 * (t - 1)) * KVW; }
    if (t <= 16) { nvalid = 64; return KVC + ((size_t)bi * PAST + 64 * (t - 1)) * KVW; }
    nvalid = TS; return KVB + (size_t)(R_SAMPLE + TS * bi) * KVW;
}
__device__ __forceinline__ void attn_unit(const Args& a, LAS unsigned char* L, int type, int bi, int c, int qh, int tid) {
    asm volatile("" : "+v"(tid));
    unsigned char* ws = a.ws;
    const bf16* QA = (const bf16*)(ws + WS_QA); const rsrc_t wsr = ws_rsrc(a);
    const int lane = tid & 63, wave = __builtin_amdgcn_readfirstlane(tid >> 6), g = wave >> 2, h = wave & 3, r32 = lane & 31, hi = lane >> 5;
    int qrow0, nq, nt;
    if (type == 0) { qrow0 = R_PROMPT + bi * SEQ + 64 * c + 32 * qh; nq = 32; nt = c + 2; }
    else if (type == 1) { qrow0 = R_SAMPLE + TS * bi; nq = 32; nt = 18; }
    else { qrow0 = 0; nq = 16; nt = 1; }
    const int nsteps = (nt + 1) >> 1;
    bf16x8 qr[12];
    { const bf16* qp = QA + (size_t)(qrow0 + r32) * NQA + h * KVW + hi * 8;
#pragma unroll
      for (int d0 = 0; d0 < 12; ++d0) qr[d0] = *(const bf16x8*)(qp + d0 * 16); }
    f32x16 o[4];
#pragma unroll
    for (int d = 0; d < 4; ++d)
#pragma unroll
        for (int r = 0; r < 16; ++r) o[d][r] = 0.f;
    float m_reg = -1e30f, l_reg = 0.f;
    unsigned rb_[8], kb_[4], tb_[8];
    { const unsigned X = ((r32 & 3) << 2) | ((r32 >> 2) & 3);
#pragma unroll
      for (int s = 0; s < 8; ++s) rb_[s] = 256u * r32 + 32u * (s ^ (X >> 1)) + 16u * (hi ^ (X & 1));
#pragma unroll
      for (int s = 0; s < 4; ++s) kb_[s] = 16384u + offk(r32, 2 * s + hi);
      const unsigned blk = (lane >> 4) & 1, q = (lane & 15) >> 2, p = lane & 3;
#pragma unroll
      for (int cb = 0; cb < 4; ++cb)
#pragma unroll
          for (int t = 0; t < 2; ++t) tb_[2 * cb + t] = 256u * (8 * hi + 4 * t + q) + 64u * (cb ^ q) + 16u * ((2 * blk + (p >> 1)) ^ ((2 * hi + t) & 3)) + 8u * (p & 1); }
#define AT_STAGE(step) do { int ln_ = lane; asm volatile("" : "+v"(ln_)); _Pragma("unroll") for (int i_ = 0; i_ < 6; ++i_) { const int pid_ = wave * 6 + i_, tt_ = pid_ >= 24 ? 1 : 0, pp_ = pid_ - 24 * tt_, t_ = 2 * (step) + tt_; \
        if (t_ < nt) { int nv_; const bf16* src_ = attn_tile_src(ws, type, bi, t_, nv_); LAS unsigned char* T_ = L + (((step) % 3) * 2 + tt_) * AT_TILE + (pp_ < 16 ? pp_ * 1024 : 16384 + (pp_ - 16) * 1024); unsigned so_; \
            if (pp_ < 16) { const unsigned row_ = 4 * pp_ + (ln_ >> 4), slot_ = ln_ & 15; so_ = row_ * KVW + 8 * (slot_ ^ (((row_ & 3) << 2) | ((row_ >> 2) & 3))); } \
            else { const unsigned row_ = 8 * (pp_ - 16) + (ln_ >> 3), slot_ = ln_ & 7; so_ = row_ * KVW + 128 + 8 * (slot_ ^ ((row_ >> 1) & 7)); } \
            __builtin_amdgcn_global_load_lds((const unsigned*)(src_ + so_), (LAS unsigned*)T_, 16, 0, 0); } } } while (0)
    AT_STAGE(0);
    __syncthreads();
    bf16x8 pa0, pa1, pa2, pa3; int pend = -1;
#define AT_TR(T_, cb, ks) ({ const v4i16_t lo_ = __builtin_amdgcn_ds_read_tr16_b64_v4i16((LAS v4i16_t*)((T_) + tb_[2 * (cb)] + 4096 * (ks))), hi_ = __builtin_amdgcn_ds_read_tr16_b64_v4i16((LAS v4i16_t*)((T_) + tb_[2 * (cb) + 1] + 4096 * (ks))); \
                (bf16x8){lo_[0], lo_[1], lo_[2], lo_[3], hi_[0], hi_[1], hi_[2], hi_[3]}; })
#define AT_PV(T_) do { _Pragma("unroll") for (int d0 = 0; d0 < 4; ++d0) { const bf16x8 va_ = AT_TR(T_, d0, 0), vb_ = AT_TR(T_, d0, 1), vc_ = AT_TR(T_, d0, 2), vd_ = AT_TR(T_, d0, 3); \
            o[d0] = __builtin_amdgcn_mfma_f32_32x32x16_bf16(va_, pa0, o[d0], 0, 0, 0); o[d0] = __builtin_amdgcn_mfma_f32_32x32x16_bf16(vb_, pa1, o[d0], 0, 0, 0); \
            o[d0] = __builtin_amdgcn_mfma_f32_32x32x16_bf16(vc_, pa2, o[d0], 0, 0, 0); o[d0] = __builtin_amdgcn_mfma_f32_32x32x16_bf16(vd_, pa3, o[d0], 0, 0, 0); } } while (0)
    for (int s = 0; s < nsteps; ++s) {
        if (s + 1 < nsteps) AT_STAGE(s + 1);
        const int t = 2 * s + g; const bool act = t < nt;
        f32x16 p0, p1;
        if (act) {
            LAS unsigned char* T = L + ((s % 3) * 2 + g) * AT_TILE;
#pragma unroll
            for (int r = 0; r < 16; ++r) { p0[r] = 0.f; p1[r] = 0.f; }
            bf16x8 k0 = *(LAS bf16x8*)(T + rb_[0]), k1 = *(LAS bf16x8*)(T + rb_[0] + 8192);
#pragma unroll
            for (int d0 = 0; d0 < 12; ++d0) {
                bf16x8 n0 = k0, n1 = k1;
                if (d0 < 7) { n0 = *(LAS bf16x8*)(T + rb_[d0 + 1]); n1 = *(LAS bf16x8*)(T + rb_[d0 + 1] + 8192); }
                else if (d0 < 11) { n0 = *(LAS bf16x8*)(T + kb_[d0 - 7]); n1 = *(LAS bf16x8*)(T + kb_[d0 - 7] + 4096); }
                p0 = __builtin_amdgcn_mfma_f32_32x32x16_bf16(k0, qr[d0], p0, 0, 0, 0);
                p1 = __builtin_amdgcn_mfma_f32_32x32x16_bf16(k1, qr[d0], p1, 0, 0, 0);
                k0 = n0; k1 = n1;
            }
        }
        if (pend >= 0) { LAS unsigned char* Tp = L + (pend * 2 + g) * AT_TILE; AT_PV(Tp); }
        if (g == 1) __syncthreads();
        if (act) {
            int nvalid; (void)attn_tile_src(ws, type, bi, t, nvalid);
            if (nvalid < 64) {
#pragma unroll
                for (int r = 0; r < 16; ++r) { const int key = crow(r, hi); if (key >= nvalid) p0[r] = -1e30f; if (key + 32 >= nvalid) p1[r] = -1e30f; }
            }
            float pmax = p0[0];
#pragma unroll
            for (int r = 1; r < 16; ++r) pmax = fmaxf(pmax, p0[r]);
#pragma unroll
            for (int r = 0; r < 16; ++r) pmax = fmaxf(pmax, p1[r]);
            pmax = half_swap_max(pmax);
            float alpha = 1.f;
            if (!__all(pmax - m_reg <= 8.0f)) { const float mn = fmaxf(m_reg, pmax); alpha = __builtin_amdgcn_exp2f((m_reg - mn) * LOG2E); m_reg = mn; }
            const float mnC = -m_reg * LOG2E; float ps = 0.f;
#pragma unroll
            for (int r = 0; r < 16; ++r) { p0[r] = __builtin_amdgcn_exp2f(fmaf(p0[r], LOG2E, mnC)); p1[r] = __builtin_amdgcn_exp2f(fmaf(p1[r], LOG2E, mnC)); ps += p0[r] + p1[r]; }
            ps = half_swap_sum(ps);
            l_reg = l_reg * alpha + ps;
            if (__any(alpha < 1.f)) {
#pragma unroll
                for (int d = 0; d < 4; ++d)
#pragma unroll
                    for (int r = 0; r < 16; ++r) o[d][r] *= alpha;
            }
            PK4(p0, 0, pa0); PK4(p0, 8, pa1); PK4(p1, 0, pa2); PK4(p1, 8, pa3);
            pend = s % 3;
        } else pend = -1;
        if (g == 0) __syncthreads();
    }
    if (pend >= 0) { LAS unsigned char* Tp = L + (pend * 2 + g) * AT_TILE; AT_PV(Tp); }
    __syncthreads();
#undef AT_PV
#undef AT_TR
#undef AT_STAGE
    LAS float* M = (LAS float*)(L + h * 17408);
    if (g == 1) {
#pragma unroll
        for (int d = 0; d < 4; ++d)
#pragma unroll
            for (int r = 0; r < 16; ++r) M[(d * 16 + r) * 64 + lane] = o[d][r];
        M[4096 + lane] = m_reg; M[4160 + lane] = l_reg;
    }
    __syncthreads();
    if (g == 0) {
        const float m1 = M[4096 + lane], l1 = M[4160 + lane];
        const float mm = fmaxf(m_reg, m1), f0 = __builtin_amdgcn_exp2f((m_reg - mm) * LOG2E), f1 = __builtin_amdgcn_exp2f((m1 - mm) * LOG2E);
        const float rl = __builtin_amdgcn_rcpf(l_reg * f0 + l1 * f1), s0 = f0 * rl, s1 = f1 * rl;
        if (r32 < nq) {
            const size_t op = WS_A16A + ((size_t)(qrow0 + r32) * DM + 512 + h * 128 + 4 * hi) * 2;
#pragma unroll
            for (int d0 = 0; d0 < 4; ++d0)
#pragma unroll
                for (int rg = 0; rg < 4; ++rg) { float v[4];
#pragma unroll
                    for (int i = 0; i < 4; ++i) v[i] = o[d0][4 * rg + i] * s0 + M[(d0 * 16 + 4 * rg + i) * 64 + lane] * s1;
                    v2u w_; w_.x = pk2(v[0], v[1]); w_.y = pk2(v[2], v[3]); wt8(wsr, op + (32 * d0 + 8 * rg) * 2, w_); }
        }
    }
    __syncthreads();
}

struct RetItem { int kind, bh, n; };
__device__ __forceinline__ void ret_geom(const RetItem& it, int& h, int& rowbase, int& tlo, int& thi, int& T) {
    if (it.kind == 0) { h = it.bh; rowbase = -48; tlo = 48; thi = 64; T = 64; }
    else if (it.kind == 1) { h = it.bh & 3; rowbase = R_PROMPT + (it.bh >> 2) * SEQ + 64 * (it.n - 1); tlo = 0; thi = 64; T = 64; }
    else { h = it.bh & 3; rowbase = R_SAMPLE + TS * (it.bh >> 2); tlo = 0; thi = TS; T = TS; }
}
__device__ __forceinline__ int kvn_index(const RetItem& it) { return it.kind == 0 ? it.bh : 4 + it.bh * 64 + (it.n - 1); }
__device__ __forceinline__ RetItem ret_item(int i) {
    if (i < 4) return RetItem{0, i, 0};
    if (i < 1028) { const int j = i - 4; return RetItem{1, j >> 6, (j & 63) + 1}; }
    return RetItem{2, i - 1028, 0};
}
constexpr int NRET = 4 + NB * 4 * 64 + DBS * 4;
template <bool DEC> __device__ __forceinline__ void ret_stage(LAS unsigned char* T_, const bf16* X, int rowbase, int h, int tlo, int thi, float lg2, int T, int tid) {
    const int ch = tid & 15;
#pragma unroll
    for (int i = 0; i < 2; ++i) {
        const int t = (tid >> 4) + 32 * i; v4u v = {0u, 0u, 0u, 0u};
        if (t >= tlo && t < thi) {
            v = *(const v4u*)(X + (size_t)(rowbase + t) * 512 + h * 128 + ch * 8);
            if (DEC) { const float d = __builtin_amdgcn_exp2f(lg2 * (float)(T - 1 - t));
                v.x = pk2(bflo(v.x) * d, bfhi(v.x) * d); v.y = pk2(bflo(v.y) * d, bfhi(v.y) * d); v.z = pk2(bflo(v.z) * d, bfhi(v.z) * d); v.w = pk2(bflo(v.w) * d, bfhi(v.w) * d); }
        }
        *(LAS v4u*)(T_ + offb(t, ch)) = v;
    }
}
__device__ __forceinline__ void ret_kv_item(const Args& a, LAS unsigned char* L, const RetItem& it, int tid) {
    asm volatile("" : "+v"(tid));
    unsigned char* ws = a.ws;
    const bf16* KR = (const bf16*)(ws + WS_KR); const bf16* VR = (const bf16*)(ws + WS_VR); bf16* KVN = (bf16*)(ws + WS_KVN);
    int h, rowbase, tlo, thi, T; ret_geom(it, h, rowbase, tlo, thi, T);
    const float lg2 = lg2gamma(h); const int lane = tid & 63, w = __builtin_amdgcn_readfirstlane(tid >> 6), r32 = lane & 31, hi = lane >> 5, ib = w >> 1, jb0 = 2 * (w & 1);
    LAS unsigned char* TK = L; LAS unsigned char* TV = L + 16384;
    ret_stage<false>(TK, KR, rowbase, h, tlo, thi, lg2, T, tid);
    ret_stage<true>(TV, VR, rowbase, h, tlo, thi, lg2, T, tid);
    __syncthreads();
    f32x16 c0, c1;
#pragma unroll
    for (int r = 0; r < 16; ++r) { c0[r] = 0.f; c1[r] = 0.f; }
#pragma unroll
    for (int ks = 0; ks < 4; ++ks) {
        const bf16x8 af = trfrag(TK, lane, ib, ks), b0 = trfrag(TV, lane, jb0, ks), b1 = trfrag(TV, lane, jb0 + 1, ks);
        c0 = __builtin_amdgcn_mfma_f32_32x32x16_bf16(af, b0, c0, 0, 0, 0);
        c1 = __builtin_amdgcn_mfma_f32_32x32x16_bf16(af, b1, c1, 0, 0, 0);
    }
    if (it.kind != 2) {
        bf16* dst = KVN + (size_t)kvn_index(it) * 16384;
#pragma unroll
        for (int rg = 0; rg < 4; ++rg) { const int dk0 = 32 * ib + 8 * rg + 4 * hi;
            v2u w0; w0.x = pk2(c0[4 * rg], c0[4 * rg + 1]); w0.y = pk2(c0[4 * rg + 2], c0[4 * rg + 3]);
            v2u w1; w1.x = pk2(c1[4 * rg], c1[4 * rg + 1]); w1.y = pk2(c1[4 * rg + 2], c1[4 * rg + 3]);
            *(v2u*)(dst + (size_t)(32 * jb0 + r32) * 128 + dk0) = w0; *(v2u*)(dst + (size_t)(32 * (jb0 + 1) + r32) * 128 + dk0) = w1; }
    } else {
        const float dec = __builtin_amdgcn_exp2f(lg2 * (float)T);
        const float* s0 = a.in[4] + (size_t)it.bh * 16384; float* so = a.out + O_SST + (size_t)it.bh * 16384;
#pragma unroll
        for (int r = 0; r < 16; ++r) { const size_t e = (size_t)(32 * ib + crow(r, hi)) * 128 + 32 * jb0 + r32;
            so[e] = dec * s0[e] + c0[r]; so[e + 32] = dec * s0[e + 32] + c1[r]; }
    }
    __syncthreads();
}
struct RetRegs { v4u q[2], k[2], v[2], s[4]; };
__device__ __forceinline__ void ret_out_load(const Args& a, const RetItem& it, int tid, RetRegs& R) {
    unsigned char* ws = a.ws;
    const bf16* QR = (const bf16*)(ws + WS_QR); const bf16* KR = (const bf16*)(ws + WS_KR); const bf16* VR = (const bf16*)(ws + WS_VR); const bf16* KVN = (const bf16*)(ws + WS_KVN);
    int h, rowbase, tlo, thi, T; ret_geom(it, h, rowbase, tlo, thi, T);
    const int ch = tid & 15; const v4u z = {0u, 0u, 0u, 0u};
#pragma unroll
    for (int i = 0; i < 2; ++i) { const int t = (tid >> 4) + 32 * i; const bool ok = t >= tlo && t < thi; const size_t off = (size_t)(rowbase + t) * 512 + h * 128 + ch * 8;
        R.q[i] = ok ? *(const v4u*)(QR + off) : z; R.k[i] = ok ? *(const v4u*)(KR + off) : z; R.v[i] = ok ? *(const v4u*)(VR + off) : z; }
    if (it.kind == 1) { const bf16* st = KVN + (size_t)kvn_index(it) * 16384;
#pragma unroll
        for (int i = 0; i < 4; ++i) R.s[i] = *(const v4u*)(st + (size_t)((tid >> 4) + 32 * i) * 128 + ch * 8); }
}
__device__ __forceinline__ void ret_out_phase(const Args& a, LAS unsigned char* L, int vcu, int G, int tid) {
    asm volatile("" : "+v"(tid));
    unsigned char* ws = a.ws;
    const bf16* GS = (const bf16*)(ws + WS_GS); const rsrc_t wsr = ws_rsrc(a);
    const int w = __builtin_amdgcn_readfirstlane(tid >> 6), qhalf = w & 1, cb = w >> 1, ch = tid & 15;
    LAS unsigned char* TQ = L; LAS unsigned char* TK = L + 16384; LAS unsigned char* TV = L + 32768; LAS unsigned char* TS_ = L + 49152;
    LAS float* ST = (LAS float*)(L + 81920);
    RetRegs R;
    if (vcu < NRET) ret_out_load(a, ret_item(vcu), tid, R);
    for (int i = vcu; i < NRET; i += G) {
        const RetItem it = ret_item(i);
        int h, rowbase, tlo, thi, T; ret_geom(it, h, rowbase, tlo, thi, T);
        const float lg2 = lg2gamma(h);
        int lane = tid & 63; asm volatile("" : "+v"(lane));
        const int r32 = lane & 31, hi = lane >> 5;
#pragma unroll
        for (int j = 0; j < 2; ++j) { const unsigned o_ = offb((tid >> 4) + 32 * j, ch); *(LAS v4u*)(TQ + o_) = R.q[j]; *(LAS v4u*)(TK + o_) = R.k[j]; *(LAS v4u*)(TV + o_) = R.v[j]; }
        if (it.kind == 1) {
#pragma unroll
            for (int j = 0; j < 4; ++j) *(LAS v4u*)(TS_ + offb((tid >> 4) + 32 * j, ch)) = R.s[j];
        } else if (it.kind == 2) {
            const float* s0 = a.in[4] + (size_t)it.bh * 16384;
            f32x4 sv[8];
#pragma unroll
            for (int j = 0; j < 8; ++j) sv[j] = *((const f32x4*)s0 + tid + 512 * j);
#pragma unroll
            for (int j = 0; j < 8; ++j) { const int dk = (tid >> 5) + 16 * j, dv = 4 * (tid & 31);
#pragma unroll
                for (int q = 0; q < 4; ++q) *(LAS unsigned short*)(TS_ + offb(dv + q, dk >> 3) + 2 * (dk & 7)) = (unsigned short)f2bf(sv[j][q]); }
        }
        __syncthreads();
        if (i + G < NRET) ret_out_load(a, ret_item(i + G), tid, R);
        f32x16 o;
#pragma unroll
        for (int r = 0; r < 16; ++r) o[r] = 0.f;
        bf16x8 qr[8];
#pragma unroll
        for (int d0 = 0; d0 < 8; ++d0) qr[d0] = rowfrag(TQ, 32 * qhalf, lane, d0);
        const int tq = 32 * qhalf + r32;
        if (it.kind != 0) {
#pragma unroll
            for (int kd = 0; kd < 8; ++kd) o = __builtin_amdgcn_mfma_f32_32x32x16_bf16(rowfrag(TS_, 32 * cb, lane, kd), qr[kd], o, 0, 0, 0);
            const float qd = __builtin_amdgcn_exp2f(lg2 * (float)(tq + 1));
#pragma unroll
            for (int r = 0; r < 16; ++r) o[r] *= qd;
        }
        f32x16 p0, p1;
#pragma unroll
        for (int r = 0; r < 16; ++r) { p0[r] = 0.f; p1[r] = 0.f; }
#pragma unroll
        for (int d0 = 0; d0 < 8; ++d0) {
            p0 = __builtin_amdgcn_mfma_f32_32x32x16_bf16(rowfrag(TK, 0, lane, d0), qr[d0], p0, 0, 0, 0);
            p1 = __builtin_amdgcn_mfma_f32_32x32x16_bf16(rowfrag(TK, 32, lane, d0), qr[d0], p1, 0, 0, 0);
        }
#pragma unroll
        for (int r = 0; r < 16; ++r) { const int k0 = crow(r, hi), k1 = k0 + 32;
            p0[r] = tq >= k0 ? p0[r] * __builtin_amdgcn_exp2f(lg2 * (float)(tq - k0)) : 0.f;
            p1[r] = tq >= k1 ? p1[r] * __builtin_amdgcn_exp2f(lg2 * (float)(tq - k1)) : 0.f; }
        bf16x8 pa0, pa1, pa2, pa3;
        PK4(p0, 0, pa0); PK4(p0, 8, pa1); PK4(p1, 0, pa2); PK4(p1, 8, pa3);
        o = __builtin_amdgcn_mfma_f32_32x32x16_bf16(trfrag(TV, lane, cb, 0), pa0, o, 0, 0, 0);
        o = __builtin_amdgcn_mfma_f32_32x32x16_bf16(trfrag(TV, lane, cb, 1), pa1, o, 0, 0, 0);
        o = __builtin_amdgcn_mfma_f32_32x32x16_bf16(trfrag(TV, lane, cb, 2), pa2, o, 0, 0, 0);
        o = __builtin_amdgcn_mfma_f32_32x32x16_bf16(trfrag(TV, lane, cb, 3), pa3, o, 0, 0, 0);
        { float s = 0.f, q = 0.f;
#pragma unroll
          for (int r = 0; r < 16; ++r) { s += o[r]; q += o[r] * o[r]; }
          s = half_swap_sum(s); q = half_swap_sum(q);
          if (hi == 0) { ST[(tq * 4 + cb) * 2] = s; ST[(tq * 4 + cb) * 2 + 1] = q; } }
        __syncthreads();
        {
            const LAS f32x4* sp = (const LAS f32x4*)(ST + tq * 8);
            const f32x4 u0 = sp[0], u1 = sp[1];
            const float mean = ((u0.x + u0.z) + (u1.x + u1.z)) * (1.f / 128), var = fmaxf(((u0.y + u0.w) + (u1.y + u1.w)) * (1.f / 128) - mean * mean, 0.f);
            const float rstd = 1.0f / sqrtf(var + LN_EPS);
            if (tq >= tlo && tq < thi) {
                const size_t rb = (size_t)(rowbase + tq);
#pragma unroll
                for (int rg = 0; rg < 4; ++rg) {
                    const int col = h * 128 + 32 * cb + 8 * rg + 4 * hi;
                    const f32x4 gn = *(const f32x4*)(a.in[11] + col);
                    const v2u gw_ = *(const v2u*)(GS + rb * 512 + col);
                    v2u w_;
                    w_.x = pk2((o[4 * rg] - mean) * rstd * gn.x * bflo(gw_.x), (o[4 * rg + 1] - mean) * rstd * gn.y * bfhi(gw_.x));
                    w_.y = pk2((o[4 * rg + 2] - mean) * rstd * gn.z * bflo(gw_.y), (o[4 * rg + 3] - mean) * rstd * gn.w * bfhi(gw_.y));
                    wt8(wsr, WS_A16A + (rb * DM + col) * 2, w_);
                }
            }
        }
        __syncthreads();
    }
}


__device__ __forceinline__ void ret_scan(const Args& a, int gtid, int gthreads) {
    unsigned* KVN = (unsigned*)(a.ws + WS_KVN);
    for (int g = gtid; g < NB * 4 * 8192; g += gthreads) {
        const int bh = g >> 13, e2 = g & 8191, h = bh & 3;
        const float dec = __builtin_amdgcn_exp2f(lg2gamma(h) * 64.f);
        const unsigned w0 = KVN[(size_t)h * 8192 + e2];
        float s0 = bflo(w0), s1 = bfhi(w0);
        unsigned* p = KVN + (size_t)(4 + bh * 64) * 8192 + e2;
#pragma unroll 16
        for (int n = 0; n < 64; ++n) { const unsigned kv = p[(size_t)n * 8192]; p[(size_t)n * 8192] = pk2(s0, s1); s0 = dec * s0 + bflo(kv); s1 = dec * s1 + bfhi(kv); }
        const int dv = e2 >> 6, dk = (e2 & 63) * 2;
        float* so = a.out + O_PST + (size_t)bh * 16384;
        so[(size_t)dk * 128 + dv] = s0; so[(size_t)(dk + 1) * 128 + dv] = s1;
    }
}


#ifndef PROBE_DUP
#define PROBE_DUP -1
#endif
#define REPS(k) for (int rep_ = 0; rep_ < ((PROBE_DUP == (k)) ? 2 : 1); ++rep_)
constexpr int NWAVES = 8, RING_BYTES = 147456  , LDS_BYTES = RING_BYTES + 1024, MISC_OFF = RING_BYTES + 320;

__global__ void __launch_bounds__(NWAVES * 64, 2) fwd_mega(Args a) {
    extern __shared__ __attribute__((aligned(16))) unsigned char lds[];
    LAS unsigned char* L = (LAS unsigned char*)lds;
    volatile LAS unsigned* MISC = (volatile LAS unsigned*)(L + MISC_OFF);
    int tid = threadIdx.x, lane = tid & 63, wave = __builtin_amdgcn_readfirstlane(tid >> 6);
    const int G = gridDim.x, bx = blockIdx.x;
    const int vcu = (G % 8 == 0) ? (bx % 8) * (G / 8) + bx / 8 : bx;
    int gw = vcu * NWAVES + wave, gtid = vcu * (NWAVES * 64) + tid; const int NGW = G * NWAVES, gthreads = G * NWAVES * 64;
#define PHASE_BEGIN() do { tid = threadIdx.x; asm volatile("" : "+v"(tid)); lane = tid & 63; wave = __builtin_amdgcn_readfirstlane(tid >> 6); gw = vcu * NWAVES + wave; gtid = vcu * (NWAVES * 64) + tid; } while (0)
    unsigned char* ws = a.ws;
    for (int u = tid; u < (LDS_BYTES - RING_BYTES) / 4; u += NWAVES * 64) ((LAS unsigned*)(L + RING_BYTES))[u] = 0u;
    __syncthreads();
    XcdBarrier bar = xcd_barrier_post((unsigned*)(ws + WS_CTL) + CW_BAR, MISC + 8);
#define GRID_BAR() do { xcd_barrier(bar); PHASE_BEGIN(); } while (0)
#define SCR ((LAS float*)(L + wave * 16384))

    bf16* WFI = (bf16*)(ws + WS_WFI); bf16* WFO = (bf16*)(ws + WS_WFO); bf16* WMI = (bf16*)(ws + WS_WMI); bf16* WMO = (bf16*)(ws + WS_WMO); bf16* WUQ = (bf16*)(ws + WS_WUQ);
    f32x2* R128 = (f32x2*)(ws + WS_R128); f32x2* R64 = (f32x2*)(ws + WS_R64);
    bf16* A16A = (bf16*)(ws + WS_A16A); bf16* A16B = (bf16*)(ws + WS_A16B); float* Z = (float*)(ws + WS_Z); bf16* HID = (bf16*)(ws + WS_HID);

    REPS(0) {
        REPS(100) {
        transpose_matrix(a.in[6], DM, 2 * FF, WFI, 2 * FF, DM, 0, 0, SCR, gw, NGW, lane);
        transpose_matrix(a.in[7], FF, DM, WFO, DM, FF, 0, 1, SCR, gw, NGW, lane);
        transpose_matrix(a.in[10], DM, DIN, WMI, DINP, DM, 0, 2, SCR, gw, NGW, lane);
        transpose_matrix(a.in[16], 512, DM, WMO, DM, DM, 0, 1, SCR, gw, NGW, lane);
        transpose_matrix(a.in[13], 256, NQA, WUQ, 256, 256, 512, 3, SCR, gw, NGW, lane);
        }
        REPS(101) {
        const float* wuq = a.in[13]; const float* wukv = a.in[15]; const float* wmo = a.in[16];
        for (int idx = gtid; idx < 512 * 256; idx += gthreads) {
            const int k = idx & 255, np = idx >> 8, head = np >> 7, c = np & 127;
            const f32x4* x = (const f32x4*)(wuq + (size_t)k * NQA + head * KVW); const f32x4* y = (const f32x4*)(wukv + (size_t)c * 1024 + head * 256);
            float s = 0.f;
#pragma unroll 8
            for (int n = 0; n < 32; ++n) { const f32x4 xv = x[n], yv = y[n]; s += (xv.x * yv.x + xv.y * yv.y) + (xv.z * yv.z + xv.w * yv.w); }
            WUQ[(size_t)np * 256 + k] = (bf16)f2bf(s);
        }
        for (int idx = gtid; idx < 1024 * 64; idx += gthreads) {
            const int n = idx & 1023, hc = idx >> 10, head = hc >> 4, c8 = hc & 15;
            float s[8];
#pragma unroll
            for (int j = 0; j < 8; ++j) s[j] = 0.f;
            const float* wm = wmo + (size_t)(512 + head * 128) * DM + n; const float* uk = wukv + (size_t)(c8 * 8) * 1024 + head * 256 + 128;
#pragma unroll 2
            for (int v = 0; v < 128; v += 4) {
                float m[4];
#pragma unroll
                for (int q = 0; q < 4; ++q) m[q] = wm[(size_t)(v + q) * DM];
#pragma unroll
                for (int j = 0; j < 8; ++j) { const f32x4 u = *(const f32x4*)(uk + (size_t)j * 1024 + v); s[j] += (u.x * m[0] + u.y * m[1]) + (u.z * m[2] + u.w * m[3]); } }
            v4u w; w.x = pk2(s[0], s[1]); w.y = pk2(s[2], s[3]); w.z = pk2(s[4], s[5]); w.w = pk2(s[6], s[7]);
            *(v4u*)(WMO + (size_t)n * DM + 512 + head * 128 + c8 * 8) = w;
        }
        }
        REPS(102) {
        for (int idx = gtid; idx < LP * 64; idx += gthreads) {
            const int pos = idx >> 6, i = idx & 63;
            const float inv = (float)exp2(-(double)(2 * i) * (13.287712379549449 / 128.0));
            float sn, cs; sincos_acc((float)pos * inv, sn, cs);
            R128[idx] = (f32x2){cs, sn};
            if ((i & 1) == 0) R64[(size_t)pos * 32 + (i >> 1)] = (f32x2){cs, sn};
        }
        }
        REPS(103) {
        for (int r0 = gw; r0 < MTOT; r0 += 4 * NGW) {
            f32x4 v[4][4];
#pragma unroll
            for (int u = 0; u < 4; ++u) { const int r = r0 + u * NGW; const float* xr = r < MTOT ? x_row(a, r) : nullptr;
#pragma unroll
                for (int j = 0; j < 4; ++j) v[u][j] = xr ? *((const f32x4*)xr + lane + 64 * j) : (f32x4){0.f, 0.f, 0.f, 0.f}; }
#pragma unroll
            for (int u = 0; u < 4; ++u) { const int r = r0 + u * NGW; if (r < MTOT) { v2u* o = (v2u*)(A16A + (size_t)r * DM) + lane;
#pragma unroll
                for (int j = 0; j < 4; ++j) { v2u w; w.x = pk2(v[u][j].x, v[u][j].y); w.y = pk2(v[u][j].z, v[u][j].w); o[64 * j] = w; } } }
        }
        }
    }
    GRID_BAR();
#ifndef NO_P1
    REPS(1) { pg8::Gemm g{A16A, WFI, MTOT, 2 * FF, DM}; pg8::StaticOrder S; S.init(MTOT, 2 * FF, G, bx, DM); EpiSwiglu E{ws_rsrc(a), WS_HID};
      pg8::gemm_phase<EpiSwiglu, pg8::StaticOrder, true, true>(L, g, S, E); }
#endif
    GRID_BAR();
#ifndef NO_P2
    REPS(2) { pg8::Gemm g{HID, WFO, MTOT, DM, FF}; pg8::SplitOrder S; S.init(MAIN_ROWS, MTOT, DM, G, bx, FF, 11); EpiResZ<0> E{ws_rsrc(a), WS_Z, nullptr, a, 0.5f};
      pg8::gemm_phase<EpiResZ<0>, pg8::SplitOrder, true, true>(L, g, S, E, (float*)A16A); }
#endif
    GRID_BAR();
    REPS(3) ln_rows<false, 0, 11>(a, Z, a.in[8], a.in[9], A16B, (const float*)A16A, nullptr, 0.5f, gw, NGW, lane);
    GRID_BAR();
#ifndef NO_P4
    REPS(4) { pg8::Gemm g{A16B, WMI, MTOT, DINP, DM}; pg8::StaticOrder S; S.init(MTOT, DINP, G, bx, DM);
      EpiMixIn E{ws_rsrc(a), R128};
      pg8::gemm_phase<EpiMixIn, pg8::StaticOrder, true, true>(L, g, S, E); }
#endif
    GRID_BAR();
    REPS(5) { post_rows(a, gw, NGW, lane);
    transpose_matrix(a.in[19], DM, 2 * FF, WFI, 2 * FF, DM, 0, 0, SCR, gw, NGW, lane);
    transpose_matrix(a.in[20], FF, DM, WFO, DM, FF, 0, 1, SCR, gw, NGW, lane); }
    GRID_BAR();
#ifndef NO_P6
    REPS(6) { int kq = 256; asm volatile("" : "+s"(kq));
      pg8::Gemm g{(const bf16*)(ws + WS_CQB), WUQ, MTOT, NQA, kq}; pg8::StaticOrder S; S.init(MTOT, NQA, G, bx, kq); EpiUq E{ws_rsrc(a), R64};
      pg8::gemm_phase<EpiUq, pg8::StaticOrder, true, true>(L, g, S, E); }
#endif
    GRID_BAR();
    {
        REPS(70) for (int i = vcu; i < NRET; i += G) ret_kv_item(a, L, ret_item(i), tid);
        {
            unsigned* qctr = (unsigned*)(ws + WS_CTL) + CW_ATTQ;
            for (;;) {
                if (tid == 0) MISC[16] = __hip_atomic_fetch_add(qctr, 1u, __ATOMIC_RELAXED, __HIP_MEMORY_SCOPE_AGENT);
                __syncthreads();
                const int idx = (int)MISC[16];
                if (idx >= 529) break;
                int type, bi, cc, qh;
                if (idx < 392) { type = 0; cc = 63 - (idx >> 3); bi = idx & 3; qh = (idx >> 2) & 1; }
                else if (idx < 408) { type = 1; bi = idx - 392; cc = 0; qh = 0; }
                else if (idx < 528) { const int j = idx - 408; type = 0; cc = 14 - (j >> 3); bi = j & 3; qh = (j >> 2) & 1; }
                else { type = 2; bi = 0; cc = 0; qh = 0; }
                attn_unit(a, L, type, bi, cc, qh, tid);
            }
        }
    }
    GRID_BAR();
    ret_scan(a, gtid, gthreads);
    GRID_BAR();
    REPS(9) ret_out_phase(a, L, vcu, G, tid);
    GRID_BAR();
#ifndef NO_P10
    REPS(10) { pg8::Gemm g{A16A, WMO, MTOT, DM, DM}; pg8::SplitOrder S; S.init(MAIN_ROWS, MTOT, DM, G, bx, DM, 4); EpiResZ<1> E{ws_rsrc(a), WS_Z, A16B, a, 1.0f};
      pg8::gemm_phase<EpiResZ<1>, pg8::SplitOrder, true, true>(L, g, S, E, (float*)HID); }
#endif
    GRID_BAR();
    ln_rows<false, 1, 4>(a, Z, a.in[17], a.in[18], A16B, (const float*)HID, A16B, 1.0f, gw, NGW, lane);
    GRID_BAR();
#ifndef NO_P12
    REPS(12) { pg8::Gemm g{A16B, WFI, MTOT, 2 * FF, DM}; pg8::StaticOrder S; S.init(MTOT, 2 * FF, G, bx, DM); EpiSwiglu E{ws_rsrc(a), WS_HID};
      pg8::gemm_phase<EpiSwiglu, pg8::StaticOrder, true, true>(L, g, S, E); }
#endif
    GRID_BAR();
#ifndef NO_P13
    REPS(13) { pg8::Gemm g{HID, WFO, MTOT, DM, FF}; pg8::SplitOrder S; S.init(MAIN_ROWS, MTOT, DM, G, bx, FF, 11); EpiResZ<1> E{ws_rsrc(a), WS_Z, A16B, a, 0.5f};
      pg8::gemm_phase<EpiResZ<1>, pg8::SplitOrder, true, true>(L, g, S, E, (float*)A16A); }
#endif
    GRID_BAR();
    ln_rows<true, 1, 11>(a, Z, a.in[21], a.in[22], nullptr, (const float*)A16A, A16B, 0.5f, gw, NGW, lane);
#undef GRID_BAR
}

extern "C" void kernel_launch(void* const* d_in, const int* in_sizes, int n_in, void* d_out, int out_size, void* d_ws, size_t ws_size, hipStream_t stream) {
    static int grid = 0;
    if (grid == 0) {
        if (n_in != 23 || out_size != (int)O_END || ws_size < WS_END) { fprintf(stderr, "kernel_launch: unexpected shapes (n_in %d, out %d, ws %zu; need 23, %zu, >= %zu)\n", n_in, out_size, ws_size, (size_t)O_END, (size_t)WS_END); grid = -1; return; }
        int dev = 0, cus = 0, per_cu = 0;
        if (hipGetDevice(&dev) != hipSuccess || hipDeviceGetAttribute(&cus, hipDeviceAttributeMultiprocessorCount, dev) != hipSuccess) { grid = -1; return; }
        if (hipFuncSetAttribute((const void*)fwd_mega, hipFuncAttributeMaxDynamicSharedMemorySize, LDS_BYTES) != hipSuccess) { fprintf(stderr, "kernel_launch: hipFuncSetAttribute failed\n"); grid = -1; return; }
        if (hipOccupancyMaxActiveBlocksPerMultiprocessor(&per_cu, (const void*)fwd_mega, NWAVES * 64, LDS_BYTES) != hipSuccess || per_cu < 1) { fprintf(stderr, "kernel_launch: occupancy query says %d blocks per CU\n", per_cu); per_cu = 1; }
        (void)hipGetLastError();
        grid = cus;
    }
    if (grid < 0) return;
    (void)hipMemsetAsync((char*)d_ws + WS_CTL, 0, CTL_BYTES, stream);
    Args a{};
    for (int i = 0; i < 23; ++i) a.in[i] = (const float*)d_in[i];
    a.out = (float*)d_out; a.ws = (unsigned char*)d_ws;
    void* args[] = {&a};
    hipError_t e = hipLaunchCooperativeKernel((const void*)fwd_mega, dim3(grid), dim3(NWAVES * 64), args, LDS_BYTES, stream);
    if (e != hipSuccess) fprintf(stderr, "kernel_launch: cooperative launch failed: %s (grid %d)\n", hipGetErrorString(e), grid);
}
```
